# Optimizing an MI355X kernel written in HIP

```python
import math
import jax, jax.numpy as jnp
from jax import lax
import numpy as np

D_MODEL = 2048
BATCH = 4
SEQ = 4096
DEPTH = 2

SB_HEADS = 8
SB_HEAD_DIM = 128
SB_WIDTH = SB_HEADS * SB_HEAD_DIM
POOL_WINDOWS = (2, 4, 8, 16)
POOL_GROUPS = len(POOL_WINDOWS)
POOL_WIDTH = D_MODEL - SB_WIDTH
POOL_GROUP_DIM = POOL_WIDTH // POOL_GROUPS
MIX_WIDTH = SB_WIDTH + POOL_WIDTH
EVEN_IN = 4 * SB_WIDTH + 2 * POOL_WIDTH
BLOCK_Q = 128

RWKV_HEAD_DIM = 64
RWKV_HEADS = D_MODEL // RWKV_HEAD_DIM
DECAY_LORA = 96
ICLR_LORA = 96
GN_EPS = 64e-5
L2_EPS = 1e-12

LN_EPS = 1e-5
DEEPNORM_ALPHA = (2 * DEPTH) ** 0.25
DEEPNORM_BETA = (8 * DEPTH) ** -0.25
N_EVEN = (DEPTH + 1) // 2
N_ODD = DEPTH // 2

kernel_name = "hybrid_stickbreak_pool_rwkv7"


def layer_norm(x, g, b):
    xf = x.astype(jnp.float32)
    mean = jnp.mean(xf, axis=-1, keepdims=True)
    var = jnp.mean(jnp.square(xf - mean), axis=-1, keepdims=True)
    return ((xf - mean) * lax.rsqrt(var + LN_EPS) * g + b).astype(x.dtype)


def stick_breaking_attention(q, k, v):
    S = q.shape[2]
    scale = SB_HEAD_DIM ** -0.5
    outs = []
    for start in range(0, S, BLOCK_Q):
        end = start + BLOCK_Q
        qb = q[:, :, start:end].astype(jnp.float32)
        kb = k[:, :, :end].astype(jnp.float32)
        vb = v[:, :, :end]
        z = jnp.einsum('bhqd,bhkd->bhqk', qb, kb) * scale
        t_idx = start + jnp.arange(BLOCK_Q)[:, None]
        s_idx = jnp.arange(end)[None, :]
        causal = s_idx < t_idx
        log_keep = jnp.where(causal, jax.nn.log_sigmoid(-z), 0.0)
        later = lax.cumsum(log_keep, axis=3, reverse=True) - log_keep
        weights = jnp.where(causal, jnp.exp(jax.nn.log_sigmoid(z) + later), 0.0)
        outs.append(jnp.einsum('bhqk,bhkd->bhqd', weights.astype(vb.dtype), vb))
    return jnp.concatenate(outs, axis=2)


def multiscale_pool(u, w_pool, pool_scale):
    B_, S, _ = u.shape
    ug = u.reshape(B_, S, POOL_GROUPS, POOL_GROUP_DIM).astype(jnp.float32)
    c0 = jnp.concatenate([jnp.zeros_like(ug[:, :1]), jnp.cumsum(ug, axis=1)], axis=1)
    pos = jnp.arange(1, S + 1, dtype=jnp.float32)
    outs = []
    for g, w in enumerate(POOL_WINDOWS):
        cg = c0[:, :, g]
        lower = jnp.concatenate([jnp.zeros_like(cg[:, :w - 1]), cg[:, :S - w + 1]], axis=1)
        count = jnp.minimum(pos, float(w))[None, :, None]
        outs.append((cg[:, 1:] - lower) / count - ug[:, :, g])
    pooled = jnp.stack(outs, axis=2)
    mixed = jnp.einsum('bsgc,gcd->bsgd', pooled, w_pool.astype(jnp.float32))
    return (mixed.reshape(B_, S, POOL_WIDTH) * pool_scale).astype(u.dtype)


def even_layer(x, w_in, w_pool, pool_scale, w_out):
    B_, S, _ = x.shape
    h = x @ w_in
    q, k, v, g_a, u, g_b = jnp.split(
        h, [SB_WIDTH, 2 * SB_WIDTH, 3 * SB_WIDTH, 4 * SB_WIDTH, 4 * SB_WIDTH + POOL_WIDTH], axis=-1)

    def heads(t):
        return t.reshape(B_, S, SB_HEADS, SB_HEAD_DIM).transpose(0, 2, 1, 3)

    o_a = stick_breaking_attention(heads(q), heads(k), heads(v))
    o_a = o_a.transpose(0, 2, 1, 3).reshape(B_, S, SB_WIDTH)
    o_b = multiscale_pool(u, w_pool, pool_scale)
    mixed = jnp.concatenate([o_a * jax.nn.silu(g_a), o_b * jax.nn.silu(g_b)], axis=-1)
    return mixed @ w_out


def wkv7_scan(r, w, k, v, kk, a):
    B_, S, H, N = r.shape

    def step(state, inp):
        r_t, w_t, k_t, v_t, kk_t, a_t = inp
        sa = jnp.einsum('bhvk,bhk->bhv', state, -kk_t)
        state = (state * w_t[:, :, None, :]
                 + sa[..., None] * (kk_t * a_t)[:, :, None, :]
                 + v_t[..., None] * k_t[:, :, None, :])
        return state, jnp.einsum('bhvk,bhk->bhv', state, r_t)

    xs = (jnp.moveaxis(r, 1, 0), jnp.moveaxis(w, 1, 0), jnp.moveaxis(k, 1, 0),
          jnp.moveaxis(v, 1, 0), jnp.moveaxis(kk, 1, 0), jnp.moveaxis(a, 1, 0))
    state0 = jnp.zeros((B_, H, N, N), jnp.float32)
    _, out = lax.scan(step, state0, xs)
    return jnp.moveaxis(out, 0, 1)


def odd_layer(x, mu, w_r, w_k, w_v, w_g, w0, w1, w2, a0, a1, a2, k_k, k_a, r_k, gn_w, gn_b, w_o):
    B_, S, D = x.shape
    H, N = RWKV_HEADS, RWKV_HEAD_DIM
    f32 = jnp.float32
    x_prev = jnp.pad(x, ((0, 0), (1, 0), (0, 0)))[:, :S]
    xx = x_prev - x
    xr = x + xx * mu[0]
    xw = x + xx * mu[1]
    xk = x + xx * mu[2]
    xv = x + xx * mu[3]
    xa = x + xx * mu[4]
    xg = x + xx * mu[5]
    r = (xr @ w_r).astype(f32)
    k = (xk @ w_k).astype(f32)
    v = (xv @ w_v).astype(f32)
    g = (xg @ w_g).astype(f32)
    w_log = -jax.nn.softplus(-(w0 + jnp.tanh(xw @ w1) @ w2).astype(f32)) - 0.5
    decay = jnp.exp(-jnp.exp(w_log))
    a = jax.nn.sigmoid((a0 + (xa @ a1) @ a2).astype(f32))
    kk = (k * k_k).reshape(B_, S, H, N)
    kk = kk / jnp.maximum(jnp.sqrt(jnp.sum(kk * kk, axis=-1, keepdims=True)), L2_EPS)
    k = k * (1.0 + (a - 1.0) * k_a)
    r = r.reshape(B_, S, H, N)
    k = k.reshape(B_, S, H, N)
    v = v.reshape(B_, S, H, N)
    o = wkv7_scan(r, decay.reshape(B_, S, H, N), k, v, kk, a.reshape(B_, S, H, N))
    mean = jnp.mean(o, axis=-1, keepdims=True)
    var = jnp.mean(jnp.square(o - mean), axis=-1, keepdims=True)
    o = ((o - mean) * lax.rsqrt(var + GN_EPS)).reshape(B_, S, D) * gn_w + gn_b
    bonus = jnp.sum(r * k * r_k, axis=-1, keepdims=True) * v
    o = (o + bonus.reshape(B_, S, D)) * jax.nn.silu(g)
    return o.astype(x.dtype) @ w_o


def setup_inputs(seed: int = 0) -> dict:
    key = jax.random.key(seed)
    ks = list(jax.random.split(key, 32))
    f32 = jnp.float32

    def nrm(i, shape, scale):
        return scale * jax.random.normal(ks[i], shape, f32)

    def unif(i, shape, lo, hi):
        return jax.random.uniform(ks[i], shape, f32, lo, hi)

    D = D_MODEL
    H, N = RWKV_HEADS, RWKV_HEAD_DIM
    return {
        'x': nrm(0, (BATCH, SEQ, D), 1.0),
        'ev_w_in': nrm(1, (N_EVEN, D, EVEN_IN), D ** -0.5),
        'ev_w_pool': nrm(2, (N_EVEN, POOL_GROUPS, POOL_GROUP_DIM, POOL_GROUP_DIM), POOL_GROUP_DIM ** -0.5),
        'ev_pool_scale': 1.0 + nrm(3, (N_EVEN, POOL_WIDTH), 0.1),
        'ev_w_out': nrm(4, (N_EVEN, MIX_WIDTH, D), DEEPNORM_BETA * MIX_WIDTH ** -0.5),
        'od_mu': unif(5, (N_ODD, 6, D), 0.0, 1.0),
        'od_w_r': nrm(6, (N_ODD, D, D), D ** -0.5),
        'od_w_k': nrm(7, (N_ODD, D, D), D ** -0.5),
        'od_w_v': nrm(8, (N_ODD, D, D), D ** -0.5),
        'od_w_g': nrm(9, (N_ODD, D, D), D ** -0.5),
        'od_w0': unif(10, (N_ODD, D), -6.0, 1.0),
        'od_w1': nrm(11, (N_ODD, D, DECAY_LORA), D ** -0.5),
        'od_w2': nrm(12, (N_ODD, DECAY_LORA, D), 0.5 * DECAY_LORA ** -0.5),
        'od_a0': nrm(13, (N_ODD, D), 0.1),
        'od_a1': nrm(14, (N_ODD, D, ICLR_LORA), D ** -0.5),
        'od_a2': nrm(15, (N_ODD, ICLR_LORA, D), 0.5 * ICLR_LORA ** -0.5),
        'od_k_k': 0.85 + nrm(16, (N_ODD, D), 0.05),
        'od_k_a': 1.0 + nrm(17, (N_ODD, D), 0.05),
        'od_r_k': nrm(18, (N_ODD, H, N), 0.1),
        'od_gn_w': 1.0 + nrm(19, (N_ODD, D), 0.05),
        'od_gn_b': nrm(20, (N_ODD, D), 0.02),
        'od_w_o': nrm(21, (N_ODD, D, D), DEEPNORM_BETA * D ** -0.5),
        'ln_g': 1.0 + nrm(22, (DEPTH, D), 0.02),
        'ln_b': nrm(23, (DEPTH, D), 0.02),
    }


def reference(x, ev_w_in, ev_w_pool, ev_pool_scale, ev_w_out,
              od_mu, od_w_r, od_w_k, od_w_v, od_w_g, od_w0, od_w1, od_w2,
              od_a0, od_a1, od_a2, od_k_k, od_k_a, od_r_k, od_gn_w, od_gn_b, od_w_o,
              ln_g, ln_b):
    for layer in range(DEPTH):
        j = layer // 2
        if layer % 2 == 0:
            y = even_layer(x, ev_w_in[j], ev_w_pool[j], ev_pool_scale[j], ev_w_out[j])
        else:
            y = odd_layer(x, od_mu[j], od_w_r[j], od_w_k[j], od_w_v[j], od_w_g[j],
                          od_w0[j], od_w1[j], od_w2[j], od_a0[j], od_a1[j], od_a2[j],
                          od_k_k[j], od_k_a[j], od_r_k[j], od_gn_w[j], od_gn_b[j], od_w_o[j])
        x = layer_norm(DEEPNORM_ALPHA * x + y, ln_g[layer], ln_b[layer])
    return x
```

```cpp
#include <hip/hip_runtime.h>
#include <hip/hip_bf16.h>
#include <cstdio>
#include <cstdint>

#ifndef MK_N_LAUNCHES
#define MK_N_LAUNCHES 12
#endif

namespace pg8 {
#define PG8_LAS __attribute__((address_space(3)))
typedef unsigned short bf16_t;
typedef short bf16x8 __attribute__((ext_vector_type(8)));
typedef float f32x4 __attribute__((ext_vector_type(4)));
typedef float f32x2 __attribute__((ext_vector_type(2)));
typedef unsigned u32x4 __attribute__((ext_vector_type(4)));
constexpr int BM = 256, BK = 64, HALF = 128, HTB = HALF * BK * 2, STAGE_BYTES = 8 * HTB, NXCD = 8, WGM = 8;

__host__ __device__ __forceinline__ int lds_byte(int r, int c) { const int st = (r >> 4) * 2 + (c >> 5), rr = r & 15, cc = c & 31, ob = rr * 64 + cc * 2; return st * 1024 + (ob ^ (((ob >> 9) & 1) << 5)); }
__host__ __device__ __forceinline__ void stage_rc(int b, int& R, int& C) { const int st = b / 1024, sb = b % 1024, swz = sb ^ (((sb >> 9) & 1) << 5); R = (st >> 1) * 16 + swz / 64; C = (st & 1) * 32 + (swz % 64) / 2; }
__host__ __device__ __forceinline__ int perm32(int rho) { const int n = rho >> 4, i = rho & 15; return 8 * (i >> 2) + 4 * n + (i & 3); }

struct Unit { int pm, pn; };
struct Gemm { const bf16_t* A; const bf16_t* Bt; int M, N, K, lda, ldb; int asel; size_t astride; };
__device__ __forceinline__ const bf16_t* a_base(const Gemm& g, const Unit& u) {
    int idx = 0;
    if (g.asel == 1) idx = u.pn;
    else if (g.asel == 2) idx = u.pn < 32 ? (u.pn >> 3) : (u.pn - 28);
    return g.A + (size_t)idx * g.astride;
}

struct StaticOrder {
    int nM, nN, nwg, G, c;
    __host__ __device__ void init(int M, int N, int G_, int c_) { nM = M / BM; nN = N / BM; nwg = nM * nN; G = G_; c = c_; }
    __host__ __device__ bool next(int i, Unit& u) const {
        const long L = (long)i * G + c; if (L >= nwg) return false;
        int wgid = (int)L; { const int q = nwg / NXCD, r = nwg % NXCD, xcd = wgid % NXCD, off = wgid / NXCD; wgid = (xcd < r ? xcd * (q + 1) : r * (q + 1) + (xcd - r) * q) + off; }
        const int nig = WGM * nN, gid = wgid / nig, fm = gid * WGM, gsz = (nM - fm) < WGM ? (nM - fm) : WGM;
        u.pm = fm + ((wgid % nig) % gsz); u.pn = (wgid % nig) / gsz; return true;
    }
};
struct OneUnit { Unit u0; __device__ __forceinline__ bool next(int i, Unit& u) const { if (i != 0) return false; u = u0; return true; } };

__device__ __forceinline__ unsigned cvt_pk_bf16(float lo, float hi) { unsigned r; asm volatile("v_cvt_pk_bf16_f32 %0, %1, %2" : "=v"(r) : "v"(lo), "v"(hi)); return r; }
__device__ __forceinline__ float bf_lo(unsigned w) { return __uint_as_float(w << 16); }
__device__ __forceinline__ float bf_hi(unsigned w) { return __uint_as_float(w & 0xffff0000u); }
__device__ __forceinline__ float sigmoidf_(float x) { return __builtin_amdgcn_rcpf(1.0f + __builtin_amdgcn_exp2f(-1.4426950408889634f * x)); }
__device__ __forceinline__ float siluf_(float x) { return x * sigmoidf_(x); }
__device__ __forceinline__ float tanhf_(float x) { return 1.0f - 2.0f * __builtin_amdgcn_rcpf(1.0f + __builtin_amdgcn_exp2f(2.8853900817779268f * x)); }

constexpr float QSCALE2 = 0.08838834764831845f * 1.4426950408889634f;

struct EpiH {
    static constexpr bool PERM = true;
    bf16_t* O;
    __device__ __forceinline__ void operator()(const f32x4 (&acc)[2][2][4][2], const Unit& u, int wr, int wc, int fr, int fq) const {
        const int row0 = u.pm * BM + wr * 64 + fr, col0 = u.pn * BM + wc * 32 + 8 * fq;
        const int mode = u.pn < 4 ? 1 : (((u.pn >= 12 && u.pn < 16) || u.pn >= 20) ? 2 : 0);
#pragma unroll
        for (int ai = 0; ai < 2; ++ai)
#pragma unroll
            for (int m = 0; m < 4; ++m) { bf16_t* rowp = O + (size_t)(row0 + ai * HALF + m * 16) * 6144 + col0;
#pragma unroll
                for (int bj = 0; bj < 2; ++bj) { f32x4 v0 = acc[ai][bj][m][0], v1 = acc[ai][bj][m][1];
                    if (mode == 1) { v0 = v0 * QSCALE2; v1 = v1 * QSCALE2; }
                    else if (mode == 2) {
#pragma unroll
                        for (int e = 0; e < 4; ++e) { v0[e] = siluf_(v0[e]); v1[e] = siluf_(v1[e]); } }
                    u32x4 w; w.x = cvt_pk_bf16(v0[0], v0[1]); w.y = cvt_pk_bf16(v0[2], v0[3]); w.z = cvt_pk_bf16(v1[0], v1[1]); w.w = cvt_pk_bf16(v1[2], v1[3]);
                    *(u32x4*)(rowp + bj * HALF) = w; } }
    }
};
struct EpiPool {
    static constexpr bool PERM = true;
    bf16_t* MIX; const bf16_t* Hb; const float* pscale;
    __device__ __forceinline__ void operator()(const f32x4 (&acc)[2][2][4][2], const Unit& u, int wr, int wc, int fr, int fq) const {
        const int row0 = u.pm * BM + wr * 64 + fr, col0 = u.pn * BM + wc * 32 + 8 * fq;
#pragma unroll
        for (int ai = 0; ai < 2; ++ai)
#pragma unroll
            for (int m = 0; m < 4; ++m) { const size_t row = (size_t)(row0 + ai * HALF + m * 16);
#pragma unroll
                for (int bj = 0; bj < 2; ++bj) {
                    const f32x4 s0 = *(const f32x4*)(pscale + col0 + bj * HALF), s1 = *(const f32x4*)(pscale + col0 + bj * HALF + 4);
                    const u32x4 gb = *(const u32x4*)(Hb + row * 6144 + 5120 + col0 + bj * HALF);
                    f32x4 v0 = acc[ai][bj][m][0] * s0, v1 = acc[ai][bj][m][1] * s1;
                    v0[0] *= bf_lo(gb.x); v0[1] *= bf_hi(gb.x); v0[2] *= bf_lo(gb.y); v0[3] *= bf_hi(gb.y);
                    v1[0] *= bf_lo(gb.z); v1[1] *= bf_hi(gb.z); v1[2] *= bf_lo(gb.w); v1[3] *= bf_hi(gb.w);
                    u32x4 w; w.x = cvt_pk_bf16(v0[0], v0[1]); w.y = cvt_pk_bf16(v0[2], v0[3]); w.z = cvt_pk_bf16(v1[0], v1[1]); w.w = cvt_pk_bf16(v1[2], v1[3]);
                    *(u32x4*)(MIX + row * 2048 + 1024 + col0 + bj * HALF) = w; }
                asm volatile("" ::: "memory"); }
    }
};
struct EpiZ {
    static constexpr bool PERM = false;
    const float* X; float* Z; float alpha;
    __device__ __forceinline__ void operator()(const f32x4 (&acc)[2][2][4][2], const Unit& u, int wr, int wc, int fr, int fq) const {
        const int row0 = u.pm * BM + wr * 64 + fr, col0 = u.pn * BM + wc * 32 + 4 * fq;
#pragma unroll
        for (int ai = 0; ai < 2; ++ai)
#pragma unroll
            for (int m = 0; m < 4; ++m) { const size_t off = (size_t)(row0 + ai * HALF + m * 16) * 2048 + col0;
#pragma unroll
                for (int bj = 0; bj < 2; ++bj)
#pragma unroll
                    for (int n = 0; n < 2; ++n) { const f32x4 xv = *(const f32x4*)(X + off + bj * HALF + n * 16); *(f32x4*)(Z + off + bj * HALF + n * 16) = xv * alpha + acc[ai][bj][m][n]; } }
    }
};
struct Epi5 {
    static constexpr bool PERM = true;
    bf16_t* OUT; size_t ostride; bf16_t* TL; int row_off;
    __device__ __forceinline__ void operator()(const f32x4 (&acc)[2][2][4][2], const Unit& u, int wr, int wc, int fr, int fq) const {
        const int row0 = row_off + u.pm * BM + wr * 64 + fr, ct = wc * 32 + 8 * fq;
#pragma unroll
        for (int ai = 0; ai < 2; ++ai)
#pragma unroll
            for (int m = 0; m < 4; ++m) { const size_t row = (size_t)(row0 + ai * HALF + m * 16);
#pragma unroll
                for (int bj = 0; bj < 2; ++bj) { f32x4 v0 = acc[ai][bj][m][0], v1 = acc[ai][bj][m][1]; const int c = ct + bj * HALF;
                    bf16_t* dst;
                    if (u.pn < 32) { const int arr = u.pn >> 3; dst = OUT + (size_t)arr * ostride + row * 2048 + (u.pn & 7) * BM + c;
                        if (arr == 3) {
#pragma unroll
                            for (int e = 0; e < 4; ++e) { v0[e] = siluf_(v0[e]); v1[e] = siluf_(v1[e]); } } }
                    else if (u.pn == 32) { if (c >= 96) continue; dst = TL + row * 256 + c;
#pragma unroll
                        for (int e = 0; e < 4; ++e) { v0[e] = tanhf_(v0[e]); v1[e] = tanhf_(v1[e]); } }
                    else { if (c >= 160) continue; dst = TL + row * 256 + 96 + c; }
                    u32x4 w; w.x = cvt_pk_bf16(v0[0], v0[1]); w.y = cvt_pk_bf16(v0[2], v0[3]); w.z = cvt_pk_bf16(v1[0], v1[1]); w.w = cvt_pk_bf16(v1[2], v1[3]);
                    *(u32x4*)dst = w; } }
    }
};
typedef _Float16 h16x2 __attribute__((ext_vector_type(2)));
__device__ __forceinline__ unsigned pk_h2(float a, float b) { h16x2 h = {(_Float16)a, (_Float16)b}; return __builtin_bit_cast(unsigned, h); }
struct Epi6 {
    static constexpr bool PERM = true;
    unsigned short* LOGW; unsigned short* AA; const float* w0; const float* a0;
    __device__ __forceinline__ void operator()(const f32x4 (&acc)[2][2][4][2], const Unit& u, int wr, int wc, int fr, int fq) const {
        const int row0 = u.pm * BM + wr * 64 + fr; const bool isw = u.pn < 8;
        const int col0 = (u.pn & 7) * BM + wc * 32 + 8 * fq; unsigned short* O = isw ? LOGW : AA; const float* bias = isw ? w0 : a0; const float sc = isw ? -0.6065306597126334f : 1.0f;
#pragma unroll
        for (int bj = 0; bj < 2; ++bj) { const f32x4 b0 = *(const f32x4*)(bias + col0 + bj * HALF), b1 = *(const f32x4*)(bias + col0 + bj * HALF + 4);
#pragma unroll
            for (int ai = 0; ai < 2; ++ai)
#pragma unroll
                for (int m = 0; m < 4; ++m) { f32x4 v0 = acc[ai][bj][m][0] + b0, v1 = acc[ai][bj][m][1] + b1;
#pragma unroll
                    for (int e = 0; e < 4; ++e) { v0[e] = sc * sigmoidf_(v0[e]); v1[e] = sc * sigmoidf_(v1[e]); }
                    u32x4 w; w.x = pk_h2(v0[0], v0[1]); w.y = pk_h2(v0[2], v0[3]); w.z = pk_h2(v1[0], v1[1]); w.w = pk_h2(v1[2], v1[3]);
                    *(u32x4*)(O + (size_t)(row0 + ai * HALF + m * 16) * 2048 + col0 + bj * HALF) = w; } }
    }
};
struct Epi8 {
    static constexpr bool PERM = false;
    float* Z; const float* stats; const float* g; const float* b; float alpha;
    __device__ __forceinline__ void operator()(const f32x4 (&acc)[2][2][4][2], const Unit& u, int wr, int wc, int fr, int fq) const {
        const int row0 = u.pm * BM + wr * 64 + fr, col0 = u.pn * BM + wc * 32 + 4 * fq;
#pragma unroll
        for (int ai = 0; ai < 2; ++ai)
#pragma unroll
            for (int m = 0; m < 4; ++m) { const int row = row0 + ai * HALF + m * 16; const f32x2 st = *(const f32x2*)(stats + 2 * row); const size_t off = (size_t)row * 2048 + col0;
#pragma unroll
                for (int bj = 0; bj < 2; ++bj)
#pragma unroll
                    for (int n = 0; n < 2; ++n) { const int cc = col0 + bj * HALF + n * 16; const f32x4 gv = *(const f32x4*)(g + cc), bv = *(const f32x4*)(b + cc);
                        const f32x4 z = *(const f32x4*)(Z + off + bj * HALF + n * 16); const f32x4 x1 = (z - st.x) * st.y * gv + bv;
                        *(f32x4*)(Z + off + bj * HALF + n * 16) = x1 * alpha + acc[ai][bj][m][n]; } }
    }
};

template <class Epi, class Sched, bool ALIGN_EPI = true>
__device__ __forceinline__ void gemm_phase(PG8_LAS unsigned char* lds, const Gemm g, const Sched& S, const Epi& E) {
    int tid = threadIdx.x; asm volatile("" : "+v"(tid));
    const int wid = __builtin_amdgcn_readfirstlane(tid >> 6), lane = tid & 63, wr = wid >> 2, wc = wid & 3, fr = lane & 15, fq = lane >> 4;
    const int K = g.K, nt = K / BK;
    unsigned voffA[2], voffB[2];
#pragma unroll
    for (int i = 0; i < 2; ++i) { int R, C; stage_rc(tid * 16 + i * 8192, R, C); const int Rb = Epi::PERM ? ((R & ~31) + perm32(R & 31)) : R;
        voffA[i] = (unsigned)(R * g.lda + C) * 2u; voffB[i] = (unsigned)(Rb * g.ldb + C) * 2u; }
    const size_t kstep = (size_t)(BK * 2);
    const size_t hstepA = (size_t)HALF * g.lda * 2, hstepB = (size_t)HALF * g.ldb * 2;
    const size_t tstepA = 2 * hstepA, tstepB = 2 * hstepB;
    const unsigned ldsw = (unsigned)wid * 1024u;
    const int aoff = lds_byte(wr * 64 + fr, fq * 8), boff = lds_byte(wc * 32 + fr, fq * 8);
#define PG8_SA(b, h) (((b) * 2 + (h)) * HTB)
#define PG8_SB(b, h) ((4 + (b) * 2 + (h)) * HTB)
#define PG8_STAGE(bufoff, gbase, voff) do { _Pragma("unroll") for (int _i = 0; _i < 2; ++_i) \
        __builtin_amdgcn_global_load_lds((const unsigned*)((const char*)(gbase) + (voff)[_i]), (PG8_LAS unsigned*)(lds + (bufoff) + ldsw + _i * 8192), 16, 0, 0); } while (0)
#define PG8_LDA(dst, b, h) do { _Pragma("unroll") for (int m = 0; m < 4; ++m) _Pragma("unroll") for (int k = 0; k < 2; ++k) dst[m][k] = *(const PG8_LAS bf16x8*)(lds + PG8_SA(b, h) + aoff + m * 2048 + k * 1024); } while (0)
#define PG8_LDB(dst, b, h) do { _Pragma("unroll") for (int n = 0; n < 2; ++n) _Pragma("unroll") for (int k = 0; k < 2; ++k) dst[n][k] = *(const PG8_LAS bf16x8*)(lds + PG8_SB(b, h) + boff + n * 2048 + k * 1024); } while (0)
#define PG8_MMA(ai, bj, At, Bt) do { __builtin_amdgcn_s_setprio(1); _Pragma("unroll") for (int m = 0; m < 4; ++m) _Pragma("unroll") for (int n = 0; n < 2; ++n) _Pragma("unroll") for (int k = 0; k < 2; ++k) \
        acc[ai][bj][m][n] = __builtin_amdgcn_mfma_f32_16x16x32_bf16(Bt[n][k], At[m][k], acc[ai][bj][m][n], 0, 0, 0); __builtin_amdgcn_s_setprio(0); } while (0)
#define PG8_WAIT_V(n) asm volatile("s_waitcnt vmcnt(" #n ")" ::: "memory")
#define PG8_WAIT_L(n) asm volatile("s_waitcnt lgkmcnt(" #n ")" ::: "memory")
#define PG8_BAR __builtin_amdgcn_s_barrier()
#define PG8_SCHED __builtin_amdgcn_sched_barrier(0)
    Unit cur, nxt; int ui = 0;
    if (!S.next(0, cur)) return;
    f32x4 acc[2][2][4][2];
#pragma unroll
    for (int a = 0; a < 2; ++a)
#pragma unroll
        for (int b = 0; b < 2; ++b)
#pragma unroll
            for (int m = 0; m < 4; ++m)
#pragma unroll
                for (int n = 0; n < 2; ++n) acc[a][b][m][n] = (f32x4){0.f, 0.f, 0.f, 0.f};
    bf16x8 At[4][2], B0[2][2], B1[2][2];
    const char* cA = (const char*)a_base(g, cur) + (size_t)cur.pm * tstepA; const char* cB = (const char*)g.Bt + (size_t)cur.pn * tstepB;
    PG8_STAGE(PG8_SB(0, 0), cB, voffB); PG8_STAGE(PG8_SB(0, 1), cB + hstepB, voffB); PG8_STAGE(PG8_SA(0, 0), cA, voffA); PG8_STAGE(PG8_SA(0, 1), cA + hstepA, voffA);
    if (wr == 1) PG8_BAR;
    PG8_WAIT_V(2); PG8_BAR;
    PG8_STAGE(PG8_SB(1, 0), cB + kstep, voffB); PG8_STAGE(PG8_SA(1, 0), cA + kstep, voffA); PG8_STAGE(PG8_SB(1, 1), cB + hstepB + kstep, voffB);
    PG8_WAIT_V(6); PG8_BAR;
    for (;;) {
        const bool has_next = S.next(ui + 1, nxt);
        const char* nA = has_next ? (const char*)a_base(g, nxt) + (size_t)nxt.pm * tstepA : cA; const char* nB = has_next ? (const char*)g.Bt + (size_t)nxt.pn * tstepB : cB;
        for (int t = 0; t < nt; t += 2) {
            const bool last = (t == nt - 2);
            const char* a1 = cA + (size_t)(t + 1) * kstep;
            const char* a2 = last ? nA : cA + (size_t)(t + 2) * kstep; const char* b2 = last ? nB : cB + (size_t)(t + 2) * kstep;
            const char* a3 = a2 + kstep; const char* b3 = b2 + kstep;
            PG8_LDB(B0, 0, 0); PG8_LDB(B1, 0, 1); PG8_SCHED; PG8_LDA(At, 0, 0); PG8_STAGE(PG8_SA(1, 1), a1 + hstepA, voffA);
            PG8_WAIT_V(8); PG8_WAIT_L(0); PG8_BAR; PG8_MMA(0, 0, At, B0); PG8_MMA(0, 1, At, B1); PG8_BAR; PG8_SCHED;
            PG8_LDA(At, 0, 1); PG8_STAGE(PG8_SB(0, 0), b2, voffB); PG8_STAGE(PG8_SB(0, 1), b2 + hstepB, voffB); PG8_STAGE(PG8_SA(0, 0), a2, voffA);
            PG8_WAIT_V(8); PG8_WAIT_L(0); PG8_BAR; PG8_MMA(1, 0, At, B0); PG8_MMA(1, 1, At, B1); PG8_BAR; PG8_SCHED;
            PG8_LDB(B0, 1, 0); PG8_LDB(B1, 1, 1); PG8_SCHED; PG8_LDA(At, 1, 0); PG8_STAGE(PG8_SA(0, 1), a2 + hstepA, voffA);
            PG8_WAIT_V(8); PG8_WAIT_L(0); PG8_BAR; PG8_MMA(0, 0, At, B0); PG8_MMA(0, 1, At, B1); PG8_BAR; PG8_SCHED;
            PG8_LDA(At, 1, 1); PG8_STAGE(PG8_SB(1, 0), b3, voffB); PG8_STAGE(PG8_SB(1, 1), b3 + hstepB, voffB); PG8_STAGE(PG8_SA(1, 0), a3, voffA);
            PG8_WAIT_V(8); PG8_WAIT_L(0); PG8_BAR; PG8_MMA(1, 0, At, B0); PG8_MMA(1, 1, At, B1); PG8_BAR; PG8_SCHED;
        }
        if constexpr (ALIGN_EPI) { if (wr == 0) PG8_BAR; }
        { int l2 = lane; asm volatile("" : "+v"(l2)); E(acc, cur, wr, wc, l2 & 15, l2 >> 4); }
        if (!has_next) break;
#pragma unroll
        for (int a = 0; a < 2; ++a)
#pragma unroll
            for (int b = 0; b < 2; ++b)
#pragma unroll
                for (int m = 0; m < 4; ++m)
#pragma unroll
                    for (int n = 0; n < 2; ++n) acc[a][b][m][n] = (f32x4){0.f, 0.f, 0.f, 0.f};
        cur = nxt; cA = nA; cB = nB; ++ui;
        if constexpr (ALIGN_EPI) { if (wr == 1) PG8_BAR; }
    }
    PG8_WAIT_V(0);
    if constexpr (!ALIGN_EPI) { if (wr == 0) PG8_BAR; }
    PG8_BAR;
#undef PG8_SA
#undef PG8_SB
#undef PG8_STAGE
#undef PG8_LDA
#undef PG8_LDB
#undef PG8_MMA
#undef PG8_WAIT_V
#undef PG8_WAIT_L
#undef PG8_BAR
#undef PG8_SCHED
}
}

namespace sba {
using bf16 = __hip_bfloat16;
typedef short bf16x8 __attribute__((ext_vector_type(8)));
typedef short s16x4 __attribute__((ext_vector_type(4)));
typedef float f32x16 __attribute__((ext_vector_type(16)));
typedef float f32x4 __attribute__((ext_vector_type(4)));
typedef unsigned u32x4 __attribute__((ext_vector_type(4)));
constexpr int NW = 8, QBLK = 32, KVBLK = 64, QB = NW * QBLK, D = 128;
constexpr int PIN = 6144, POUT = 2048;
constexpr int SHM_V = KVBLK * D * 2, SHM_K = KVBLK * D * 2;
constexpr int SHM_Q = QBLK * D * 2;
constexpr int LDS_BYTES = 2 * SHM_V + 2 * SHM_K + NW * SHM_Q;

#define KSWZ(row, colB) ((row) * 256 + ((colB) ^ (((row) & 7) << 4)))
#define SBAR() __builtin_amdgcn_sched_barrier(0)
__device__ __forceinline__ int v_st(int k, int c) { const int kk = (k & ~0xC) | ((k & 4) << 1) | ((k & 8) >> 1); return ((kk >> 3) * 4 + (c >> 5)) * 512 + ((kk & 7) * 32 + (c & 31)) * 2; }
__device__ __forceinline__ int v_rd_base(int lane) { return ((lane & 3) << 3) | (((lane >> 2) & 3) << 6) | (((lane >> 4) & 1) << 5) | (((lane >> 5) & 1) << 8); }
constexpr int v_rd_off(int d0, int ks, int half) { return d0 * 512 + ks * 4096 + half * 2048; }
__device__ __forceinline__ int crow(int r, int hi) { return (r & 3) + 8 * (r >> 2) + 4 * hi; }
__device__ __forceinline__ unsigned cvtpk(float lo, float hi) { unsigned r; asm volatile("v_cvt_pk_bf16_f32 %0, %1, %2" : "=v"(r) : "v"(lo), "v"(hi)); return r; }
__device__ __forceinline__ bf16x8 load8(const bf16* p) { return *reinterpret_cast<const bf16x8*>(p); }

__device__ __forceinline__ void mask_tile(f32x16& p0, f32x16& p1, int dq) {
    const float NEG = -__builtin_inff();
#pragma unroll
    for (int r = 0; r < 16; ++r) {
        const int c = (r & 3) + 8 * (r >> 2);
        if (dq - c < 0) p0[r] = NEG;
        if (dq - c - 32 < 0) p1[r] = NEG;
    }
}
__device__ __forceinline__ void partA_half(f32x16& p, float& C, int hi) {
    f32x16 s;
#pragma unroll
    for (int r = 0; r < 16; ++r) {
        const float z = __builtin_fminf(p[r], 60.f);
        s[r] = __builtin_amdgcn_logf(1.0f + __builtin_amdgcn_exp2f(z));
        p[r] = z - s[r];
    }
    float U[4], X[4];
#pragma unroll
    for (int g = 0; g < 4; ++g) { const float T = (s[4 * g] + s[4 * g + 1]) + (s[4 * g + 2] + s[4 * g + 3]);
        auto rr = __builtin_amdgcn_permlane32_swap(__float_as_uint(T), __float_as_uint(T), false, false);
        const float tl = __uint_as_float(rr[0]), th = __uint_as_float(rr[1]); U[g] = tl + th; X[g] = th; }
#pragma unroll
    for (int g = 3; g >= 0; --g) {
        float run = C + (hi == 0 ? X[g] : 0.f);
#pragma unroll
        for (int i = 3; i >= 0; --i) { const float a = p[4 * g + i] - run; run += s[4 * g + i]; p[4 * g + i] = a; }
        C += U[g];
    }
}
__device__ __forceinline__ void partA(f32x16& p0, f32x16& p1, float& Rrun, int hi) { partA_half(p1, Rrun, hi); partA_half(p0, Rrun, hi); }
__device__ __forceinline__ void partB(f32x16& p0, f32x16& p1, bf16x8& pa0, bf16x8& pa1, bf16x8& pa2, bf16x8& pa3) {
#pragma unroll
    for (int r = 0; r < 16; ++r) { p0[r] = __builtin_amdgcn_exp2f(p0[r]); p1[r] = __builtin_amdgcn_exp2f(p1[r]); }
#define PK4(P, B_, OUT) do { unsigned a0 = cvtpk(P[B_+0], P[B_+1]), a1 = cvtpk(P[B_+2], P[B_+3]);                          \
        unsigned b0 = cvtpk(P[B_+4], P[B_+5]), b1 = cvtpk(P[B_+6], P[B_+7]);                                             \
        auto r0 = __builtin_amdgcn_permlane32_swap(a0, b0, false, false); auto r1 = __builtin_amdgcn_permlane32_swap(a1, b1, false, false); \
        u32x4 w = {r0[0], r1[0], r0[1], r1[1]}; OUT = *reinterpret_cast<bf16x8*>(&w); } while (0)
    PK4(p0, 0, pa0); PK4(p0, 8, pa1); PK4(p1, 0, pa2); PK4(p1, 8, pa3);
#undef PK4
}
template <int KB>
__device__ __forceinline__ void qkt(f32x16& p0, f32x16& p1, const char* K_lds, int r32, int hi, const char* Qw_lds, bool act) {
    if (!act) { const float NEG = -__builtin_inff();
#pragma unroll
        for (int r = 0; r < 16; ++r) { p0[r] = NEG; p1[r] = NEG; } return; }
    p0 = f32x16{}; p1 = f32x16{};
    const char* kb[4];
#pragma unroll
    for (int dd = 0; dd < 4; ++dd) kb[dd] = K_lds + KB * SHM_K + KSWZ(r32, (dd * 16 + hi * 8) * 2);
#pragma unroll
    for (int d0 = 0; d0 < 8; ++d0) { const char* a = kb[d0 & 3] + (d0 >> 2) * 128;
        bf16x8 b0 = *reinterpret_cast<const bf16x8*>(a);
        bf16x8 b1 = *reinterpret_cast<const bf16x8*>(a + 32 * 256);
        bf16x8 q = *reinterpret_cast<const bf16x8*>(Qw_lds + (kb[d0 & 3] - (K_lds + KB * SHM_K)) + (d0 >> 2) * 128);
        p0 = __builtin_amdgcn_mfma_f32_32x32x16_bf16(b0, q, p0, 0, 0, 0);
        p1 = __builtin_amdgcn_mfma_f32_32x32x16_bf16(b1, q, p1, 0, 0, 0); }
}
template <int VB>
__device__ __forceinline__ void pv_tile(f32x16* o, int vb0, bf16x8 pa0, bf16x8 pa1, bf16x8 pa2, bf16x8 pa3, bool act) {
    if (!act) return;
#define TRRD(dst, off) asm volatile("ds_read_b64_tr_b16 %0, %1 offset:%2" : "=&v"(dst) : "v"(vb0), "i"(off) : "memory")
#define PV_D0(d0) do { s16x4 l0, l1, l2, l3, h0, h1, h2, h3; constexpr int b_ = VB * SHM_V + v_rd_off(d0, 0, 0); \
        TRRD(l0, b_); TRRD(h0, b_ + 2048); TRRD(l1, b_ + 4096); TRRD(h1, b_ + 6144); TRRD(l2, b_ + 8192); TRRD(h2, b_ + 10240); TRRD(l3, b_ + 12288); TRRD(h3, b_ + 14336); \
        asm volatile("s_waitcnt lgkmcnt(0)" ::: "memory"); SBAR();   \
        o[d0] = __builtin_amdgcn_mfma_f32_32x32x16_bf16(pa0, (bf16x8){l0[0], l0[1], l0[2], l0[3], h0[0], h0[1], h0[2], h0[3]}, o[d0], 0, 0, 0);   \
        o[d0] = __builtin_amdgcn_mfma_f32_32x32x16_bf16(pa1, (bf16x8){l1[0], l1[1], l1[2], l1[3], h1[0], h1[1], h1[2], h1[3]}, o[d0], 0, 0, 0);   \
        o[d0] = __builtin_amdgcn_mfma_f32_32x32x16_bf16(pa2, (bf16x8){l2[0], l2[1], l2[2], l2[3], h2[0], h2[1], h2[2], h2[3]}, o[d0], 0, 0, 0);   \
        o[d0] = __builtin_amdgcn_mfma_f32_32x32x16_bf16(pa3, (bf16x8){l3[0], l3[1], l3[2], l3[3], h3[0], h3[1], h3[2], h3[3]}, o[d0], 0, 0, 0); } while (0)
    PV_D0(0); PV_D0(1); PV_D0(2); PV_D0(3);
#undef PV_D0
#undef TRRD
}

struct BlockRef { const bf16* Q; const bf16* K; const bf16* V; const bf16* G; bf16* O; int P0; };
#define ROW(p, k0, rr) ((p) + (size_t)((k0) + (rr)) * PIN + sc)
#define VMW() asm volatile("s_waitcnt vmcnt(0)" ::: "memory")
#define SLOAD_H(Kp, Vp, k0) do { st_v0 = load8(ROW(Vp, k0, sr)); st_v1 = load8(ROW(Vp, k0, 32 + sr));              \
                         st_k0 = load8(ROW(Kp, k0, sr)); st_k1 = load8(ROW(Kp, k0, 32 + sr)); } while (0)
#define SWRITE_H(bf) do { *(bf16x8*)(V_lds + (bf) * SHM_V + vst0) = st_v0; *(bf16x8*)(V_lds + (bf) * SHM_V + vst1) = st_v1; \
                          *(bf16x8*)(K_lds + (bf) * SHM_K + kws) = st_k0; *(bf16x8*)(K_lds + (bf) * SHM_K + kws + 32 * 256) = st_k1; } while (0)
__device__ __forceinline__ void q_to_lds(const bf16* Q, char* Qw_lds, int wid, int r32, int hi) {
    bf16x8 qr[8];
#pragma unroll
    for (int d0 = 0; d0 < 8; ++d0) qr[d0] = load8(Q + (size_t)(wid * QBLK + r32) * PIN + d0 * 16 + hi * 8);
#pragma unroll
    for (int d0 = 0; d0 < 8; ++d0) *(bf16x8*)(Qw_lds + KSWZ(r32, (d0 * 16 + hi * 8) * 2)) = qr[d0];
}
__device__ __forceinline__ void sb_block(const BlockRef& cur, char* lds) {
    int tid = threadIdx.x; asm volatile("" : "+v"(tid));
    const int wid = __builtin_amdgcn_readfirstlane(tid >> 6), lane = tid & 63, r32 = lane & 31, hi = lane >> 5;
    const int NT = (cur.P0 + QB) / KVBLK;
    const int qlo = cur.P0 + wid * QBLK, qm = qlo + r32 - 1 - 4 * hi;
    char* V_lds = lds; char* K_lds = lds + 2 * SHM_V; char* Qw_lds = lds + 2 * SHM_V + 2 * SHM_K + wid * SHM_Q;
    float Rrun = 0.f; f32x16 o[4] = {};
    const int sr = tid >> 4, sc = (tid & 15) * 8, vst0 = v_st(sr, sc), vst1 = v_st(32 + sr, sc), kws = KSWZ(sr, sc * 2);
    const int vb0 = (int)(uintptr_t)V_lds + v_rd_base(lane);
    const bf16* Kh = cur.K; const bf16* Vh = cur.V;
    bf16x8 st_v0, st_v1, st_k0, st_k1;
#define KBASE(t) ((NT - 1 - (t)) * KVBLK)
#define ACT(t) (KBASE(t) <= qlo + QBLK - 2)
#define MASKT(P0_, P1_, t) do { const int kb_ = KBASE(t); if (ACT(t) && (kb_ + KVBLK - 1 > qlo - 1)) mask_tile(P0_, P1_, qm - kb_); } while (0)
    q_to_lds(cur.Q, Qw_lds, wid, r32, hi);
    SLOAD_H(Kh, Vh, KBASE(0)); VMW(); SWRITE_H(0);
    __syncthreads();
    f32x16 p0, p1; bf16x8 pa0, pa1, pa2, pa3;
#define STEP(t, BF) do {                                                                                   \
        if ((t) + 1 < NT) { SLOAD_H(Kh, Vh, KBASE((t) + 1)); }                                              \
        SBAR(); qkt<BF>(p0, p1, K_lds, r32, hi, Qw_lds, ACT(t));                                          \
        MASKT(p0, p1, (t)); partA(p0, p1, Rrun, hi); partB(p0, p1, pa0, pa1, pa2, pa3); SBAR();               \
        pv_tile<BF>(o, vb0, pa0, pa1, pa2, pa3, ACT(t));                                                     \
        if ((t) + 1 < NT) { VMW(); SWRITE_H(1 - BF); }                                                       \
        __syncthreads(); } while (0)
    for (int t = 0; t < NT; t += 2) { STEP(t, 0); STEP(t + 1, 1); }
    {
        bf16* Ow = cur.O + (size_t)(wid * QBLK) * POUT; const bf16* Gw = cur.G + (size_t)(wid * QBLK) * PIN;
#pragma unroll
        for (int r = 0; r < 16; ++r) { const int orow = crow(r, hi);
#pragma unroll
            for (int d0 = 0; d0 < 4; ++d0) { const float gv = __bfloat162float(Gw[(size_t)orow * PIN + d0 * 32 + r32]); const float v = o[d0][r] * gv;
                const float vn = __shfl_xor(v, 1);
                if ((r32 & 1) == 0) *(unsigned*)(Ow + (size_t)orow * POUT + d0 * 32 + r32) = cvtpk(v, vn); }
            asm volatile("" ::: "memory"); }
    }
#undef KBASE
#undef ACT
#undef MASKT
#undef STEP
}
#undef ROW
#undef VMW
#undef SLOAD_H
#undef SWRITE_H
#undef KSWZ
#undef SBAR
}

constexpr int NWAVES = 8;
constexpr int N_LAUNCHES = MK_N_LAUNCHES;
constexpr int N_PHASES = 12;
constexpr int BATCH = 4, SEQ = 4096, DM = 2048, M = BATCH * SEQ, MH = M / 2;
constexpr int EVEN_IN = 6144;
constexpr float LN_EPS = 1e-5f, GN_EPS = 64e-5f;
constexpr float ALPHA = 1.4142135623730951f;
constexpr int N2CAT = 4 * DM + 512;

constexpr size_t MiB = 1u << 20;
constexpr size_t WS_CTL = 0, CTL_ZERO_BYTES = 1 * MiB;
constexpr size_t WS_W2CAT = 1 * MiB, WS_WOT = 35 * MiB, WS_L2T = 43 * MiB, WS_STATS = 45 * MiB, WS_D = 46 * MiB;
constexpr size_t WS_WINT = WS_D, WS_WOUTT = WS_D + 24 * MiB, WS_WPOOLT = WS_D + 32 * MiB, WS_XB = WS_D + 33 * MiB, WS_MIX = WS_XB, WS_H = WS_D + 97 * MiB, WS_POOLED = WS_D + 289 * MiB;
constexpr size_t WS_XMIX = WS_D, WS_LOGW = WS_D, WS_AA = WS_D + 64 * MiB, WS_OG = WS_D + 128 * MiB;
constexpr size_t WS_R = WS_D + 192 * MiB, WS_TL = WS_D + 448 * MiB, WS_END = WS_D + 456 * MiB;
static_assert(WS_POOLED + 32 * MiB <= WS_END && WS_END <= 512 * MiB, "d_ws map");
constexpr int CW_TMO = 0, CW_CODE = 1, CW_BAR = 4096;

constexpr int RING_OFF = 0, RING_BYTES = 131072;
constexpr int LDSCTL_OFF = RING_BYTES, MISC_OFF = LDSCTL_OFF + 320;
constexpr int LDS_BYTES = 147456;

#define GAS __attribute__((address_space(1)))
#define LAS __attribute__((address_space(3)))
typedef unsigned short bf16;
typedef unsigned v4u __attribute__((ext_vector_type(4)));
typedef unsigned v2u __attribute__((ext_vector_type(2)));
typedef float f32x4 __attribute__((ext_vector_type(4)));
typedef GAS unsigned gu32;
#define RLX_AGENT __ATOMIC_RELAXED, __HIP_MEMORY_SCOPE_AGENT
#define LDS_WAIT() asm volatile("s_waitcnt lgkmcnt(0)" ::: "memory")
#define VM_WAIT() asm volatile("s_waitcnt vmcnt(0)" ::: "memory")
__device__ __forceinline__ unsigned f2bf(float f) { unsigned u = __builtin_bit_cast(unsigned, f); return (u + 0x7fffu + ((u >> 16) & 1u)) >> 16; }
__device__ __forceinline__ unsigned pk2(float lo, float hi) { return f2bf(lo) | (f2bf(hi) << 16); }
__device__ __forceinline__ float bflo(unsigned w) { return __uint_as_float(w << 16); }
__device__ __forceinline__ float bfhi(unsigned w) { return __uint_as_float(w & 0xffff0000u); }

#define XB_TMO      128
#define XB_XCNT(j)  (256  + 64 * (j))
#define XB_XSUB(j)  (1280 + 64 * (j))
#define XB_XGEN(j)  (2304 + 64 * (j))
#define XB_TOP      3328
#define XB_TOPGEN   3392
#define XCD_BAR_WORDS 3456
#define XB_SPIN_CAP (1u << 23)
__device__ __forceinline__ unsigned xb_ld(unsigned* p)              { return __hip_atomic_load(p, __ATOMIC_RELAXED, __HIP_MEMORY_SCOPE_AGENT); }
__device__ __forceinline__ unsigned xb_add(unsigned* p, unsigned v) { return __hip_atomic_fetch_add(p, v, __ATOMIC_RELAXED, __HIP_MEMORY_SCOPE_AGENT); }
__device__ __forceinline__ unsigned xb_xcc_id() { return (unsigned)__builtin_amdgcn_s_getreg((3 << 11) | 20) & 0xFu; }
#define XB_SPIN(cond, bar) do { unsigned _sp = 0; while (cond) { __builtin_amdgcn_s_sleep(1); \
    if ((++_sp & 255u) == 0u) { if (xb_ld(&(bar)[XB_TMO])) break; if (_sp > XB_SPIN_CAP) { atomicAdd(&(bar)[XB_TMO], 1u); break; } } } } while (0)
struct XcdBarrier { unsigned* bar; unsigned x; volatile LAS unsigned* st; };
__device__ __forceinline__ XcdBarrier xcd_barrier_post(unsigned* bar, volatile LAS unsigned* st) {
    XcdBarrier b; b.bar = bar; b.x = xb_xcc_id(); b.st = st;
    if (threadIdx.x == 0) (void)xb_add(&bar[XB_XCNT(b.x)], 1u);
    return b;
}
__device__ __forceinline__ void xcd_barrier_complete(unsigned* bar, unsigned x, unsigned& nloc, unsigned& nx) {
    const unsigned G = gridDim.x * gridDim.y * gridDim.z;
    unsigned sum, cnt, mine, sp = 0u;
    for (;;) {
        sum = 0u; cnt = 0u; mine = 0u;
#pragma unroll
        for (unsigned j = 0; j < 16; ++j) { const unsigned c = xb_ld(&bar[XB_XCNT(j)]); sum += c; cnt += (c > 0u) ? 1u : 0u; mine = (j == x) ? c : mine; }
        if (sum == G) break;
        __builtin_amdgcn_s_sleep(1);
        if ((++sp & 255u) == 0u) { if (xb_ld(&bar[XB_TMO])) break; if (sp > XB_SPIN_CAP) { atomicAdd(&bar[XB_TMO], 1u); break; } }
    }
    nloc = mine > 0u ? mine : 1u; nx = cnt > 0u ? cnt : 1u;
}
__device__ __forceinline__ void xcd_barrier(const XcdBarrier& b) {
    asm volatile("s_waitcnt vmcnt(0)" ::: "memory");
    __syncthreads();
    if (threadIdx.x == 0) {
        unsigned* bar = b.bar;
        __builtin_amdgcn_s_waitcnt(0);
        unsigned nloc = b.st[0], nx = b.st[1];
        if (nloc == 0u) { xcd_barrier_complete(bar, b.x, nloc, nx); b.st[0] = nloc; b.st[1] = nx; }
        const unsigned old = xb_add(&bar[XB_XSUB(b.x)], 1u);
        const unsigned gen = old / nloc;
        if (old + 1u == (gen + 1u) * nloc) {
            __builtin_amdgcn_fence(__ATOMIC_RELEASE, "agent");
            asm volatile("s_waitcnt vmcnt(0)" ::: "memory");
            const unsigned og = xb_add(&bar[XB_TOP], 1u);
            const unsigned tg = og / nx;
            if (og + 1u == (tg + 1u) * nx) xb_add(&bar[XB_TOPGEN], 1u);
            else XB_SPIN(xb_ld(&bar[XB_TOPGEN]) == tg, bar);
            __builtin_amdgcn_fence(__ATOMIC_ACQUIRE, "agent");
            xb_add(&bar[XB_XGEN(b.x)], 1u);
            asm volatile("s_waitcnt vmcnt(0)" ::: "memory");
        } else {
            XB_SPIN(xb_ld(&bar[XB_XGEN(b.x)]) == gen, bar);
            __builtin_amdgcn_fence(__ATOMIC_ACQUIRE, "agent");
            asm volatile("s_waitcnt vmcnt(0)" ::: "memory");
        }
    }
    __syncthreads();
}

struct Frame {
    LAS unsigned char* lds;
    volatile LAS unsigned* MISC;
    gu32* ctl;
    int vcu, G;
};
#define PHASE_TID() int tid_ = threadIdx.x; asm volatile("" : "+v"(tid_)); const int tid = tid_, lane = tid & 63, wave = __builtin_amdgcn_readfirstlane(tid >> 6); (void)lane; (void)wave
__device__ __forceinline__ float wave_sum(float v) {
#pragma unroll
    for (int o = 1; o < 64; o <<= 1) v += __shfl_xor(v, o);
    return v;
}
__device__ __forceinline__ void p0_transpose_item(const float* W, int N, bf16* WT, int ldwt, int row_off, LAS float* scr, int item, int lane) {
    const int nblk = N / 32, kb = item / nblk, nb = item % nblk, k0 = 64 * kb, n0 = 32 * nb;
#pragma unroll 8
    for (int i = 0; i < 32; ++i) { const int kk = 2 * i + (lane >> 5); scr[kk * 33 + (lane & 31)] = W[(size_t)(k0 + kk) * N + n0 + (lane & 31)]; }
    LDS_WAIT(); asm volatile("" ::: "memory");
    const int c = lane & 7;
#pragma unroll
    for (int j = 0; j < 4; ++j) { const int n = (lane >> 3) + 8 * j; const LAS float* s = scr + (8 * c) * 33 + n;
        v4u o; o.x = pk2(s[0 * 33], s[1 * 33]); o.y = pk2(s[2 * 33], s[3 * 33]); o.z = pk2(s[4 * 33], s[5 * 33]); o.w = pk2(s[6 * 33], s[7 * 33]);
        *(GAS v4u*)(WT + (size_t)(row_off + n0 + n) * ldwt + k0 + 8 * c) = o; }
    LDS_WAIT(); asm volatile("" ::: "memory");
}

struct Args { const float* in[24]; float* out; unsigned char* ws; int ph_lo, ph_hi, li, pad; };

__device__ __forceinline__ void p0_prologue(Frame& F, const Args& a) {
    PHASE_TID();
    unsigned char* ws = a.ws;
    LAS float* scr = (LAS float*)(F.lds + RING_OFF + wave * 16384);
    const int gw = F.vcu * NWAVES + wave, NGW = F.G * NWAVES;
    bf16* WINT = (bf16*)(ws + WS_WINT); bf16* WOUTT = (bf16*)(ws + WS_WOUTT); bf16* WPOOLT = (bf16*)(ws + WS_WPOOLT); bf16* W2CAT = (bf16*)(ws + WS_W2CAT); bf16* WOT = (bf16*)(ws + WS_WOT);
    constexpr int I_IN = (DM / 64) * (EVEN_IN / 32), I_SQ = (DM / 64) * (DM / 32), I_POOL = (256 / 64) * (256 / 32), I_LORA = (DM / 64) * (96 / 32);
    constexpr int NITEMS = I_IN + 6 * I_SQ + 4 * I_POOL + 2 * I_LORA;
    for (int it = gw; it < NITEMS; it += NGW) {
        int r = it;
        if (r < I_IN) { p0_transpose_item(a.in[1], EVEN_IN, WINT, DM, 0, scr, r, lane); continue; } r -= I_IN;
        if (r < I_SQ) { p0_transpose_item(a.in[4], DM, WOUTT, DM, 0, scr, r, lane); continue; } r -= I_SQ;
        if (r < 4 * I_SQ) { const int w = r / I_SQ; p0_transpose_item(a.in[6 + w], DM, W2CAT, DM, w * DM, scr, r % I_SQ, lane); continue; } r -= 4 * I_SQ;
        if (r < I_SQ) { p0_transpose_item(a.in[21], DM, WOT, DM, 0, scr, r, lane); continue; } r -= I_SQ;
        if (r < 4 * I_POOL) { const int g = r / I_POOL; p0_transpose_item(a.in[2] + (size_t)g * 65536, 256, WPOOLT + (size_t)g * 65536, 256, 0, scr, r % I_POOL, lane); continue; } r -= 4 * I_POOL;
        if (r < I_LORA) { p0_transpose_item(a.in[11], 96, W2CAT, DM, 4 * DM, scr, r, lane); continue; } r -= I_LORA;
        p0_transpose_item(a.in[14], 96, W2CAT, DM, 4 * DM + 256, scr, r, lane);
    }
    const int gt = F.vcu * (NWAVES * 64) + tid, NGT = F.G * NWAVES * 64;
    for (int i = gt; i < 2 * 160 * (DM / 8); i += NGT) { const int blk = i / (160 * (DM / 8)), rr = (i / (DM / 8)) % 160, c8 = i % (DM / 8);
        *(GAS v4u*)(W2CAT + (size_t)(4 * DM + blk * 256 + 96 + rr) * DM + c8 * 8) = (v4u){0u, 0u, 0u, 0u}; }
    { bf16* L2T = (bf16*)(ws + WS_L2T); const float* w2 = a.in[12]; const float* a2 = a.in[15];
      for (int i = gt; i < 4096 * 32; i += NGT) { const int n = i % 4096, c8 = i / 4096; const int k0 = c8 * 8; float v[8];
#pragma unroll
          for (int e = 0; e < 8; ++e) { const int k = k0 + e; float x = 0.f;
              if (n < 2048) { if (k < 96) x = w2[(size_t)k * DM + n]; } else { if (k >= 96 && k < 192) x = a2[(size_t)(k - 96) * DM + (n - 2048)]; }
              v[e] = x; }
          *(GAS v4u*)(L2T + (size_t)n * 256 + k0) = (v4u){pk2(v[0], v[1]), pk2(v[2], v[3]), pk2(v[4], v[5]), pk2(v[6], v[7])}; } }
    { const float* x = a.in[0]; bf16* XB = (bf16*)(ws + WS_XB);
      for (size_t i = gt; i < (size_t)M * DM / 8; i += NGT) { const f32x4 u0 = *(const GAS f32x4*)(x + i * 8), u1 = *(const GAS f32x4*)(x + i * 8 + 4);
          *(GAS v4u*)(XB + i * 8) = (v4u){pk2(u0.x, u0.y), pk2(u0.z, u0.w), pk2(u1.x, u1.y), pk2(u1.z, u1.w)}; } }
}

__device__ __forceinline__ void pool_tile(Frame& F, const bf16* Hb, bf16* POOLED, int pm, int g) {
    PHASE_TID();
    const int win = 2 << g;
    const int c4 = (tid & 63) * 4, rw = tid >> 6;
    const float inv_full = 1.0f / (float)win;
    for (int rr = 0; rr < 32; ++rr) {
        const int row = pm * 256 + rw * 32 + rr, t = row & (SEQ - 1);
        const int cnt = (t + 1) < win ? (t + 1) : win;
        float s0 = 0.f, s1 = 0.f, s2 = 0.f, s3 = 0.f; v2u cur = {0u, 0u};
        for (int i = 0; i < cnt; ++i) { const v2u w = *(const GAS v2u*)(Hb + (size_t)(row - i) * 6144 + 4096 + g * 256 + c4);
            if (i == 0) cur = w;
            s0 += bflo(w.x); s1 += bfhi(w.x); s2 += bflo(w.y); s3 += bfhi(w.y); }
        const float inv = (cnt == win) ? inv_full : 1.0f / (float)cnt;
        const float o0 = s0 * inv - bflo(cur.x), o1 = s1 * inv - bfhi(cur.x), o2 = s2 * inv - bflo(cur.y), o3 = s3 * inv - bfhi(cur.y);
        *(GAS v2u*)(POOLED + (size_t)row * 1024 + g * 256 + c4) = (v2u){pk2(o0, o1), pk2(o2, o3)};
    }
}

__device__ __forceinline__ void ln_mix_phase(Frame& F, const Args& a, int half) {
    const float* Z = a.out; float* stats = (float*)(a.ws + WS_STATS); bf16* XMIX = (bf16*)(a.ws + WS_XMIX);
    const float* lg = a.in[22]; const float* lb = a.in[23]; const float* mu = a.in[5];
    PHASE_TID();
    const int gw = F.vcu * NWAVES + wave, NGW = F.G * NWAVES;
    constexpr int STRIP = 4;
    for (int sidx = gw; sidx < MH / STRIP; sidx += NGW) {
        const int r0 = half * MH + sidx * STRIP;
        f32x4 prev[8];
        if ((r0 & (SEQ - 1)) == 0) {
#pragma unroll
            for (int j = 0; j < 8; ++j) prev[j] = (f32x4){0.f, 0.f, 0.f, 0.f};
        } else {
            const GAS f32x4* zr = (const GAS f32x4*)(Z + (size_t)(r0 - 1) * DM) + lane; float s = 0.f;
#pragma unroll
            for (int j = 0; j < 8; ++j) { prev[j] = zr[64 * j]; s += (prev[j].x + prev[j].y) + (prev[j].z + prev[j].w); }
            const float mean = wave_sum(s) * (1.f / DM); float s2 = 0.f;
#pragma unroll
            for (int j = 0; j < 8; ++j) { prev[j] = prev[j] - mean; s2 += (prev[j].x * prev[j].x + prev[j].y * prev[j].y) + (prev[j].z * prev[j].z + prev[j].w * prev[j].w); }
            const float rstd = 1.f / sqrtf(wave_sum(s2) * (1.f / DM) + LN_EPS);
#pragma unroll
            for (int j = 0; j < 8; ++j) { const f32x4 gv = *(const f32x4*)(lg + 4 * lane + 256 * j), bv = *(const f32x4*)(lb + 4 * lane + 256 * j); prev[j] = prev[j] * rstd * gv + bv; asm volatile("" ::: "memory"); }
        }
        for (int rr = 0; rr < STRIP; ++rr) {
            const int row = r0 + rr;
            const GAS f32x4* zr = (const GAS f32x4*)(Z + (size_t)row * DM) + lane; f32x4 v[8]; float s = 0.f;
#pragma unroll
            for (int j = 0; j < 8; ++j) { v[j] = zr[64 * j]; s += (v[j].x + v[j].y) + (v[j].z + v[j].w); }
            const float mean = wave_sum(s) * (1.f / DM); float s2 = 0.f;
#pragma unroll
            for (int j = 0; j < 8; ++j) { v[j] = v[j] - mean; s2 += (v[j].x * v[j].x + v[j].y * v[j].y) + (v[j].z * v[j].z + v[j].w * v[j].w); }
            const float rstd = 1.f / sqrtf(wave_sum(s2) * (1.f / DM) + LN_EPS);
            if (lane == 0) { stats[2 * row] = mean; stats[2 * row + 1] = rstd; }
            const size_t orow = (size_t)(row - half * MH) * DM;
#pragma unroll
            for (int j = 0; j < 8; ++j) { { const f32x4 gv = *(const f32x4*)(lg + 4 * lane + 256 * j), bv = *(const f32x4*)(lb + 4 * lane + 256 * j); v[j] = v[j] * rstd * gv + bv; }
                const f32x4 xx = prev[j] - v[j];
#pragma unroll
                for (int q = 0; q < 6; ++q) { const int mrow = (q == 0) ? 0 : (q == 1) ? 2 : (q == 2) ? 3 : (q == 3) ? 5 : (q == 4) ? 1 : 4;
                    const f32x4 mv = *(const f32x4*)(mu + (size_t)mrow * DM + 4 * lane + 256 * j); const f32x4 o = v[j] + xx * mv;
                    *(GAS v2u*)(XMIX + (size_t)q * MH * DM + orow + 4 * lane + 256 * j) = (v2u){pk2(o.x, o.y), pk2(o.z, o.w)}; }
                prev[j] = v[j]; asm volatile("" ::: "memory"); }
        }
    }
}
__device__ __forceinline__ void final_ln_phase(Frame& F, const Args& a) {
    float* Z = a.out; const float* lg = a.in[22] + DM; const float* lb = a.in[23] + DM;
    PHASE_TID();
    const int gw = F.vcu * NWAVES + wave, NGW = F.G * NWAVES;
    for (int row = gw; row < M; row += NGW) {
        GAS f32x4* zr = (GAS f32x4*)(Z + (size_t)row * DM) + lane; f32x4 v[8]; float s = 0.f;
#pragma unroll
        for (int j = 0; j < 8; ++j) { v[j] = zr[64 * j]; s += (v[j].x + v[j].y) + (v[j].z + v[j].w); }
        const float mean = wave_sum(s) * (1.f / DM); float s2 = 0.f;
#pragma unroll
        for (int j = 0; j < 8; ++j) { v[j] = v[j] - mean; s2 += (v[j].x * v[j].x + v[j].y * v[j].y) + (v[j].z * v[j].z + v[j].w * v[j].w); }
        const float rstd = 1.f / sqrtf(wave_sum(s2) * (1.f / DM) + LN_EPS);
#pragma unroll
        for (int j = 0; j < 8; ++j) { const f32x4 gv = *(const f32x4*)(lg + 4 * lane + 256 * j), bv = *(const f32x4*)(lb + 4 * lane + 256 * j); zr[64 * j] = v[j] * rstd * gv + bv; }
    }
}

__device__ __forceinline__ float dpp_sum8(float v) {
    v += __builtin_bit_cast(float, __builtin_amdgcn_update_dpp(0, __builtin_bit_cast(int, v), 0xB1, 0xf, 0xf, false));
    v += __builtin_bit_cast(float, __builtin_amdgcn_update_dpp(0, __builtin_bit_cast(int, v), 0x4E, 0xf, 0xf, false));
    v += __builtin_bit_cast(float, __builtin_amdgcn_update_dpp(0, __builtin_bit_cast(int, v), 0x141, 0xf, 0xf, false));
    return v;
}
__device__ __forceinline__ float h2f(unsigned short h) { return (float)__builtin_bit_cast(_Float16, h); }
__device__ __forceinline__ void scan_phase(Frame& F, const Args& a) {
    const bf16* Rb = (const bf16*)(a.ws + WS_R); const bf16* Kb = Rb + (size_t)M * DM; const bf16* Vb = Kb + (size_t)M * DM; const bf16* SGb = Vb + (size_t)M * DM;
    const unsigned short* LOGW = (const unsigned short*)(a.ws + WS_LOGW); const unsigned short* AA = (const unsigned short*)(a.ws + WS_AA); bf16* OG = (bf16*)(a.ws + WS_OG);
    const float* k_k = a.in[16]; const float* k_a = a.in[17]; const float* r_k = a.in[18]; const float* gn_w = a.in[19]; const float* gn_b = a.in[20];
    LAS float* LW = (LAS float*)(F.lds);
    LAS float* LKK = LW + 4096; LAS float* LB = LKK + 4096; LAS float* LK = LB + 4096; LAS float* LR = LK + 4096; LAS float* LV = LR + 4096; LAS float* LO = LV + 4096;
    PHASE_TID();
    const int ti = tid >> 3, cg = tid & 7;
    for (int bh = F.vcu; bh < BATCH * 32; bh += F.G) {
        const int b = bh >> 5, h = bh & 31;
        float S[8];
#pragma unroll
        for (int c = 0; c < 8; ++c) S[c] = 0.f;
        float kkv[8], kav[8], rkv[8];
#pragma unroll
        for (int c = 0; c < 8; ++c) { kkv[c] = k_k[h * 64 + cg * 8 + c]; kav[c] = k_a[h * 64 + cg * 8 + c]; rkv[c] = r_k[h * 64 + cg * 8 + c]; }
        for (int blk = 0; blk < SEQ / 64; ++blk) {
            const size_t grow = (size_t)(b * SEQ + blk * 64 + ti) * DM + h * 64 + cg * 8;
            const v4u rw = *(const GAS v4u*)(Rb + grow), kw = *(const GAS v4u*)(Kb + grow), vw = *(const GAS v4u*)(Vb + grow), lw = *(const GAS v4u*)(LOGW + grow), aw = *(const GAS v4u*)(AA + grow);
            float r8[8], k8[8], v8[8], w8[8], a8[8];
            { const unsigned rr[4] = {rw.x, rw.y, rw.z, rw.w}, kk_[4] = {kw.x, kw.y, kw.z, kw.w}, vv[4] = {vw.x, vw.y, vw.z, vw.w}, ll[4] = {lw.x, lw.y, lw.z, lw.w}, aa[4] = {aw.x, aw.y, aw.z, aw.w};
#pragma unroll
              for (int e = 0; e < 4; ++e) { r8[2 * e] = bflo(rr[e]); r8[2 * e + 1] = bfhi(rr[e]); k8[2 * e] = bflo(kk_[e]); k8[2 * e + 1] = bfhi(kk_[e]); v8[2 * e] = bflo(vv[e]); v8[2 * e + 1] = bfhi(vv[e]);
                  w8[2 * e] = h2f((unsigned short)(ll[e] & 0xffffu)); w8[2 * e + 1] = h2f((unsigned short)(ll[e] >> 16)); a8[2 * e] = h2f((unsigned short)(aa[e] & 0xffffu)); a8[2 * e + 1] = h2f((unsigned short)(aa[e] >> 16)); } }
            float kk8[8], ss = 0.f;
#pragma unroll
            for (int c = 0; c < 8; ++c) { kk8[c] = k8[c] * kkv[c]; ss += kk8[c] * kk8[c]; }
            ss = dpp_sum8(ss);
            const float inv = 1.0f / fmaxf(sqrtf(ss), 1e-12f);
            __syncthreads();
#pragma unroll
            for (int c = 0; c < 8; ++c) { const int o = ti * 64 + cg * 8 + c; const float kkn = kk8[c] * inv;
                LW[o] = __builtin_amdgcn_exp2f(1.4426950408889634f * w8[c]); LKK[o] = kkn; LB[o] = kkn * a8[c]; LK[o] = k8[c] * (1.0f + (a8[c] - 1.0f) * kav[c]); LR[o] = r8[c]; LV[o] = v8[c]; }
            __syncthreads();
            for (int t = 0; t < 64; ++t) {
                const LAS float* pw = LW + t * 64 + cg * 8; const LAS float* pkk = LKK + t * 64 + cg * 8; const LAS float* pb = LB + t * 64 + cg * 8; const LAS float* pk = LK + t * 64 + cg * 8; const LAS float* pr = LR + t * 64 + cg * 8;
                const f32x4 w0 = *(const LAS f32x4*)pw, w1 = *(const LAS f32x4*)(pw + 4), q0 = *(const LAS f32x4*)pkk, q1 = *(const LAS f32x4*)(pkk + 4), b0 = *(const LAS f32x4*)pb, b1 = *(const LAS f32x4*)(pb + 4);
                const f32x4 k0 = *(const LAS f32x4*)pk, k1 = *(const LAS f32x4*)(pk + 4), r0 = *(const LAS f32x4*)pr, r1 = *(const LAS f32x4*)(pr + 4);
                const float vi = LV[t * 64 + ti];
                float sa = 0.f;
#pragma unroll
                for (int c = 0; c < 4; ++c) { sa += S[c] * q0[c]; sa += S[4 + c] * q1[c]; }
                sa = -dpp_sum8(sa);
                float oo = 0.f;
#pragma unroll
                for (int c = 0; c < 4; ++c) { S[c] = S[c] * w0[c] + sa * b0[c] + vi * k0[c]; S[4 + c] = S[4 + c] * w1[c] + sa * b1[c] + vi * k1[c]; oo += S[c] * r0[c]; oo += S[4 + c] * r1[c]; }
                oo = dpp_sum8(oo);
                if (cg == 0) LO[t * 64 + ti] = oo;
            }
            __syncthreads();
            {
                float o8[8], s = 0.f;
#pragma unroll
                for (int c = 0; c < 8; ++c) { o8[c] = LO[ti * 64 + cg * 8 + c]; s += o8[c]; }
                const float mean = dpp_sum8(s) * (1.f / 64.f); float s2 = 0.f;
#pragma unroll
                for (int c = 0; c < 8; ++c) { o8[c] -= mean; s2 += o8[c] * o8[c]; }
                const float rstd = 1.0f / sqrtf(dpp_sum8(s2) * (1.f / 64.f) + GN_EPS);
                float bs = 0.f;
#pragma unroll
                for (int c = 0; c < 8; ++c) bs += LR[ti * 64 + cg * 8 + c] * LK[ti * 64 + cg * 8 + c] * rkv[c];
                bs = dpp_sum8(bs);
                const v4u sg = *(const GAS v4u*)(SGb + grow); const unsigned sgw[4] = {sg.x, sg.y, sg.z, sg.w}; float res[8];
#pragma unroll
                for (int c = 0; c < 8; ++c) { const int col = h * 64 + cg * 8 + c; const float gate = (c & 1) ? bfhi(sgw[c >> 1]) : bflo(sgw[c >> 1]);
                    res[c] = (o8[c] * rstd * gn_w[col] + gn_b[col] + bs * v8[c]) * gate; }
                *(GAS v4u*)(OG + grow) = (v4u){pk2(res[0], res[1]), pk2(res[2], res[3]), pk2(res[4], res[5]), pk2(res[6], res[7])};
            }
        }
        __syncthreads();
    }
}

__global__ void __launch_bounds__(NWAVES * 64, 2) fwd_kernel(Args args) {
    extern __shared__ __attribute__((aligned(16))) unsigned char lds[];
    Frame F;
    F.lds = (LAS unsigned char*)lds;
    F.MISC = (volatile LAS unsigned*)(F.lds + MISC_OFF);
    F.G = gridDim.x; { const int bx = blockIdx.x; F.vcu = (F.G % 8 == 0) ? (bx % 8) * (F.G / 8) + bx / 8 : bx; }
    unsigned char* ws = args.ws;
    F.ctl = (gu32*)(ws + WS_CTL);
    for (int u = threadIdx.x; u < (LDS_BYTES - LDSCTL_OFF) / 4; u += NWAVES * 64) ((LAS unsigned*)(F.lds + LDSCTL_OFF))[u] = 0u;
    __syncthreads();
    XcdBarrier bar; bar.bar = (unsigned*)(F.ctl + CW_BAR); bar.x = 0; bar.st = nullptr;
    if (N_LAUNCHES == 1) bar = xcd_barrier_post((unsigned*)(F.ctl + CW_BAR), F.MISC + 8);
#define GRID_BAR() do { if (N_LAUNCHES == 1) xcd_barrier(bar); } while (0)
    const int lo = args.ph_lo, hi = args.ph_hi;
#ifndef PH_MASK
#define PH_MASK 0xFFF
#endif
#define IN(k) ((((PH_MASK) >> (k)) & 1) && lo <= (k) && (k) < hi)
#define BOTH(k) (IN(k) && IN((k) + 1))
    bf16* H = (bf16*)(ws + WS_H); bf16* MIX = (bf16*)(ws + WS_MIX);

    if (IN(0)) { p0_prologue(F, args); if (BOTH(0)) GRID_BAR(); }

    if (IN(1)) {
        pg8::Gemm g{(const bf16*)(ws + WS_XB), (const bf16*)(ws + WS_WINT), M, EVEN_IN, DM, DM, DM, 0, 0};
        pg8::StaticOrder S; S.init(M, EVEN_IN, F.G, (int)blockIdx.x);
        pg8::EpiH E{H};
        pg8::gemm_phase<pg8::EpiH, pg8::StaticOrder>(F.lds + RING_OFF, g, S, E);
        if (BOTH(1)) GRID_BAR();
    }

    if (IN(2)) {
#ifndef NO_POOL
        {
            pg8::StaticOrder SO; SO.init(M, 1024, F.G, (int)blockIdx.x); pg8::Unit u;
            bf16* POOLED = (bf16*)(ws + WS_POOLED);
            for (int i = 0; SO.next(i, u); ++i) {
                pool_tile(F, H, POOLED, u.pm, u.pn);
                VM_WAIT(); __syncthreads();
                if (threadIdx.x == 0) { __builtin_amdgcn_fence(__ATOMIC_RELEASE, "agent"); __builtin_amdgcn_fence(__ATOMIC_ACQUIRE, "agent"); VM_WAIT(); }
                __syncthreads();
                pg8::Gemm g{POOLED, (const bf16*)(ws + WS_WPOOLT), M, 1024, 256, 1024, 256, 1, 256};
                pg8::OneUnit S1{u};
                pg8::EpiPool E{MIX, H, args.in[3]};
                pg8::gemm_phase<pg8::EpiPool, pg8::OneUnit>(F.lds + RING_OFF, g, S1, E);
            }
        }
#endif
#ifndef NO_ATTN
        {
            const sba::bf16* Hb = (const sba::bf16*)H; sba::bf16* Mb = (sba::bf16*)MIX;
            for (int item = F.vcu; item < 256; item += F.G) {
                const int bh = item >> 3, x = item & 7, b = bh >> 3, h = bh & 7;
                const size_t rowbase = (size_t)b * SEQ;
                const sba::bf16* Kp = Hb + rowbase * 6144 + 1024 + h * 128; const sba::bf16* Vp = Hb + rowbase * 6144 + 2048 + h * 128;
#pragma unroll 1
                for (int pass = 0; pass < 2; ++pass) {
                    const int qb = pass ? 15 - x : x; sba::BlockRef br;
                    br.P0 = qb * 256; br.Q = Hb + (rowbase + br.P0) * 6144 + h * 128; br.K = Kp; br.V = Vp; br.G = Hb + (rowbase + br.P0) * 6144 + 3072 + h * 128; br.O = Mb + (rowbase + br.P0) * 2048 + h * 128;
                    sba::sb_block(br, (char*)lds + RING_OFF);
                }
            }
        }
#endif
        if (BOTH(2)) GRID_BAR();
    }

    if (IN(3)) {
        pg8::Gemm g{MIX, (const bf16*)(ws + WS_WOUTT), M, DM, DM, DM, DM, 0, 0};
        pg8::StaticOrder S; S.init(M, DM, F.G, (int)blockIdx.x);
        pg8::EpiZ E{args.in[0], args.out, ALPHA};
        pg8::gemm_phase<pg8::EpiZ, pg8::StaticOrder>(F.lds + RING_OFF, g, S, E);
        if (BOTH(3)) GRID_BAR();
    }

#pragma unroll 1
    for (int half = 0; half < 2; ++half) {
        if (IN(4 + 2 * half)) { ln_mix_phase(F, args, half); if (BOTH(4 + 2 * half)) GRID_BAR(); }
        if (IN(5 + 2 * half)) {
            pg8::Gemm g{(const bf16*)(ws + WS_XMIX), (const bf16*)(ws + WS_W2CAT), MH, N2CAT, DM, DM, DM, 2, (size_t)MH * DM};
            pg8::StaticOrder S; S.init(MH, N2CAT, F.G, (int)blockIdx.x);
            pg8::Epi5 E{(bf16*)(ws + WS_R), (size_t)M * DM, (bf16*)(ws + WS_TL), half * MH};
            pg8::gemm_phase<pg8::Epi5, pg8::StaticOrder>(F.lds + RING_OFF, g, S, E);
            if (BOTH(5 + 2 * half)) GRID_BAR();
        }
    }

    if (IN(8)) {
        pg8::Gemm g{(const bf16*)(ws + WS_TL), (const bf16*)(ws + WS_L2T), M, 4096, 256, 256, 256, 0, 0};
        pg8::StaticOrder S; S.init(M, 4096, F.G, (int)blockIdx.x);
        pg8::Epi6 E{(unsigned short*)(ws + WS_LOGW), (unsigned short*)(ws + WS_AA), args.in[10], args.in[13]};
        pg8::gemm_phase<pg8::Epi6, pg8::StaticOrder>(F.lds + RING_OFF, g, S, E);
        if (BOTH(8)) GRID_BAR();
    }

    if (IN(9)) { scan_phase(F, args); if (BOTH(9)) GRID_BAR(); }

    if (IN(10)) {
        pg8::Gemm g{(const bf16*)(ws + WS_OG), (const bf16*)(ws + WS_WOT), M, DM, DM, DM, DM, 0, 0};
        pg8::StaticOrder S; S.init(M, DM, F.G, (int)blockIdx.x);
        pg8::Epi8 E{args.out, (const float*)(ws + WS_STATS), args.in[22], args.in[23], ALPHA};
        pg8::gemm_phase<pg8::Epi8, pg8::StaticOrder>(F.lds + RING_OFF, g, S, E);
        if (BOTH(10)) GRID_BAR();
    }

    if (IN(11)) { final_ln_phase(F, args); }
#undef IN
#undef BOTH
#undef GRID_BAR
}

extern "C" void kernel_launch(void* const* d_in, const int* in_sizes, int n_in, void* d_out, int out_size, void* d_ws, size_t ws_size, hipStream_t stream) {
    static int grid = 0;
    if (grid == 0) {
        if (n_in != 24 || in_sizes[0] != M * DM || out_size != M * DM || ws_size < WS_END) { fprintf(stderr, "kernel_launch: shape/workspace mismatch (n_in %d, in0 %d, out %d, ws %zu, need %zu)\n", n_in, n_in > 0 ? in_sizes[0] : -1, out_size, ws_size, (size_t)WS_END); grid = -1; return; }
        int dev = 0, cus = 0;
        if (hipGetDevice(&dev) != hipSuccess || hipDeviceGetAttribute(&cus, hipDeviceAttributeMultiprocessorCount, dev) != hipSuccess) { grid = -1; return; }
        if (hipFuncSetAttribute((const void*)fwd_kernel, hipFuncAttributeMaxDynamicSharedMemorySize, LDS_BYTES) != hipSuccess) { fprintf(stderr, "kernel_launch: hipFuncSetAttribute failed\n"); grid = -1; return; }
        int per_cu = 0;
        if (hipOccupancyMaxActiveBlocksPerMultiprocessor(&per_cu, (const void*)fwd_kernel, NWAVES * 64, LDS_BYTES) != hipSuccess || per_cu < 1) fprintf(stderr, "kernel_launch: occupancy query says %d\n", per_cu);
        (void)hipGetLastError();
        grid = cus;
    }
    if (grid < 0) return;
    if (hipMemsetAsync((char*)d_ws + WS_CTL, 0, CTL_ZERO_BYTES, stream) != hipSuccess) return;
    Args a{};
    for (int i = 0; i < 24; ++i) a.in[i] = (const float*)d_in[i];
    a.out = (float*)d_out; a.ws = (unsigned char*)d_ws;
    if (N_LAUNCHES == 1) { a.ph_lo = 0; a.ph_hi = N_PHASES; a.li = 0; hipLaunchKernelGGL(fwd_kernel, dim3(grid), dim3(NWAVES * 64), LDS_BYTES, stream, a); }
    else for (int li = 0; li < N_PHASES; ++li) { a.ph_lo = li; a.ph_hi = li + 1; a.li = li; hipLaunchKernelGGL(fwd_kernel, dim3(grid), dim3(NWAVES * 64), LDS_BYTES, stream, a); }
}
```

```cpp
#include <hip/hip_runtime.h>
#include <hip/hip_bf16.h>
#include <cstdio>
#include <cstdint>

#ifndef MK_N_LAUNCHES
#define MK_N_LAUNCHES 1
#endif

namespace pg8 {
#define PG8_LAS __attribute__((address_space(3)))
typedef unsigned short bf16_t;
typedef short bf16x8 __attribute__((ext_vector_type(8)));
typedef float f32x4 __attribute__((ext_vector_type(4)));
typedef float f32x2 __attribute__((ext_vector_type(2)));
typedef unsigned u32x4 __attribute__((ext_vector_type(4)));
constexpr int BM = 256, BK = 64, HALF = 128, HTB = HALF * BK * 2, STAGE_BYTES = 8 * HTB, NXCD = 8, WGM = 8;

__host__ __device__ __forceinline__ int lds_byte(int r, int c) { const int st = (r >> 4) * 2 + (c >> 5), rr = r & 15, cc = c & 31, ob = rr * 64 + cc * 2; return st * 1024 + (ob ^ (((ob >> 9) & 1) << 5)); }
__host__ __device__ __forceinline__ void stage_rc(int b, int& R, int& C) { const int st = b / 1024, sb = b % 1024, swz = sb ^ (((sb >> 9) & 1) << 5); R = (st >> 1) * 16 + swz / 64; C = (st & 1) * 32 + (swz % 64) / 2; }
__host__ __device__ __forceinline__ int perm32(int rho) { const int n = rho >> 4, i = rho & 15; return 8 * (i >> 2) + 4 * n + (i & 3); }

struct Unit { int pm, pn; };
struct Gemm { const bf16_t* A; const bf16_t* Bt; int M, N, K, lda, ldb; int asel; size_t astride; };
__device__ __forceinline__ const bf16_t* a_base(const Gemm& g, const Unit& u) {
    int idx = 0;
    if (g.asel == 1) idx = u.pn;
    else if (g.asel == 2) idx = u.pn < 32 ? (u.pn >> 3) : (u.pn - 28);
    return g.A + (size_t)idx * g.astride;
}

struct StaticOrder {
    int nM, nN, nwg, G, c;
    __host__ __device__ void init(int M, int N, int G_, int c_) { nM = M / BM; nN = N / BM; nwg = nM * nN; G = G_; c = c_; }
    __host__ __device__ bool next(int i, Unit& u) const { return next_at((long)i * G + c, u); }
    __host__ __device__ bool next_at(long L, Unit& u) const {
        if (L >= nwg) return false;
        int wgid = (int)L; { const int q = nwg / NXCD, r = nwg % NXCD, xcd = wgid % NXCD, off = wgid / NXCD; wgid = (xcd < r ? xcd * (q + 1) : r * (q + 1) + (xcd - r) * q) + off; }
        const int nig = WGM * nN, gid = wgid / nig, fm = gid * WGM, gsz = (nM - fm) < WGM ? (nM - fm) : WGM;
        u.pm = fm + ((wgid % nig) % gsz); u.pn = (wgid % nig) / gsz; return true;
    }
};
struct ArrayOrder {
    StaticOrder sub; int nm;
    __host__ __device__ void init(int M, int G_, int c_) { sub.init(M, 2048, G_, c_); nm = M / BM; }
    __host__ __device__ bool next(int i, Unit& u) const {
        const long L0 = (long)i * sub.G + sub.c; const long per = sub.nwg, nl = 2 * nm;
        if (L0 < nl) { u.pm = (int)(L0 >> 1); u.pn = 32 + (int)(L0 & 1); return true; }
        const long L = L0 - nl; if (L >= 4 * per) return false;
        const int a = (int)(L / per); sub.next_at(L - a * per, u); u.pn += 8 * a; return true;
    }
};
struct TailOrder { int first, n;
    __host__ __device__ void init(int G_, int c_, int nlora) { const int c = c_; const bool late = c < nlora;
        const int nearly = G_ - nlora; const int per_late = nearly > 0 ? 2 : (1024 + G_ - 1) / G_, late_total = per_late * (nlora < G_ ? nlora : G_);
        if (late) { first = c * per_late; n = per_late; } else { const int rest = 1024 - late_total, per = (rest + nearly - 1) / nearly; first = late_total + (c - nlora) * per; n = per; }
        if (first > 1024) first = 1024; if (first + n > 1024) n = 1024 - first; }
    __host__ __device__ bool next(int i, Unit& u) const { if (i >= n) return false; const int j = first + i; u.pm = j >> 4; u.pn = j & 15; return true; } };
struct OneUnit { Unit u0; __device__ __forceinline__ bool next(int i, Unit& u) const { if (i != 0) return false; u = u0; return true; } };

typedef __bf16 bf16x2_t __attribute__((ext_vector_type(2)));
__device__ __forceinline__ unsigned cvt_pk_bf16(float lo, float hi) { f32x2 v = {lo, hi}; bf16x2_t b = __builtin_convertvector(v, bf16x2_t); return __builtin_bit_cast(unsigned, b); }
__device__ __forceinline__ float bf_lo(unsigned w) { return __uint_as_float(w << 16); }
__device__ __forceinline__ float bf_hi(unsigned w) { return __uint_as_float(w & 0xffff0000u); }
__device__ __forceinline__ float sigmoidf_(float x) { return __builtin_amdgcn_rcpf(1.0f + __builtin_amdgcn_exp2f(-1.4426950408889634f * x)); }
__device__ __forceinline__ float siluf_(float x) { return x * sigmoidf_(x); }
__device__ __forceinline__ float tanhf_(float x) { return 1.0f - 2.0f * __builtin_amdgcn_rcpf(1.0f + __builtin_amdgcn_exp2f(2.8853900817779268f * x)); }

constexpr float QSCALE2 = 0.08838834764831845f * 1.4426950408889634f;

struct EpiH {
    static constexpr bool PERM = true;
    bf16_t* O;
    __device__ __forceinline__ void operator()(const f32x4 (&acc)[2][2][4][2], const Unit& u, int wr, int wc, int fr, int fq) const {
        const int row0 = u.pm * BM + wr * 64 + fr, col0 = u.pn * BM + wc * 32 + 8 * fq;
        const int mode = u.pn < 4 ? 1 : (((u.pn >= 12 && u.pn < 16) || u.pn >= 20) ? 2 : 0);
#pragma unroll
        for (int ai = 0; ai < 2; ++ai)
#pragma unroll
            for (int m = 0; m < 4; ++m) { bf16_t* rowp = O + (size_t)(row0 + ai * HALF + m * 16) * 6144 + col0;
#pragma unroll
                for (int bj = 0; bj < 2; ++bj) { f32x4 v0 = acc[ai][bj][m][0], v1 = acc[ai][bj][m][1];
                    if (mode == 1) { v0 = v0 * QSCALE2; v1 = v1 * QSCALE2; }
                    else if (mode == 2) {
#pragma unroll
                        for (int e = 0; e < 4; ++e) { v0[e] = siluf_(v0[e]); v1[e] = siluf_(v1[e]); } }
                    u32x4 w; w.x = cvt_pk_bf16(v0[0], v0[1]); w.y = cvt_pk_bf16(v0[2], v0[3]); w.z = cvt_pk_bf16(v1[0], v1[1]); w.w = cvt_pk_bf16(v1[2], v1[3]);
                    *(u32x4*)(rowp + bj * HALF) = w; } }
    }
};
struct EpiPool {
    static constexpr bool PERM = true;
    bf16_t* MIX; const bf16_t* Hb; const float* pscale;
    __device__ __forceinline__ void operator()(const f32x4 (&acc)[2][2][4][2], const Unit& u, int wr, int wc, int fr, int fq) const {
        const int row0 = u.pm * BM + wr * 64 + fr, col0 = u.pn * BM + wc * 32 + 8 * fq;
#pragma unroll
        for (int ai = 0; ai < 2; ++ai)
#pragma unroll
            for (int m = 0; m < 4; ++m) { const size_t row = (size_t)(row0 + ai * HALF + m * 16);
#pragma unroll
                for (int bj = 0; bj < 2; ++bj) {
                    const f32x4 s0 = *(const f32x4*)(pscale + col0 + bj * HALF), s1 = *(const f32x4*)(pscale + col0 + bj * HALF + 4);
                    const u32x4 gb = *(const u32x4*)(Hb + row * 6144 + 5120 + col0 + bj * HALF);
                    f32x4 v0 = acc[ai][bj][m][0] * s0, v1 = acc[ai][bj][m][1] * s1;
                    v0[0] *= bf_lo(gb.x); v0[1] *= bf_hi(gb.x); v0[2] *= bf_lo(gb.y); v0[3] *= bf_hi(gb.y);
                    v1[0] *= bf_lo(gb.z); v1[1] *= bf_hi(gb.z); v1[2] *= bf_lo(gb.w); v1[3] *= bf_hi(gb.w);
                    u32x4 w; w.x = cvt_pk_bf16(v0[0], v0[1]); w.y = cvt_pk_bf16(v0[2], v0[3]); w.z = cvt_pk_bf16(v1[0], v1[1]); w.w = cvt_pk_bf16(v1[2], v1[3]);
                    *(u32x4*)(MIX + row * 2048 + 1024 + col0 + bj * HALF) = w; }
                asm volatile("" ::: "memory"); }
    }
};
struct EpiY {
    static constexpr bool PERM = true;
    bf16_t* O;
    __device__ __forceinline__ void operator()(const f32x4 (&acc)[2][2][4][2], const Unit& u, int wr, int wc, int fr, int fq) const {
        const int row0 = u.pm * BM + wr * 64 + fr, col0 = u.pn * BM + wc * 32 + 8 * fq;
#pragma unroll
        for (int ai = 0; ai < 2; ++ai)
#pragma unroll
            for (int m = 0; m < 4; ++m) { bf16_t* rowp = O + (size_t)(row0 + ai * HALF + m * 16) * 2048 + col0;
#pragma unroll
                for (int bj = 0; bj < 2; ++bj) { const f32x4 v0 = acc[ai][bj][m][0], v1 = acc[ai][bj][m][1];
                    u32x4 w; w.x = cvt_pk_bf16(v0[0], v0[1]); w.y = cvt_pk_bf16(v0[2], v0[3]); w.z = cvt_pk_bf16(v1[0], v1[1]); w.w = cvt_pk_bf16(v1[2], v1[3]);
                    *(u32x4*)(rowp + bj * HALF) = w; } }
    }
};
struct Epi5 {
    static constexpr bool PERM = true;
    bf16_t* O4[4]; bf16_t* TL; unsigned* cnt; unsigned tgt;
    __device__ __forceinline__ bool wants_publish(const Unit& u) const { return u.pn >= 32; }
    __device__ __forceinline__ void publish(const Unit&) const { __builtin_amdgcn_fence(__ATOMIC_RELEASE, "agent"); __hip_atomic_fetch_add(cnt + 4, 1u, __ATOMIC_RELAXED, __HIP_MEMORY_SCOPE_AGENT); }
    __device__ __forceinline__ void before(const Unit& u, int tid) const {
        if (u.pn >= 32) return;
        const int a = u.pn >> 3;
        if (tid == 0) { __hip_atomic_fetch_add(cnt + a, 1u, __ATOMIC_RELAXED, __HIP_MEMORY_SCOPE_AGENT);
            if (a >= 1) { unsigned sp = 0; while (__hip_atomic_load(cnt + a - 1, __ATOMIC_RELAXED, __HIP_MEMORY_SCOPE_AGENT) < tgt) { __builtin_amdgcn_s_sleep(4); if (++sp > (1u << 22)) break; } } }
        if (a >= 1) __builtin_amdgcn_s_barrier();
    }
    __device__ __forceinline__ void operator()(const f32x4 (&acc)[2][2][4][2], const Unit& u, int wr, int wc, int fr, int fq) const {
        const int row0 = u.pm * BM + wr * 64 + fr, ct = wc * 32 + 8 * fq;
#pragma unroll
        for (int ai = 0; ai < 2; ++ai)
#pragma unroll
            for (int m = 0; m < 4; ++m) { const size_t row = (size_t)(row0 + ai * HALF + m * 16);
#pragma unroll
                for (int bj = 0; bj < 2; ++bj) { f32x4 v0 = acc[ai][bj][m][0], v1 = acc[ai][bj][m][1]; const int c = ct + bj * HALF;
                    bf16_t* dst;
                    if (u.pn < 32) { const int arr = u.pn >> 3; dst = (arr == 0 ? O4[0] : arr == 1 ? O4[1] : arr == 2 ? O4[2] : O4[3]) + row * 2048 + (u.pn & 7) * BM + c;
                        if (arr == 3) {
#pragma unroll
                            for (int e = 0; e < 4; ++e) { v0[e] = siluf_(v0[e]); v1[e] = siluf_(v1[e]); } } }
                    else if (u.pn == 32) { if (c >= 96) continue; dst = TL + row * 256 + c;
#pragma unroll
                        for (int e = 0; e < 4; ++e) { v0[e] = tanhf_(v0[e]); v1[e] = tanhf_(v1[e]); } }
                    else { if (c >= 160) continue; dst = TL + row * 256 + 96 + c; }
                    u32x4 w; w.x = cvt_pk_bf16(v0[0], v0[1]); w.y = cvt_pk_bf16(v0[2], v0[3]); w.z = cvt_pk_bf16(v1[0], v1[1]); w.w = cvt_pk_bf16(v1[2], v1[3]);
                    *(u32x4*)dst = w; } }
    }
};
typedef _Float16 h16x2 __attribute__((ext_vector_type(2)));
__device__ __forceinline__ unsigned pk_h2(float a, float b) { h16x2 h = {(_Float16)a, (_Float16)b}; return __builtin_bit_cast(unsigned, h); }
struct Epi6 {
    static constexpr bool PERM = true;
    unsigned short* LOGW; unsigned short* AA; const float* w0; const float* a0;
    __device__ __forceinline__ void operator()(const f32x4 (&acc)[2][2][4][2], const Unit& u, int wr, int wc, int fr, int fq) const {
        const int row0 = u.pm * BM + wr * 64 + fr; const bool isw = u.pn < 8;
        const int col0 = (u.pn & 7) * BM + wc * 32 + 8 * fq; unsigned short* O = isw ? LOGW : AA; const float* bias = isw ? w0 : a0; const float sc = isw ? -0.6065306597126334f : 1.0f;
#pragma unroll
        for (int bj = 0; bj < 2; ++bj) { const f32x4 b0 = *(const f32x4*)(bias + col0 + bj * HALF), b1 = *(const f32x4*)(bias + col0 + bj * HALF + 4);
#pragma unroll
            for (int ai = 0; ai < 2; ++ai)
#pragma unroll
                for (int m = 0; m < 4; ++m) { f32x4 v0 = acc[ai][bj][m][0] + b0, v1 = acc[ai][bj][m][1] + b1;
#pragma unroll
                    for (int e = 0; e < 4; ++e) { v0[e] = sc * sigmoidf_(v0[e]); v1[e] = sc * sigmoidf_(v1[e]); }
                    u32x4 w; w.x = pk_h2(v0[0], v0[1]); w.y = pk_h2(v0[2], v0[3]); w.z = pk_h2(v1[0], v1[1]); w.w = pk_h2(v1[2], v1[3]);
                    *(u32x4*)(O + (size_t)(row0 + ai * HALF + m * 16) * 2048 + col0 + bj * HALF) = w; } }
    }
};
template <class Epi, class Sched, bool ALIGN_EPI = true, bool PRE = false, bool PUB = false>
__device__ __forceinline__ void gemm_phase(PG8_LAS unsigned char* lds, const Gemm g, const Sched& S, const Epi& E) {
    int tid = threadIdx.x; asm volatile("" : "+v"(tid));
    const int wid = __builtin_amdgcn_readfirstlane(tid >> 6), lane = tid & 63, wr = wid >> 2, wc = wid & 3, fr = lane & 15, fq = lane >> 4;
    const int K = g.K, nt = K / BK;
    unsigned voffA[2], voffB[2];
#pragma unroll
    for (int i = 0; i < 2; ++i) { int R, C; stage_rc(tid * 16 + i * 8192, R, C); const int Rb = Epi::PERM ? ((R & ~31) + perm32(R & 31)) : R;
        voffA[i] = (unsigned)(R * g.lda + C) * 2u; voffB[i] = (unsigned)(Rb * g.ldb + C) * 2u; }
    const size_t kstep = (size_t)(BK * 2);
    const size_t hstepA = (size_t)HALF * g.lda * 2, hstepB = (size_t)HALF * g.ldb * 2;
    const size_t tstepA = 2 * hstepA, tstepB = 2 * hstepB;
    const unsigned ldsw = (unsigned)wid * 1024u;
    const int aoff = lds_byte(wr * 64 + fr, fq * 8), boff = lds_byte(wc * 32 + fr, fq * 8);
#define PG8_SA(b, h) (((b) * 2 + (h)) * HTB)
#define PG8_SB(b, h) ((4 + (b) * 2 + (h)) * HTB)
#define PG8_STAGE(bufoff, gbase, voff) do { _Pragma("unroll") for (int _i = 0; _i < 2; ++_i) \
        __builtin_amdgcn_global_load_lds((const unsigned*)((const char*)(gbase) + (voff)[_i]), (PG8_LAS unsigned*)(lds + (bufoff) + ldsw + _i * 8192), 16, 0, 0); } while (0)
#define PG8_LDA(dst, b, h) do { _Pragma("unroll") for (int m = 0; m < 4; ++m) _Pragma("unroll") for (int k = 0; k < 2; ++k) dst[m][k] = *(const PG8_LAS bf16x8*)(lds + PG8_SA(b, h) + aoff + m * 2048 + k * 1024); } while (0)
#define PG8_LDB(dst, b, h) do { _Pragma("unroll") for (int n = 0; n < 2; ++n) _Pragma("unroll") for (int k = 0; k < 2; ++k) dst[n][k] = *(const PG8_LAS bf16x8*)(lds + PG8_SB(b, h) + boff + n * 2048 + k * 1024); } while (0)
#define PG8_MMA(ai, bj, At, Bt) do { __builtin_amdgcn_s_setprio(1); _Pragma("unroll") for (int m = 0; m < 4; ++m) _Pragma("unroll") for (int n = 0; n < 2; ++n) _Pragma("unroll") for (int k = 0; k < 2; ++k) \
        acc[ai][bj][m][n] = __builtin_amdgcn_mfma_f32_16x16x32_bf16(Bt[n][k], At[m][k], acc[ai][bj][m][n], 0, 0, 0); __builtin_amdgcn_s_setprio(0); } while (0)
#define PG8_WAIT_V(n) asm volatile("s_waitcnt vmcnt(" #n ")" ::: "memory")
#define PG8_WAIT_L(n) asm volatile("s_waitcnt lgkmcnt(" #n ")" ::: "memory")
#define PG8_BAR __builtin_amdgcn_s_barrier()
#define PG8_SCHED __builtin_amdgcn_sched_barrier(0)
    Unit cur, nxt; int ui = 0;
    if (!S.next(0, cur)) return;
    f32x4 acc[2][2][4][2];
#pragma unroll
    for (int a = 0; a < 2; ++a)
#pragma unroll
        for (int b = 0; b < 2; ++b)
#pragma unroll
            for (int m = 0; m < 4; ++m)
#pragma unroll
                for (int n = 0; n < 2; ++n) acc[a][b][m][n] = (f32x4){0.f, 0.f, 0.f, 0.f};
    bf16x8 At[4][2], B0[2][2], B1[2][2];
    const char* cA = (const char*)a_base(g, cur) + (size_t)cur.pm * tstepA; const char* cB = (const char*)g.Bt + (size_t)cur.pn * tstepB;
    PG8_STAGE(PG8_SB(0, 0), cB, voffB); PG8_STAGE(PG8_SB(0, 1), cB + hstepB, voffB); PG8_STAGE(PG8_SA(0, 0), cA, voffA); PG8_STAGE(PG8_SA(0, 1), cA + hstepA, voffA);
    if (wr == 1) PG8_BAR;
    PG8_WAIT_V(2); PG8_BAR;
    PG8_STAGE(PG8_SB(1, 0), cB + kstep, voffB); PG8_STAGE(PG8_SA(1, 0), cA + kstep, voffA); PG8_STAGE(PG8_SB(1, 1), cB + hstepB + kstep, voffB);
    PG8_WAIT_V(6); PG8_BAR;
    for (;;) {
        const bool has_next = S.next(ui + 1, nxt);
        const char* nA = has_next ? (const char*)a_base(g, nxt) + (size_t)nxt.pm * tstepA : cA; const char* nB = has_next ? (const char*)g.Bt + (size_t)nxt.pn * tstepB : cB;
        for (int t = 0; t < nt; t += 2) {
            const bool last = (t == nt - 2);
            const char* a1 = cA + (size_t)(t + 1) * kstep;
            const char* a2 = last ? nA : cA + (size_t)(t + 2) * kstep; const char* b2 = last ? nB : cB + (size_t)(t + 2) * kstep;
            const char* a3 = a2 + kstep; const char* b3 = b2 + kstep;
            PG8_LDB(B0, 0, 0); PG8_LDB(B1, 0, 1); PG8_SCHED; PG8_LDA(At, 0, 0); PG8_STAGE(PG8_SA(1, 1), a1 + hstepA, voffA);
            PG8_WAIT_V(8); PG8_WAIT_L(0); PG8_BAR; PG8_MMA(0, 0, At, B0); PG8_MMA(0, 1, At, B1); PG8_BAR; PG8_SCHED;
            PG8_LDA(At, 0, 1); PG8_STAGE(PG8_SB(0, 0), b2, voffB); PG8_STAGE(PG8_SB(0, 1), b2 + hstepB, voffB); PG8_STAGE(PG8_SA(0, 0), a2, voffA);
            PG8_WAIT_V(8); PG8_WAIT_L(0); PG8_BAR; PG8_MMA(1, 0, At, B0); PG8_MMA(1, 1, At, B1); PG8_BAR; PG8_SCHED;
            PG8_LDB(B0, 1, 0); PG8_LDB(B1, 1, 1); PG8_SCHED; PG8_LDA(At, 1, 0); PG8_STAGE(PG8_SA(0, 1), a2 + hstepA, voffA);
            PG8_WAIT_V(8); PG8_WAIT_L(0); PG8_BAR; PG8_MMA(0, 0, At, B0); PG8_MMA(0, 1, At, B1); PG8_BAR; PG8_SCHED;
            PG8_LDA(At, 1, 1); PG8_STAGE(PG8_SB(1, 0), b3, voffB); PG8_STAGE(PG8_SB(1, 1), b3 + hstepB, voffB); PG8_STAGE(PG8_SA(1, 0), a3, voffA);
            PG8_WAIT_V(8); PG8_WAIT_L(0); PG8_BAR; PG8_MMA(1, 0, At, B0); PG8_MMA(1, 1, At, B1); PG8_BAR; PG8_SCHED;
        }
        if constexpr (ALIGN_EPI) { if (wr == 0) PG8_BAR; }
        if constexpr (PRE) E.before(cur, tid);
        { int l2 = lane; asm volatile("" : "+v"(l2)); E(acc, cur, wr, wc, l2 & 15, l2 >> 4); }
        if constexpr (PUB) { if (E.wants_publish(cur)) {
            PG8_WAIT_V(0); PG8_BAR; PG8_BAR; if (wid == 0 && lane == 0) E.publish(cur); } }
        if (!has_next) break;
#pragma unroll
        for (int a = 0; a < 2; ++a)
#pragma unroll
            for (int b = 0; b < 2; ++b)
#pragma unroll
                for (int m = 0; m < 4; ++m)
#pragma unroll
                    for (int n = 0; n < 2; ++n) acc[a][b][m][n] = (f32x4){0.f, 0.f, 0.f, 0.f};
        cur = nxt; cA = nA; cB = nB; ++ui;
        if constexpr (ALIGN_EPI) { if (wr == 1) PG8_BAR; }
    }
    PG8_WAIT_V(0);
    if constexpr (!ALIGN_EPI) { if (wr == 0) PG8_BAR; }
    PG8_BAR;
#undef PG8_SA
#undef PG8_SB
#undef PG8_STAGE
#undef PG8_LDA
#undef PG8_LDB
#undef PG8_MMA
#undef PG8_WAIT_V
#undef PG8_WAIT_L
#undef PG8_BAR
#undef PG8_SCHED
}
}

namespace sba {
using bf16 = __hip_bfloat16;
typedef short bf16x8 __attribute__((ext_vector_type(8)));
typedef short s16x4 __attribute__((ext_vector_type(4)));
typedef float f32x16 __attribute__((ext_vector_type(16)));
typedef float f32x4 __attribute__((ext_vector_type(4)));
typedef unsigned u32x4 __attribute__((ext_vector_type(4)));
constexpr int NW = 8, QBLK = 32, KVBLK = 64, QB = NW * QBLK, D = 128;
constexpr int PIN = 6144, POUT = 2048;
constexpr int SHM_V = KVBLK * D * 2, SHM_K = KVBLK * D * 2;
constexpr int SHM_Q = QBLK * D * 2;
constexpr int LDS_BYTES = 2 * SHM_V + 2 * SHM_K + NW * SHM_Q;

#define KSWZ(row, colB) ((row) * 256 + ((colB) ^ (((row) & 7) << 4)))
#define SBAR() __builtin_amdgcn_sched_barrier(0)
__device__ __forceinline__ int v_st(int k, int c) { const int kk = (k & ~0xC) | ((k & 4) << 1) | ((k & 8) >> 1); return ((kk >> 3) * 4 + (c >> 5)) * 512 + ((kk & 7) * 32 + (c & 31)) * 2; }
__device__ __forceinline__ int v_rd_base(int lane) { return ((lane & 3) << 3) | (((lane >> 2) & 3) << 6) | (((lane >> 4) & 1) << 5) | (((lane >> 5) & 1) << 8); }
constexpr int v_rd_off(int d0, int ks, int half) { return d0 * 512 + ks * 4096 + half * 2048; }
__device__ __forceinline__ int crow(int r, int hi) { return (r & 3) + 8 * (r >> 2) + 4 * hi; }
typedef float f32x2_t __attribute__((ext_vector_type(2))); typedef __bf16 bf16x2_t __attribute__((ext_vector_type(2)));
__device__ __forceinline__ unsigned cvtpk(float lo, float hi) { f32x2_t v = {lo, hi}; bf16x2_t b = __builtin_convertvector(v, bf16x2_t); return __builtin_bit_cast(unsigned, b); }
__device__ __forceinline__ bf16x8 load8(const bf16* p) { return *reinterpret_cast<const bf16x8*>(p); }

__device__ __forceinline__ void mask_tile(f32x16& p0, f32x16& p1, int dq) {
    const float NEG = -__builtin_inff();
#pragma unroll
    for (int r = 0; r < 16; ++r) {
        const int c = (r & 3) + 8 * (r >> 2);
        if (dq - c < 0) p0[r] = NEG;
        if (dq - c - 32 < 0) p1[r] = NEG;
    }
}
__device__ __forceinline__ void partA_half(f32x16& p, float& C, int hi) {
    f32x16 s;
#pragma unroll
    for (int r = 0; r < 16; ++r) {
        const float E = __builtin_amdgcn_exp2f(__builtin_amdgcn_fmed3f(p[r], -1.0e30f, 60.f));
        s[r] = __builtin_amdgcn_rcpf(1.0f + E);
        p[r] = E * s[r];
    }
    float U[4], X[4];
#pragma unroll
    for (int g = 0; g < 4; ++g) { const float T = (s[4 * g] * s[4 * g + 1]) * (s[4 * g + 2] * s[4 * g + 3]);
        auto rr = __builtin_amdgcn_permlane32_swap(__float_as_uint(T), __float_as_uint(T), false, false);
        const float tl = __uint_as_float(rr[0]), th = __uint_as_float(rr[1]); U[g] = tl * th; X[g] = th; }
#pragma unroll
    for (int g = 3; g >= 0; --g) {
        float run = hi == 0 ? C * X[g] : C;
#pragma unroll
        for (int i = 3; i >= 0; --i) { const float a = p[4 * g + i] * run; run *= s[4 * g + i]; p[4 * g + i] = a; }
        C *= U[g];
    }
}
__device__ __forceinline__ void partA(f32x16& p0, f32x16& p1, float& Crun, int hi) { partA_half(p1, Crun, hi); partA_half(p0, Crun, hi); }
__device__ __forceinline__ void partB(f32x16& p0, f32x16& p1, bf16x8& pa0, bf16x8& pa1, bf16x8& pa2, bf16x8& pa3) {
#define PK4(P, B_, OUT) do { unsigned a0 = cvtpk(P[B_+0], P[B_+1]), a1 = cvtpk(P[B_+2], P[B_+3]);                          \
        unsigned b0 = cvtpk(P[B_+4], P[B_+5]), b1 = cvtpk(P[B_+6], P[B_+7]);                                             \
        auto r0 = __builtin_amdgcn_permlane32_swap(a0, b0, false, false); auto r1 = __builtin_amdgcn_permlane32_swap(a1, b1, false, false); \
        u32x4 w = {r0[0], r1[0], r0[1], r1[1]}; OUT = *reinterpret_cast<bf16x8*>(&w); } while (0)
    PK4(p0, 0, pa0); PK4(p0, 8, pa1); PK4(p1, 0, pa2); PK4(p1, 8, pa3);
#undef PK4
}
template <int KB>
__device__ __forceinline__ void qkt(f32x16& p0, f32x16& p1, const char* K_lds, int r32, int hi, const char* Qw_lds, bool act) {
    if (!act) { const float NEG = -__builtin_inff();
#pragma unroll
        for (int r = 0; r < 16; ++r) { p0[r] = NEG; p1[r] = NEG; } return; }
    p0 = f32x16{}; p1 = f32x16{};
    const char* kb[4];
#pragma unroll
    for (int dd = 0; dd < 4; ++dd) kb[dd] = K_lds + KB * SHM_K + KSWZ(r32, (dd * 16 + hi * 8) * 2);
#pragma unroll
    for (int d0 = 0; d0 < 8; ++d0) { const char* a = kb[d0 & 3] + (d0 >> 2) * 128;
        bf16x8 b0 = *reinterpret_cast<const bf16x8*>(a);
        bf16x8 b1 = *reinterpret_cast<const bf16x8*>(a + 32 * 256);
        bf16x8 q = *reinterpret_cast<const bf16x8*>(Qw_lds + (kb[d0 & 3] - (K_lds + KB * SHM_K)) + (d0 >> 2) * 128);
        p0 = __builtin_amdgcn_mfma_f32_32x32x16_bf16(b0, q, p0, 0, 0, 0);
        p1 = __builtin_amdgcn_mfma_f32_32x32x16_bf16(b1, q, p1, 0, 0, 0); }
}
template <int VB>
__device__ __forceinline__ void pv_tile(f32x16* o, int vb0, bf16x8 pa0, bf16x8 pa1, bf16x8 pa2, bf16x8 pa3, bool act) {
    if (!act) return;
#define TRRD(dst, off) asm volatile("ds_read_b64_tr_b16 %0, %1 offset:%2" : "=&v"(dst) : "v"(vb0), "i"(off) : "memory")
#define PV_D0(d0) do { s16x4 l0, l1, l2, l3, h0, h1, h2, h3; constexpr int b_ = VB * SHM_V + v_rd_off(d0, 0, 0); \
        TRRD(l0, b_); TRRD(h0, b_ + 2048); TRRD(l1, b_ + 4096); TRRD(h1, b_ + 6144); TRRD(l2, b_ + 8192); TRRD(h2, b_ + 10240); TRRD(l3, b_ + 12288); TRRD(h3, b_ + 14336); \
        asm volatile("s_waitcnt lgkmcnt(0)" ::: "memory"); SBAR();   \
        o[d0] = __builtin_amdgcn_mfma_f32_32x32x16_bf16(pa0, (bf16x8){l0[0], l0[1], l0[2], l0[3], h0[0], h0[1], h0[2], h0[3]}, o[d0], 0, 0, 0);   \
        o[d0] = __builtin_amdgcn_mfma_f32_32x32x16_bf16(pa1, (bf16x8){l1[0], l1[1], l1[2], l1[3], h1[0], h1[1], h1[2], h1[3]}, o[d0], 0, 0, 0);   \
        o[d0] = __builtin_amdgcn_mfma_f32_32x32x16_bf16(pa2, (bf16x8){l2[0], l2[1], l2[2], l2[3], h2[0], h2[1], h2[2], h2[3]}, o[d0], 0, 0, 0);   \
        o[d0] = __builtin_amdgcn_mfma_f32_32x32x16_bf16(pa3, (bf16x8){l3[0], l3[1], l3[2], l3[3], h3[0], h3[1], h3[2], h3[3]}, o[d0], 0, 0, 0); } while (0)
    PV_D0(0); PV_D0(1); PV_D0(2); PV_D0(3);
#undef PV_D0
#undef TRRD
}

struct BlockRef { const bf16* Q; const bf16* K; const bf16* V; const bf16* G; bf16* O; int P0; };
#define ROW(p, k0, rr) ((p) + (size_t)((k0) + (rr)) * PIN + sc)
#define VMW() asm volatile("s_waitcnt vmcnt(0)" ::: "memory")
#define SLOAD_H(Kp, Vp, k0) do { st_v0 = load8(ROW(Vp, k0, sr)); st_v1 = load8(ROW(Vp, k0, 32 + sr));              \
                         st_k0 = load8(ROW(Kp, k0, sr)); st_k1 = load8(ROW(Kp, k0, 32 + sr)); } while (0)
#define SWRITE_H(bf) do { *(bf16x8*)(V_lds + (bf) * SHM_V + vst0) = st_v0; *(bf16x8*)(V_lds + (bf) * SHM_V + vst1) = st_v1; \
                          *(bf16x8*)(K_lds + (bf) * SHM_K + kws) = st_k0; *(bf16x8*)(K_lds + (bf) * SHM_K + kws + 32 * 256) = st_k1; } while (0)
__device__ __forceinline__ void q_to_lds(const bf16* Q, char* Qw_lds, int wid, int r32, int hi) {
    bf16x8 qr[8];
#pragma unroll
    for (int d0 = 0; d0 < 8; ++d0) qr[d0] = load8(Q + (size_t)(wid * QBLK + r32) * PIN + d0 * 16 + hi * 8);
#pragma unroll
    for (int d0 = 0; d0 < 8; ++d0) *(bf16x8*)(Qw_lds + KSWZ(r32, (d0 * 16 + hi * 8) * 2)) = qr[d0];
}
__device__ __forceinline__ void sb_block(const BlockRef& cur, char* lds) {
    int tid = threadIdx.x; asm volatile("" : "+v"(tid));
    const int wid = __builtin_amdgcn_readfirstlane(tid >> 6), lane = tid & 63, r32 = lane & 31, hi = lane >> 5;
    const int NT = (cur.P0 + QB) / KVBLK;
    const int qlo = cur.P0 + wid * QBLK, qm = qlo + r32 - 1 - 4 * hi;
    char* V_lds = lds; char* K_lds = lds + 2 * SHM_V; char* Qw_lds = lds + 2 * SHM_V + 2 * SHM_K + wid * SHM_Q;
    float Rrun = 1.f; f32x16 o[4] = {};
    const int sr = tid >> 4, sc = (tid & 15) * 8, vst0 = v_st(sr, sc), vst1 = v_st(32 + sr, sc), kws = KSWZ(sr, sc * 2);
    const int vb0 = (int)(uintptr_t)V_lds + v_rd_base(lane);
    const bf16* Kh = cur.K; const bf16* Vh = cur.V;
    bf16x8 st_v0, st_v1, st_k0, st_k1;
#define KBASE(t) ((NT - 1 - (t)) * KVBLK)
#define ACT(t) (KBASE(t) <= qlo + QBLK - 2)
#define MASKT(P0_, P1_, t) do { const int kb_ = KBASE(t); if (ACT(t) && (kb_ + KVBLK - 1 > qlo - 1)) mask_tile(P0_, P1_, qm - kb_); } while (0)
    q_to_lds(cur.Q, Qw_lds, wid, r32, hi);
    SLOAD_H(Kh, Vh, KBASE(0)); VMW(); SWRITE_H(0);
    __syncthreads();
    f32x16 p0, p1; bf16x8 pa0, pa1, pa2, pa3;
    constexpr float SKIP_THR = 1e-30f;
    volatile int* flags = (volatile int*)(lds + 2 * SHM_V + 2 * SHM_K + NW * SHM_Q);
    bool mydone = false, alldone = false;
#define STEP(t, BF) do {                                                                                   \
        if ((t) + 1 < NT) { SLOAD_H(Kh, Vh, KBASE((t) + 1)); }                                              \
        const bool act_ = ACT(t) && !mydone;                                                                 \
        SBAR(); qkt<BF>(p0, p1, K_lds, r32, hi, Qw_lds, act_);                                          \
        if (act_) { MASKT(p0, p1, (t)); partA(p0, p1, Rrun, hi); partB(p0, p1, pa0, pa1, pa2, pa3); } SBAR();               \
        pv_tile<BF>(o, vb0, pa0, pa1, pa2, pa3, act_);                                                     \
        mydone = mydone || __all(Rrun <= SKIP_THR);                                                           \
        if (lane == 0) flags[BF * 8 + wid] = mydone ? 1 : 0;                                                 \
        if ((t) + 1 < NT) { VMW(); SWRITE_H(1 - BF); }                                                       \
        __syncthreads();                                                                                     \
        { int f_ = 1; _Pragma("unroll") for (int w_ = 0; w_ < 8; ++w_) f_ &= flags[BF * 8 + w_]; alldone = f_ != 0; } } while (0)
    for (int t = 0; t < NT; t += 2) { STEP(t, 0); if (alldone) break; STEP(t + 1, 1); if (alldone) break; }
    {
        bf16* Ow = cur.O + (size_t)(wid * QBLK) * POUT; const bf16* Gw = cur.G + (size_t)(wid * QBLK) * PIN;
        float* st = (float*)Qw_lds;
        const int erow = lane >> 1, ehalf = lane & 1;
#pragma unroll
        for (int hp = 0; hp < 2; ++hp) {
            u32x4 gq[4];
#pragma unroll
            for (int i = 0; i < 4; ++i) gq[i] = *(const u32x4*)(Gw + (size_t)erow * PIN + hp * 64 + ehalf * 32 + i * 8);
            asm volatile("s_waitcnt lgkmcnt(0)" ::: "memory");
#pragma unroll
            for (int r = 0; r < 16; ++r) { const int orow = crow(r, hi);
#pragma unroll
                for (int dl = 0; dl < 2; ++dl) { const int col = dl * 32 + r32; st[orow * 64 + ((((col >> 2) ^ (orow & 15)) << 2) | (col & 3))] = o[2 * hp + dl][r]; } }
            asm volatile("s_waitcnt lgkmcnt(0)" ::: "memory");
#pragma unroll
            for (int i = 0; i < 4; ++i) {
                const int g0 = 8 * ehalf + 2 * i;
                const f32x4 a = *(const f32x4*)(st + erow * 64 + ((g0 ^ (erow & 15)) << 2)), b = *(const f32x4*)(st + erow * 64 + (((g0 + 1) ^ (erow & 15)) << 2));
                const u32x4 g = gq[i];
                u32x4 w; w.x = cvtpk(a[0] * __uint_as_float(g.x << 16), a[1] * __uint_as_float(g.x & 0xffff0000u)); w.y = cvtpk(a[2] * __uint_as_float(g.y << 16), a[3] * __uint_as_float(g.y & 0xffff0000u));
                w.z = cvtpk(b[0] * __uint_as_float(g.z << 16), b[1] * __uint_as_float(g.z & 0xffff0000u)); w.w = cvtpk(b[2] * __uint_as_float(g.w << 16), b[3] * __uint_as_float(g.w & 0xffff0000u));
                *(u32x4*)(Ow + (size_t)erow * POUT + hp * 64 + ehalf * 32 + i * 8) = w; }
        }
        asm volatile("s_waitcnt lgkmcnt(0)" ::: "memory");
    }
#undef KBASE
#undef ACT
#undef MASKT
#undef STEP
}
#undef ROW
#undef VMW
#undef SLOAD_H
#undef SWRITE_H
#undef KSWZ
#undef SBAR
}

constexpr int NWAVES = 8;
constexpr int N_LAUNCHES = MK_N_LAUNCHES;
constexpr int N_PHASES = 12;
constexpr int BATCH = 4, SEQ = 4096, DM = 2048, M = BATCH * SEQ, MH = M / 2;
constexpr int EVEN_IN = 6144;
constexpr float LN_EPS = 1e-5f, GN_EPS = 64e-5f;
constexpr float ALPHA = 1.4142135623730951f;
constexpr int N2CAT = 4 * DM + 512;

constexpr size_t MiB = 1u << 20;
constexpr size_t WS_CTL = 0, CTL_ZERO_BYTES = 1 * MiB;
constexpr size_t WS_W2CAT = 1 * MiB, WS_WOT = 35 * MiB, WS_L2T = 43 * MiB, WS_STATS = 45 * MiB, WS_D = 46 * MiB;
constexpr size_t WS_WINT = WS_D, WS_WOUTT = WS_D + 24 * MiB, WS_WPOOLT = WS_D + 32 * MiB, WS_XB = WS_D + 33 * MiB, WS_MIX = WS_XB, WS_H = WS_D + 97 * MiB, WS_POOLED = WS_D + 289 * MiB;
constexpr size_t WS_XMIX = WS_D, WS_K2 = WS_D, WS_V2 = WS_D + 64 * MiB, WS_SG = WS_D + 128 * MiB, WS_OG = WS_D + 192 * MiB, WS_AA = WS_D + 256 * MiB, WS_LOGW = WS_D + 320 * MiB;
constexpr size_t WS_R = WS_D + 384 * MiB, WS_TL = WS_D + 448 * MiB, WS_END = WS_D + 456 * MiB;
constexpr size_t WS_Y0 = WS_R;
constexpr size_t WS_GRING = WS_W2CAT;
constexpr size_t WS_Y1 = WS_LOGW;
static_assert(WS_POOLED + 32 * MiB <= WS_END && WS_END <= 512 * MiB, "d_ws map");
constexpr int CW_TMO = 0, CW_CODE = 1, CW_BAR = 4096, CW_ACNT = 8192, CW_GFL = 16384;

constexpr int RING_OFF = 0, RING_BYTES = 159744;
constexpr int LDSCTL_OFF = RING_BYTES, MISC_OFF = LDSCTL_OFF + 320;
constexpr int LDS_BYTES = 163840;

#define GAS __attribute__((address_space(1)))
#define LAS __attribute__((address_space(3)))
typedef unsigned short bf16;
typedef unsigned v4u __attribute__((ext_vector_type(4)));
typedef unsigned v2u __attribute__((ext_vector_type(2)));
typedef float f32x4 __attribute__((ext_vector_type(4)));
typedef float f32x2v __attribute__((ext_vector_type(2)));
typedef GAS unsigned gu32;
#define RLX_AGENT __ATOMIC_RELAXED, __HIP_MEMORY_SCOPE_AGENT
#define LDS_WAIT() asm volatile("s_waitcnt lgkmcnt(0)" ::: "memory")
#define VM_WAIT() asm volatile("s_waitcnt vmcnt(0)" ::: "memory")
__device__ __forceinline__ unsigned f2bf(float f) { unsigned u = __builtin_bit_cast(unsigned, f); return (u + 0x7fffu + ((u >> 16) & 1u)) >> 16; }
__device__ __forceinline__ unsigned pk2(float lo, float hi) { return pg8::cvt_pk_bf16(lo, hi); }
__device__ __forceinline__ float bflo(unsigned w) { return __uint_as_float(w << 16); }
__device__ __forceinline__ float bfhi(unsigned w) { return __uint_as_float(w & 0xffff0000u); }

#define XB_TMO      128
#define XB_XCNT(j)  (256  + 64 * (j))
#define XB_XSUB(j)  (1280 + 64 * (j))
#define XB_XGEN(j)  (2304 + 64 * (j))
#define XB_TOP      3328
#define XB_TOPGEN   3392
#define XCD_BAR_WORDS 3456
#define XB_SPIN_CAP (1u << 23)
__device__ __forceinline__ unsigned xb_ld(unsigned* p)              { return __hip_atomic_load(p, __ATOMIC_RELAXED, __HIP_MEMORY_SCOPE_AGENT); }
__device__ __forceinline__ unsigned xb_add(unsigned* p, unsigned v) { return __hip_atomic_fetch_add(p, v, __ATOMIC_RELAXED, __HIP_MEMORY_SCOPE_AGENT); }
__device__ __forceinline__ unsigned xb_xcc_id() { return (unsigned)__builtin_amdgcn_s_getreg((3 << 11) | 20) & 0xFu; }
#define XB_SPIN(cond, bar) do { unsigned _sp = 0; while (cond) { __builtin_amdgcn_s_sleep(1); \
    if ((++_sp & 255u) == 0u) { if (xb_ld(&(bar)[XB_TMO])) break; if (_sp > XB_SPIN_CAP) { atomicAdd(&(bar)[XB_TMO], 1u); break; } } } } while (0)
struct XcdBarrier { unsigned* bar; unsigned x; volatile LAS unsigned* st; };
__device__ __forceinline__ XcdBarrier xcd_barrier_post(unsigned* bar, volatile LAS unsigned* st) {
    XcdBarrier b; b.bar = bar; b.x = xb_xcc_id(); b.st = st;
    if (threadIdx.x == 0) (void)xb_add(&bar[XB_XCNT(b.x)], 1u);
    return b;
}
__device__ __forceinline__ void xcd_barrier_complete(unsigned* bar, unsigned x, unsigned& nloc, unsigned& nx) {
    const unsigned G = gridDim.x * gridDim.y * gridDim.z;
    unsigned sum, cnt, mine, sp = 0u;
    for (;;) {
        sum = 0u; cnt = 0u; mine = 0u;
#pragma unroll
        for (unsigned j = 0; j < 16; ++j) { const unsigned c = xb_ld(&bar[XB_XCNT(j)]); sum += c; cnt += (c > 0u) ? 1u : 0u; mine = (j == x) ? c : mine; }
        if (sum == G) break;
        __builtin_amdgcn_s_sleep(1);
        if ((++sp & 255u) == 0u) { if (xb_ld(&bar[XB_TMO])) break; if (sp > XB_SPIN_CAP) { atomicAdd(&bar[XB_TMO], 1u); break; } }
    }
    nloc = mine > 0u ? mine : 1u; nx = cnt > 0u ? cnt : 1u;
}
__device__ __attribute__((noinline)) void xcd_barrier(const XcdBarrier b) {
    asm volatile("s_waitcnt vmcnt(0)" ::: "memory");
    __syncthreads();
    if (threadIdx.x == 0) {
        unsigned* bar = b.bar;
        __builtin_amdgcn_s_waitcnt(0);
        unsigned nloc = b.st[0], nx = b.st[1];
        if (nloc == 0u) { xcd_barrier_complete(bar, b.x, nloc, nx); b.st[0] = nloc; b.st[1] = nx; }
        const unsigned old = xb_add(&bar[XB_XSUB(b.x)], 1u);
        const unsigned gen = old / nloc;
        if (old + 1u == (gen + 1u) * nloc) {
            __builtin_amdgcn_fence(__ATOMIC_RELEASE, "agent");
            asm volatile("s_waitcnt vmcnt(0)" ::: "memory");
            const unsigned og = xb_add(&bar[XB_TOP], 1u);
            const unsigned tg = og / nx;
            if (og + 1u == (tg + 1u) * nx) xb_add(&bar[XB_TOPGEN], 1u);
            else XB_SPIN(xb_ld(&bar[XB_TOPGEN]) == tg, bar);
            __builtin_amdgcn_fence(__ATOMIC_ACQUIRE, "agent");
            xb_add(&bar[XB_XGEN(b.x)], 1u);
            asm volatile("s_waitcnt vmcnt(0)" ::: "memory");
        } else {
            XB_SPIN(xb_ld(&bar[XB_XGEN(b.x)]) == gen, bar);
            __builtin_amdgcn_fence(__ATOMIC_ACQUIRE, "agent");
            asm volatile("s_waitcnt vmcnt(0)" ::: "memory");
        }
    }
    __syncthreads();
}

struct Frame {
    LAS unsigned char* lds;
    volatile LAS unsigned* MISC;
    gu32* ctl;
    int vcu, G;
};
#define PHASE_TID() int tid_ = threadIdx.x; asm volatile("" : "+v"(tid_)); const int tid = tid_, lane = tid & 63, wave = __builtin_amdgcn_readfirstlane(tid >> 6); (void)lane; (void)wave
__device__ __forceinline__ float wave_sum(float v) {
#pragma unroll
    for (int o = 1; o < 64; o <<= 1) v += __shfl_xor(v, o);
    return v;
}
__device__ __forceinline__ void p0_transpose_item(const float* W, int N, bf16* WT, int ldwt, int row_off, LAS float* scr, int item, int lane) {
    const int nblk = N / 32, kb = item / nblk, nb = item % nblk, k0 = 64 * kb, n0 = 32 * nb;
    { const int kk8 = lane >> 3, c4 = lane & 7; f32x4 t[8];
#pragma unroll
      for (int i = 0; i < 8; ++i) t[i] = *(const GAS f32x4*)(W + (size_t)(k0 + 8 * i + kk8) * N + n0 + 4 * c4);
#pragma unroll
      for (int i = 0; i < 8; ++i) { LAS float* d = scr + (8 * i + kk8) * 33 + 4 * c4; d[0] = t[i].x; d[1] = t[i].y; d[2] = t[i].z; d[3] = t[i].w; } }
    LDS_WAIT(); asm volatile("" ::: "memory");
    const int c = lane & 7;
#pragma unroll
    for (int j = 0; j < 4; ++j) { const int n = (lane >> 3) + 8 * j; const LAS float* s = scr + (8 * c) * 33 + n;
        v4u o; o.x = pk2(s[0 * 33], s[1 * 33]); o.y = pk2(s[2 * 33], s[3 * 33]); o.z = pk2(s[4 * 33], s[5 * 33]); o.w = pk2(s[6 * 33], s[7 * 33]);
        *(GAS v4u*)(WT + (size_t)(row_off + n0 + n) * ldwt + k0 + 8 * c) = o; }
    LDS_WAIT(); asm volatile("" ::: "memory");
}

struct Args { const float* in[24]; float* out; unsigned char* ws; int ph_lo, ph_hi, li, pad; };

__device__ __forceinline__ void p0_prologue(Frame& F, const Args& a) {
    PHASE_TID();
    unsigned char* ws = a.ws;
    LAS float* scr = (LAS float*)(F.lds + RING_OFF + wave * 16384);
    const int gw = F.vcu * NWAVES + wave, NGW = F.G * NWAVES;
    bf16* WINT = (bf16*)(ws + WS_WINT); bf16* WPOOLT = (bf16*)(ws + WS_WPOOLT);
    constexpr int I_IN = (DM / 64) * (EVEN_IN / 32), I_POOL = (256 / 64) * (256 / 32);
    constexpr int NITEMS = I_IN + 4 * I_POOL;
    for (int it = gw; it < NITEMS; it += NGW) {
        int r = it;
        if (r < I_IN) { p0_transpose_item(a.in[1], EVEN_IN, WINT, DM, 0, scr, r, lane); continue; } r -= I_IN;
        { const int g = r / I_POOL; p0_transpose_item(a.in[2] + (size_t)g * 65536, 256, WPOOLT + (size_t)g * 65536, 256, 0, scr, r % I_POOL, lane); }
    }
    const int gt = F.vcu * (NWAVES * 64) + tid, NGT = F.G * NWAVES * 64;
    { const float* x = a.in[0]; bf16* XB = (bf16*)(ws + WS_XB);
      for (size_t i = (size_t)gt * 2; i < (size_t)M * DM / 8; i += (size_t)2 * NGT) {
          const f32x4 u0 = *(const GAS f32x4*)(x + i * 8), u1 = *(const GAS f32x4*)(x + i * 8 + 4), u2 = *(const GAS f32x4*)(x + i * 8 + 8), u3 = *(const GAS f32x4*)(x + i * 8 + 12);
          *(GAS v4u*)(XB + i * 8) = (v4u){pk2(u0.x, u0.y), pk2(u0.z, u0.w), pk2(u1.x, u1.y), pk2(u1.z, u1.w)};
          *(GAS v4u*)(XB + i * 8 + 8) = (v4u){pk2(u2.x, u2.y), pk2(u2.z, u2.w), pk2(u3.x, u3.y), pk2(u3.z, u3.w)}; } }
}
__device__ __forceinline__ void late_weights(Frame& F, const Args& a) {
    PHASE_TID();
    unsigned char* ws = a.ws;
    LAS float* scr = (LAS float*)(F.lds + RING_OFF + wave * 16384);
    const int gw = F.vcu * NWAVES + wave, NGW = F.G * NWAVES;
    bf16* WOUTT = (bf16*)(ws + WS_WOUTT); bf16* W2CAT = (bf16*)(ws + WS_W2CAT);
    constexpr int I_SQ = (DM / 64) * (DM / 32), I_LORA = (DM / 64) * (96 / 32);
    constexpr int NITEMS = 5 * I_SQ + 2 * I_LORA;
    for (int it = gw; it < NITEMS; it += NGW) {
        int r = it;
        if (r < I_SQ) { p0_transpose_item(a.in[4], DM, WOUTT, DM, 0, scr, r, lane); continue; } r -= I_SQ;
        if (r < 4 * I_SQ) { const int w = r / I_SQ; p0_transpose_item(a.in[6 + w], DM, W2CAT, DM, w * DM, scr, r % I_SQ, lane); continue; } r -= 4 * I_SQ;
        if (r < I_LORA) { p0_transpose_item(a.in[11], 96, W2CAT, DM, 4 * DM, scr, r, lane); continue; } r -= I_LORA;
        p0_transpose_item(a.in[14], 96, W2CAT, DM, 4 * DM + 256, scr, r, lane);
    }
    const int gt = F.vcu * (NWAVES * 64) + tid, NGT = F.G * NWAVES * 64;
    for (int i = gt; i < 2 * 160 * (DM / 8); i += NGT) { const int blk = i / (160 * (DM / 8)), rr = (i / (DM / 8)) % 160, c8 = i % (DM / 8);
        *(GAS v4u*)(W2CAT + (size_t)(4 * DM + blk * 256 + 96 + rr) * DM + c8 * 8) = (v4u){0u, 0u, 0u, 0u}; }
    { bf16* L2T = (bf16*)(ws + WS_L2T); const float* w2 = a.in[12]; const float* a2 = a.in[15];
      for (int i = gt; i < 4096 * 32; i += NGT) { const int n = i % 4096, c8 = i / 4096; const int k0 = c8 * 8; float v[8];
#pragma unroll
          for (int e = 0; e < 8; ++e) { const int k = k0 + e; float x = 0.f;
              if (n < 2048) { if (k < 96) x = w2[(size_t)k * DM + n]; } else { if (k >= 96 && k < 192) x = a2[(size_t)(k - 96) * DM + (n - 2048)]; }
              v[e] = x; }
          *(GAS v4u*)(L2T + (size_t)n * 256 + k0) = (v4u){pk2(v[0], v[1]), pk2(v[2], v[3]), pk2(v[4], v[5]), pk2(v[6], v[7])}; } }
}

template <int WIN>
__device__ __forceinline__ void pool_tile_w(const bf16* Hb, bf16* POOLED, int pm, int g, int tid) {
    const int c4 = (tid & 63) * 4, rw = tid >> 6;
    const int row0 = pm * 256 + rw * 32, t0 = row0 & (SEQ - 1);
    const bf16* up = Hb + (size_t)row0 * 6144 + 4096 + g * 256 + c4;
    v2u ring[WIN]; float s0 = 0.f, s1 = 0.f, s2 = 0.f, s3 = 0.f;
#pragma unroll
    for (int i = 1; i < WIN; ++i) {
        v2u w = {0u, 0u};
        if (t0 - i >= 0) w = *(const GAS v2u*)(up - (size_t)i * 6144);
        ring[(WIN - i) % WIN] = w; s0 += bflo(w.x); s1 += bfhi(w.x); s2 += bflo(w.y); s3 += bfhi(w.y); }
    v2u cur[32];
#pragma unroll
    for (int rr = 0; rr < 32; ++rr) cur[rr] = *(const GAS v2u*)(up + (size_t)rr * 6144);
#pragma unroll
    for (int rr = 0; rr < 32; ++rr) {
        const v2u w = cur[rr]; const float u0 = bflo(w.x), u1 = bfhi(w.x), u2 = bflo(w.y), u3 = bfhi(w.y);
        s0 += u0; s1 += u1; s2 += u2; s3 += u3;
        const int t = t0 + rr; const float inv = (t + 1 >= WIN) ? (1.0f / (float)WIN) : __builtin_amdgcn_rcpf((float)(t + 1));
        *(GAS v2u*)(POOLED + (size_t)(row0 + rr) * 1024 + g * 256 + c4) = (v2u){pk2(s0 * inv - u0, s1 * inv - u1), pk2(s2 * inv - u2, s3 * inv - u3)};
        const v2u old = ring[(rr + 1) % WIN];
        s0 -= bflo(old.x); s1 -= bfhi(old.x); s2 -= bflo(old.y); s3 -= bfhi(old.y);
        ring[rr % WIN] = w;
    }
}
__device__ __forceinline__ void pool_tile(Frame& F, const bf16* Hb, bf16* POOLED, int pm, int g) {
    PHASE_TID();
    if (g == 0) pool_tile_w<2>(Hb, POOLED, pm, g, tid); else if (g == 1) pool_tile_w<4>(Hb, POOLED, pm, g, tid);
    else if (g == 2) pool_tile_w<8>(Hb, POOLED, pm, g, tid); else pool_tile_w<16>(Hb, POOLED, pm, g, tid);
}

struct Row32 { f32x4 a[4], b[4]; };
template <bool XBF = false>
__device__ __forceinline__ void ln_row(const float* xr, const bf16* yr, const Row32& G, const Row32& B, int lane, Row32& v) {
    float s = 0.f;
#pragma unroll
    for (int j = 0; j < 4; ++j) { const int c = 8 * lane + 512 * j; f32x4 x0, x1;
        if (XBF) { const v4u xw = *(const GAS v4u*)((const bf16*)xr + c); x0 = (f32x4){bflo(xw.x), bfhi(xw.x), bflo(xw.y), bfhi(xw.y)}; x1 = (f32x4){bflo(xw.z), bfhi(xw.z), bflo(xw.w), bfhi(xw.w)}; }
        else { x0 = *(const GAS f32x4*)(xr + c); x1 = *(const GAS f32x4*)(xr + c + 4); }
        const v4u y = *(const GAS v4u*)(yr + c);
        v.a[j] = x0 * ALPHA + (f32x4){bflo(y.x), bfhi(y.x), bflo(y.y), bfhi(y.y)}; v.b[j] = x1 * ALPHA + (f32x4){bflo(y.z), bfhi(y.z), bflo(y.w), bfhi(y.w)};
        s += ((v.a[j].x + v.a[j].y) + (v.a[j].z + v.a[j].w)) + ((v.b[j].x + v.b[j].y) + (v.b[j].z + v.b[j].w)); }
    const float mean = wave_sum(s) * (1.f / DM); float s2 = 0.f;
#pragma unroll
    for (int j = 0; j < 4; ++j) { v.a[j] = v.a[j] - mean; v.b[j] = v.b[j] - mean;
        s2 += ((v.a[j].x * v.a[j].x + v.a[j].y * v.a[j].y) + (v.a[j].z * v.a[j].z + v.a[j].w * v.a[j].w)) + ((v.b[j].x * v.b[j].x + v.b[j].y * v.b[j].y) + (v.b[j].z * v.b[j].z + v.b[j].w * v.b[j].w)); }
    const float rstd = __builtin_amdgcn_rsqf(wave_sum(s2) * (1.f / DM) + LN_EPS);
#pragma unroll
    for (int j = 0; j < 4; ++j) { v.a[j] = v.a[j] * rstd * G.a[j] + B.a[j]; v.b[j] = v.b[j] * rstd * G.b[j] + B.b[j]; }
}
template <bool XBF = false>
__device__ __forceinline__ void ln_row_ld(const float* xr, const bf16* yr, const float* lg, const float* lb, int lane, Row32& v) {
    asm volatile("" : "+s"(lg), "+s"(lb));
    Row32 G, B;
#pragma unroll
    for (int j = 0; j < 4; ++j) { const int c = 8 * lane + 512 * j; G.a[j] = *(const f32x4*)(lg + c); G.b[j] = *(const f32x4*)(lg + c + 4); B.a[j] = *(const f32x4*)(lb + c); B.b[j] = *(const f32x4*)(lb + c + 4); }
    ln_row<XBF>(xr, yr, G, B, lane, v);
}
__device__ __forceinline__ void load_row32(const float* p, int lane, Row32& r) {
#pragma unroll
    for (int j = 0; j < 4; ++j) { const int c = 8 * lane + 512 * j; r.a[j] = *(const f32x4*)(p + c); r.b[j] = *(const f32x4*)(p + c + 4); }
}
__device__ __forceinline__ void ln_mix_phase(Frame& F, const Args& a) {
    const float* X = a.in[0]; const bf16* Y0 = (const bf16*)(a.ws + WS_Y0); float* X1 = a.out; bf16* XMIX = (bf16*)(a.ws + WS_XMIX);
    const float* lg = a.in[22]; const float* lb = a.in[23]; const float* mu = a.in[5];
    PHASE_TID();
    const int gw = F.vcu * NWAVES + wave, NGW = F.G * NWAVES;
    constexpr int STRIP = 4;
    for (int sidx = gw; sidx < M / STRIP; sidx += NGW) {
        const int r0 = sidx * STRIP;
        Row32 prev;
        if ((r0 & (SEQ - 1)) == 0) {
#pragma unroll
            for (int j = 0; j < 4; ++j) { prev.a[j] = (f32x4){0.f, 0.f, 0.f, 0.f}; prev.b[j] = (f32x4){0.f, 0.f, 0.f, 0.f}; }
        } else ln_row_ld(X + (size_t)(r0 - 1) * DM, Y0 + (size_t)(r0 - 1) * DM, lg, lb, lane, prev);
        for (int rr = 0; rr < STRIP; ++rr) {
            const int row = r0 + rr; Row32 v;
            ln_row_ld(X + (size_t)row * DM, Y0 + (size_t)row * DM, lg, lb, lane, v);
            const size_t orow = (size_t)row * DM;
#pragma unroll
            for (int j = 0; j < 4; ++j) { const int c = 8 * lane + 512 * j;
                *(GAS v4u*)((bf16*)(X1 + (size_t)row * DM) + c) = (v4u){pk2(v.a[j].x, v.a[j].y), pk2(v.a[j].z, v.a[j].w), pk2(v.b[j].x, v.b[j].y), pk2(v.b[j].z, v.b[j].w)};
                const f32x4 xa = prev.a[j] - v.a[j], xb = prev.b[j] - v.b[j];
#pragma unroll
                for (int q = 0; q < 6; ++q) { const int mrow = (q == 0) ? 0 : (q == 1) ? 2 : (q == 2) ? 3 : (q == 3) ? 5 : (q == 4) ? 1 : 4;
                    const f32x4 m0 = *(const f32x4*)(mu + (size_t)mrow * DM + c), m1 = *(const f32x4*)(mu + (size_t)mrow * DM + c + 4); const f32x4 o0 = v.a[j] + xa * m0, o1 = v.b[j] + xb * m1;
                    *(GAS v4u*)(XMIX + (size_t)q * M * DM + orow + c) = (v4u){pk2(o0.x, o0.y), pk2(o0.z, o0.w), pk2(o1.x, o1.y), pk2(o1.z, o1.w)}; }
                prev.a[j] = v.a[j]; prev.b[j] = v.b[j]; asm volatile("" ::: "memory"); }
        }
    }
}
__device__ __forceinline__ void final_ln_phase(Frame& F, const Args& a) {
    float* X1 = a.out; const bf16* Y1 = (const bf16*)(a.ws + WS_Y1); const float* lg = a.in[22] + DM; const float* lb = a.in[23] + DM;
    PHASE_TID();
    const int gw = F.vcu * NWAVES + wave, NGW = F.G * NWAVES;
    for (int row = gw; row < M; row += NGW) {
        Row32 v; ln_row_ld<true>(X1 + (size_t)row * DM, Y1 + (size_t)row * DM, lg, lb, lane, v);
#pragma unroll
        for (int j = 0; j < 4; ++j) { const int c = 8 * lane + 512 * j; *(GAS f32x4*)(X1 + (size_t)row * DM + c) = v.a[j]; *(GAS f32x4*)(X1 + (size_t)row * DM + c + 4) = v.b[j]; }
    }
}

namespace wkv {
constexpr int NSLOT_ = 8;
typedef short bf16x8 __attribute__((ext_vector_type(8)));
typedef float f32x16 __attribute__((ext_vector_type(16)));
typedef float f32x4 __attribute__((ext_vector_type(4)));
typedef unsigned u32x4 __attribute__((ext_vector_type(4)));
typedef unsigned u32x2 __attribute__((ext_vector_type(2)));
typedef _Float16 h16x2 __attribute__((ext_vector_type(2)));
constexpr int O_KR = 0, O_BGT = 4096, O_KGT = 6144, O_VT = 8192, O_AM = 10240, O_LC = 11264, O_GC = 12288, O_BON = 12544, SLOT = 12608;
constexpr int OENT = 4096 + 64;
constexpr int NPREP = 6, L_SLOTS = 0, L_BK = NSLOT_ * SLOT, L_ORING = L_BK + NPREP * 4096, L_FLAGS = L_ORING + NSLOT_ * OENT, L_END = L_FLAGS + 256;
constexpr int NSLOT = 8;
constexpr float L2E = 1.4426950408889634f;
__device__ __forceinline__ int kr_off(int row, int chunk) { return row * 128 + ((chunk ^ ((row >> 1) & 7)) << 4); }
__device__ __forceinline__ int t_off(int row, int half) { return row * 32 + ((half ^ ((row >> 3) & 1)) << 4); }
typedef float f32x2_t __attribute__((ext_vector_type(2))); typedef __bf16 bf16x2_t __attribute__((ext_vector_type(2)));
__device__ __forceinline__ unsigned cvtpk(float lo, float hi) { f32x2_t v = {lo, hi}; bf16x2_t b = __builtin_convertvector(v, bf16x2_t); return __builtin_bit_cast(unsigned, b); }
__device__ __forceinline__ int rho(int j, int h) { return (j & 3) + 8 * (j >> 2) + 4 * h; }
template <int B> __device__ __forceinline__ bf16x8 frag(const f32x16& x) {
    u32x4 w = {cvtpk(x[B + 0], x[B + 1]), cvtpk(x[B + 2], x[B + 3]), cvtpk(x[B + 4], x[B + 5]), cvtpk(x[B + 6], x[B + 7])};
    return __builtin_bit_cast(bf16x8, w);
}
template <int B> __device__ __forceinline__ bf16x8 frag_pI(const f32x16& x, const float (&dI)[8]) {
    u32x4 w = {cvtpk(x[B + 0] + dI[0], x[B + 1] + dI[1]), cvtpk(x[B + 2] + dI[2], x[B + 3] + dI[3]), cvtpk(x[B + 4] + dI[4], x[B + 5] + dI[5]), cvtpk(x[B + 6] + dI[6], x[B + 7] + dI[7])};
    return __builtin_bit_cast(bf16x8, w);
}
__device__ __forceinline__ float dppf(float v, int) { return v; }
__device__ __forceinline__ float sum16(float v) {
    v += __builtin_bit_cast(float, __builtin_amdgcn_update_dpp(0, __builtin_bit_cast(int, v), 0xB1, 0xf, 0xf, false));
    v += __builtin_bit_cast(float, __builtin_amdgcn_update_dpp(0, __builtin_bit_cast(int, v), 0x4E, 0xf, 0xf, false));
    v += __builtin_bit_cast(float, __builtin_amdgcn_update_dpp(0, __builtin_bit_cast(int, v), 0x141, 0xf, 0xf, false));
    v += __builtin_bit_cast(float, __builtin_amdgcn_update_dpp(0, __builtin_bit_cast(int, v), 0x140, 0xf, 0xf, false));
    return v;
}
__device__ __forceinline__ float sum32(float v) { v = sum16(v); return v + __shfl_xor(v, 16); }
#define MF(A_, B_, C_) __builtin_amdgcn_mfma_f32_32x32x16_bf16((A_), (B_), (C_), 0, 0, 0)

struct Tensors { const unsigned short* R; const unsigned short* K; const unsigned short* V; const unsigned short* SG; const unsigned short* LOGW; const unsigned short* AA; unsigned short* OG;
                 const float* k_k; const float* k_a; const float* r_k; const float* gn_w; const float* gn_b; };

struct Raw { unsigned r[8], k[8], v[8], l[8], a[8]; };
__device__ __forceinline__ void prep_load(const Tensors& T, size_t grow0, int h, int lane, Raw& w) {
    const int cp = lane & 31, hh = lane >> 5;
    const size_t ub = grow0 * 2048 + h * 64;
    const unsigned lo = (unsigned)(hh * 8 * 2048 + 2 * cp);
    const unsigned short* pr = T.R + ub; const unsigned short* pk = T.K + ub; const unsigned short* pv = T.V + ub; const unsigned short* pl = T.LOGW + ub; const unsigned short* pa = T.AA + ub;
#pragma unroll
    for (int i = 0; i < 8; ++i) { const unsigned e = lo + (unsigned)i * 2048u;
        w.r[i] = *(const GAS unsigned*)(pr + e); w.k[i] = *(const GAS unsigned*)(pk + e); w.v[i] = *(const GAS unsigned*)(pv + e);
        w.l[i] = *(const GAS unsigned*)(pl + e); w.a[i] = *(const GAS unsigned*)(pa + e); }
}
template <class WaitSlot>
__device__ __forceinline__ void prep_elem(const Tensors& T, const Raw& w, int h, LAS unsigned char* slot, LAS unsigned char* bk, int lane, const WaitSlot& wait_slot) {
    const int cp = lane & 31, hh = lane >> 5;
    float lw[8][2], aa[8][2], rr[8][2], kr[8][2];
#pragma unroll
    for (int i = 0; i < 8; ++i) {
        const unsigned wr_ = w.r[i], wk_ = w.k[i], wl_ = w.l[i], wa_ = w.a[i];
        rr[i][0] = bflo(wr_); rr[i][1] = bfhi(wr_); kr[i][0] = bflo(wk_); kr[i][1] = bfhi(wk_);
        const h16x2 hl = __builtin_bit_cast(h16x2, wl_), ha = __builtin_bit_cast(h16x2, wa_);
        lw[i][0] = (float)hl[0]; lw[i][1] = (float)hl[1]; aa[i][0] = (float)ha[0]; aa[i][1] = (float)ha[1]; }
    float kkc[2], kac[2], rkc[2];
#pragma unroll
    for (int e = 0; e < 2; ++e) { kkc[e] = T.k_k[h * 64 + 2 * cp + e]; kac[e] = T.k_a[h * 64 + 2 * cp + e]; rkc[e] = T.r_k[h * 64 + 2 * cp + e]; }
    float g[8][2], e0x[2], gam[2];
#pragma unroll
    for (int e = 0; e < 2; ++e) { float run = 0.f;
#pragma unroll
        for (int i = 0; i < 8; ++i) { run += lw[i][e]; g[i][e] = run; }
        auto sw = __builtin_amdgcn_permlane32_swap(__float_as_uint(run), __float_as_uint(run), false, false);
        const float lo_tot = __uint_as_float(sw[0]), hi_tot = __uint_as_float(sw[1]);
        const float off = hh ? lo_tot : 0.f;
#pragma unroll
        for (int i = 0; i < 8; ++i) g[i][e] += off;
        e0x[e] = hh ? __builtin_amdgcn_exp2f(lo_tot * L2E) : 1.0f;
        gam[e] = __builtin_amdgcn_exp2f((lo_tot + hi_tot) * L2E); }
    float inv[8], bon[8], kp[8][2];
#pragma unroll
    for (int i = 0; i < 8; ++i) { const float q0 = kr[i][0] * kkc[0], q1 = kr[i][1] * kkc[1];
        const float ss = sum32(q0 * q0 + q1 * q1); inv[i] = __builtin_amdgcn_rsqf(fmaxf(ss, 1e-24f));
        kp[i][0] = kr[i][0] * (1.0f + (aa[i][0] - 1.0f) * kac[0]); kp[i][1] = kr[i][1] * (1.0f + (aa[i][1] - 1.0f) * kac[1]);
        bon[i] = sum32(rr[i][0] * kp[i][0] * rkc[0] + rr[i][1] * kp[i][1] * rkc[1]); }
    unsigned pBg[2][4], pKg[2][4], pKn[8], pRq[8];
    float eprev[2] = {e0x[0], e0x[1]};
    const int ch = cp >> 2, wo = (cp & 3) * 4;
#pragma unroll
    for (int ip = 0; ip < 4; ++ip) {
        float Bg[2][2], Kg[2][2];
#pragma unroll
        for (int q = 0; q < 2; ++q) { const int i = 2 * ip + q;
            float Kn[2], Rq[2], Bd[2], Kd[2];
#pragma unroll
            for (int e = 0; e < 2; ++e) { const float E1 = __builtin_amdgcn_exp2f(g[i][e] * L2E), Ei = __builtin_amdgcn_exp2f(-g[i][e] * L2E);
                const float kkn = kr[i][e] * kkc[e] * inv[i];
                Kn[e] = -kkn * eprev[e]; Rq[e] = rr[i][e] * E1; Bd[e] = kkn * aa[i][e] * Ei; Kd[e] = kp[i][e] * Ei; Bg[q][e] = Bd[e] * gam[e]; Kg[q][e] = Kd[e] * gam[e]; eprev[e] = E1; }
            const int tt = 8 * hh + i;
            pKn[i] = cvtpk(Kn[0], Kn[1]); pRq[i] = cvtpk(Rq[0], Rq[1]);
            *(LAS unsigned*)(bk + kr_off(tt, ch) + wo) = cvtpk(Bd[0], Bd[1]);
            *(LAS unsigned*)(bk + kr_off(16 + tt, ch) + wo) = cvtpk(Kd[0], Kd[1]); }
#pragma unroll
        for (int e = 0; e < 2; ++e) { pBg[e][ip] = cvtpk(Bg[0][e], Bg[1][e]); pKg[e][ip] = cvtpk(Kg[0][e], Kg[1][e]); }
    }
    wait_slot();
#pragma unroll
    for (int i = 0; i < 8; ++i) { const int tt = 8 * hh + i;
        *(LAS unsigned*)(slot + O_KR + kr_off(tt, ch) + wo) = pKn[i];
        *(LAS unsigned*)(slot + O_KR + kr_off(16 + tt, ch) + wo) = pRq[i]; }
    unsigned pV[2][4];
#pragma unroll
    for (int ip = 0; ip < 4; ++ip) { const unsigned a_ = w.v[2 * ip], b_ = w.v[2 * ip + 1]; pV[0][ip] = (a_ & 0xffffu) | (b_ << 16); pV[1][ip] = (a_ >> 16) | (b_ & 0xffff0000u); }
#pragma unroll
    for (int e = 0; e < 2; ++e) { const int row = 2 * cp + e;
        *(LAS u32x2*)(slot + O_BGT + t_off(row, 0) + 8 * hh) = (u32x2){pBg[e][0], pBg[e][1]}; *(LAS u32x2*)(slot + O_BGT + t_off(row, 1) + 8 * hh) = (u32x2){pBg[e][2], pBg[e][3]};
        *(LAS u32x2*)(slot + O_KGT + t_off(row, 0) + 8 * hh) = (u32x2){pKg[e][0], pKg[e][1]}; *(LAS u32x2*)(slot + O_KGT + t_off(row, 1) + 8 * hh) = (u32x2){pKg[e][2], pKg[e][3]};
        *(LAS u32x2*)(slot + O_VT + t_off(row, 0) + 8 * hh) = (u32x2){pV[e][0], pV[e][1]}; *(LAS u32x2*)(slot + O_VT + t_off(row, 1) + 8 * hh) = (u32x2){pV[e][2], pV[e][3]}; }
    if (hh == 0) *(LAS f32x2v*)(slot + O_GC + 8 * cp) = (f32x2v){gam[0], gam[1]};
    if (cp == 0) {
#pragma unroll
        for (int i = 0; i < 8; ++i) *(LAS float*)(slot + O_BON + 4 * (8 * hh + i)) = bon[i]; }
    LDS_WAIT(); asm volatile("" ::: "memory");
}
template <class WaitSlot>
__device__ __forceinline__ void prep_elem_kv(const Tensors& T, const Raw& w, int h, LAS unsigned char* slot, LAS unsigned char* bk, int lane, const float (&kkc)[2], const float (&kac)[2], const float (&rkc)[2], const WaitSlot& wait_slot) {
    const int cp = lane & 31, hh = lane >> 5;
    float lw[8][2], aa[8][2], rr[8][2], kr[8][2];
#pragma unroll
    for (int i = 0; i < 8; ++i) {
        const unsigned wr_ = w.r[i], wk_ = w.k[i], wl_ = w.l[i], wa_ = w.a[i];
        rr[i][0] = bflo(wr_); rr[i][1] = bfhi(wr_); kr[i][0] = bflo(wk_); kr[i][1] = bfhi(wk_);
        const h16x2 hl = __builtin_bit_cast(h16x2, wl_), ha = __builtin_bit_cast(h16x2, wa_);
        lw[i][0] = (float)hl[0]; lw[i][1] = (float)hl[1]; aa[i][0] = (float)ha[0]; aa[i][1] = (float)ha[1]; }
    float g[8][2], e0x[2], gam[2];
#pragma unroll
    for (int e = 0; e < 2; ++e) { float run = 0.f;
#pragma unroll
        for (int i = 0; i < 8; ++i) { run += lw[i][e]; g[i][e] = run; }
        auto sw = __builtin_amdgcn_permlane32_swap(__float_as_uint(run), __float_as_uint(run), false, false);
        const float lo_tot = __uint_as_float(sw[0]), hi_tot = __uint_as_float(sw[1]);
        const float off = hh ? lo_tot : 0.f;
#pragma unroll
        for (int i = 0; i < 8; ++i) g[i][e] += off;
        e0x[e] = hh ? __builtin_amdgcn_exp2f(lo_tot * L2E) : 1.0f;
        gam[e] = __builtin_amdgcn_exp2f((lo_tot + hi_tot) * L2E); }
    float inv[8], bon[8], kp[8][2];
#pragma unroll
    for (int i = 0; i < 8; ++i) { const float q0 = kr[i][0] * kkc[0], q1 = kr[i][1] * kkc[1];
        const float ss = sum32(q0 * q0 + q1 * q1); inv[i] = __builtin_amdgcn_rsqf(fmaxf(ss, 1e-24f));
        kp[i][0] = kr[i][0] * (1.0f + (aa[i][0] - 1.0f) * kac[0]); kp[i][1] = kr[i][1] * (1.0f + (aa[i][1] - 1.0f) * kac[1]);
        bon[i] = sum32(rr[i][0] * kp[i][0] * rkc[0] + rr[i][1] * kp[i][1] * rkc[1]); }
    unsigned pBg[2][4], pKg[2][4], pKn[8], pRq[8];
    float eprev[2] = {e0x[0], e0x[1]};
    const int ch = cp >> 2, wo = (cp & 3) * 4;
#pragma unroll
    for (int ip = 0; ip < 4; ++ip) {
        float Bg[2][2], Kg[2][2];
#pragma unroll
        for (int q = 0; q < 2; ++q) { const int i = 2 * ip + q;
            float Kn[2], Rq[2], Bd[2], Kd[2];
#pragma unroll
            for (int e = 0; e < 2; ++e) { const float E1 = __builtin_amdgcn_exp2f(g[i][e] * L2E), Ei = __builtin_amdgcn_exp2f(-g[i][e] * L2E);
                const float kkn = kr[i][e] * kkc[e] * inv[i];
                Kn[e] = -kkn * eprev[e]; Rq[e] = rr[i][e] * E1; Bd[e] = kkn * aa[i][e] * Ei; Kd[e] = kp[i][e] * Ei; Bg[q][e] = Bd[e] * gam[e]; Kg[q][e] = Kd[e] * gam[e]; eprev[e] = E1; }
            const int tt = 8 * hh + i;
            pKn[i] = cvtpk(Kn[0], Kn[1]); pRq[i] = cvtpk(Rq[0], Rq[1]);
            *(LAS unsigned*)(bk + kr_off(tt, ch) + wo) = cvtpk(Bd[0], Bd[1]);
            *(LAS unsigned*)(bk + kr_off(16 + tt, ch) + wo) = cvtpk(Kd[0], Kd[1]); }
#pragma unroll
        for (int e = 0; e < 2; ++e) { pBg[e][ip] = cvtpk(Bg[0][e], Bg[1][e]); pKg[e][ip] = cvtpk(Kg[0][e], Kg[1][e]); }
    }
    wait_slot();
#pragma unroll
    for (int i = 0; i < 8; ++i) { const int tt = 8 * hh + i;
        *(LAS unsigned*)(slot + O_KR + kr_off(tt, ch) + wo) = pKn[i];
        *(LAS unsigned*)(slot + O_KR + kr_off(16 + tt, ch) + wo) = pRq[i]; }
    unsigned pV[2][4];
#pragma unroll
    for (int ip = 0; ip < 4; ++ip) { const unsigned a_ = w.v[2 * ip], b_ = w.v[2 * ip + 1]; pV[0][ip] = (a_ & 0xffffu) | (b_ << 16); pV[1][ip] = (a_ >> 16) | (b_ & 0xffff0000u); }
#pragma unroll
    for (int e = 0; e < 2; ++e) { const int row = 2 * cp + e;
        *(LAS u32x2*)(slot + O_BGT + t_off(row, 0) + 8 * hh) = (u32x2){pBg[e][0], pBg[e][1]}; *(LAS u32x2*)(slot + O_BGT + t_off(row, 1) + 8 * hh) = (u32x2){pBg[e][2], pBg[e][3]};
        *(LAS u32x2*)(slot + O_KGT + t_off(row, 0) + 8 * hh) = (u32x2){pKg[e][0], pKg[e][1]}; *(LAS u32x2*)(slot + O_KGT + t_off(row, 1) + 8 * hh) = (u32x2){pKg[e][2], pKg[e][3]};
        *(LAS u32x2*)(slot + O_VT + t_off(row, 0) + 8 * hh) = (u32x2){pV[e][0], pV[e][1]}; *(LAS u32x2*)(slot + O_VT + t_off(row, 1) + 8 * hh) = (u32x2){pV[e][2], pV[e][3]}; }
    if (hh == 0) *(LAS f32x2v*)(slot + O_GC + 8 * cp) = (f32x2v){gam[0], gam[1]};
    if (cp == 0) {
#pragma unroll
        for (int i = 0; i < 8; ++i) *(LAS float*)(slot + O_BON + 4 * (8 * hh + i)) = bon[i]; }
    LDS_WAIT(); asm volatile("" ::: "memory");
}
__device__ __forceinline__ void prep_mfma(LAS unsigned char* slot, LAS unsigned char* bk, int lane) {
    const int r = lane & 31, hq = lane >> 5;
    bf16x8 fKR[4], fBK[4];
#pragma unroll
    for (int s4 = 0; s4 < 4; ++s4) { fKR[s4] = *(const LAS bf16x8*)(slot + O_KR + kr_off(r, 2 * s4 + hq)); fBK[s4] = *(const LAS bf16x8*)(bk + kr_off(r, 2 * s4 + hq)); }
    f32x16 P = {}, PT = {};
#pragma unroll
    for (int s4 = 0; s4 < 4; ++s4) { P = MF(fKR[s4], fBK[s4], P); PT = MF(fBK[s4], fKR[s4], PT); }
    {
        const int jc = r & 15;
#pragma unroll
        for (int gg = 0; gg < 16; ++gg) { const int tr = (gg & 3) + 8 * ((gg >> 2) & 1) + 4 * hq;
            const bool keepP = (gg < 8) ? (jc < tr) : (jc <= tr);
            const bool keepT = (r < 16) ? (tr < jc) : (tr <= jc);
            P[gg] = keepP ? P[gg] : 0.f; PT[gg] = keepT ? PT[gg] : 0.f; }
    }
    float dI[8];
#pragma unroll
    for (int j = 0; j < 8; ++j) dI[j] = (r == rho(j, hq)) ? 1.0f : 0.f;
    const f32x16 Z = {};
    const bf16x8 opN = frag<0>(P), opNt = frag<0>(PT);
    const f32x16 N2 = MF(opNt, opN, Z), N2t = MF(opN, opNt, Z);
    const bf16x8 opN2 = frag<0>(N2), opN2t = frag<0>(N2t);
    const f32x16 N4 = MF(opN2t, opN2, Z), N4t = MF(opN2, opN2t, Z);
    const bf16x8 opN4 = frag<0>(N4), opN4t = frag<0>(N4t);
    const f32x16 N8 = MF(opN4t, opN4, Z);
    const f32x16 G1t = MF(frag_pI<0>(N2, dI), frag_pI<0>(PT, dI), Z);
    const f32x16 G2 = MF(frag_pI<0>(N4t, dI), frag_pI<0>(N8, dI), Z);
    const f32x16 Tm = MF(frag<0>(G1t), frag<0>(G2), Z);
    const f32x16 Dm = MF(frag<0>(Tm), opNt, Z);
    *(LAS bf16x8*)(slot + O_LC + lane * 16) = frag_pI<0>(Dm, dI);
    *(LAS bf16x8*)(slot + O_AM + lane * 16) = frag<8>(PT);
}

__device__ __forceinline__ void chunk_step(LAS unsigned char* slot, LAS unsigned char* oent, f32x16& S0, f32x16& S1, int vh, int lane) {
    const int r = lane & 31, hq = lane >> 5, vrow = 32 * vh + r;
    const bf16x8 fVT = *(const LAS bf16x8*)(slot + O_VT + t_off(vrow, hq));
    const bf16x8 fAM = *(const LAS bf16x8*)(slot + O_AM + lane * 16);
    const f32x16 Z = {};
    f32x16 X = MF(fAM, fVT, Z);
#define LFRAG(tau, u) ({ const u32x2 a_ = *(const LAS u32x2*)(slot + O_KR + kr_off(r, 4 * (tau) + 2 * (u)) + 8 * hq), b_ = *(const LAS u32x2*)(slot + O_KR + kr_off(r, 4 * (tau) + 2 * (u) + 1) + 8 * hq); \
                         u32x4 w_ = {a_.x, a_.y, b_.x, b_.y}; __builtin_bit_cast(bf16x8, w_); })
    X = MF(LFRAG(0, 0), frag<0>(S0), X);
    X = MF(LFRAG(0, 1), frag<8>(S0), X);
    X = MF(LFRAG(1, 0), frag<0>(S1), X);
    X = MF(LFRAG(1, 1), frag<8>(S1), X);
#undef LFRAG
    const bf16x8 fLC = *(const LAS bf16x8*)(slot + O_LC + lane * 16);
    const f32x16 D2 = MF(fLC, frag<0>(X), Z);
#pragma unroll
    for (int j = 0; j < 8; ++j) *(LAS float*)(oent + (rho(j, hq) * 64 + vrow) * 4) = X[8 + j] + D2[8 + j];
    const bf16x8 fU = frag<0>(D2);
#pragma unroll
    for (int q = 0; q < 4; ++q) { const f32x4 g0 = *(const LAS f32x4*)(slot + O_GC + (8 * q + 4 * hq) * 4), g1 = *(const LAS f32x4*)(slot + O_GC + (32 + 8 * q + 4 * hq) * 4);
#pragma unroll
        for (int e = 0; e < 4; ++e) { S0[4 * q + e] *= g0[e]; S1[4 * q + e] *= g1[e]; } }
    S0 = MF(*(const LAS bf16x8*)(slot + O_BGT + t_off(r, hq)), fU, S0);
    S1 = MF(*(const LAS bf16x8*)(slot + O_BGT + t_off(32 + r, hq)), fU, S1);
    S0 = MF(*(const LAS bf16x8*)(slot + O_KGT + t_off(r, hq)), fVT, S0);
    S1 = MF(*(const LAS bf16x8*)(slot + O_KGT + t_off(32 + r, hq)), fVT, S1);
}
#undef MF
}

#define SCAN_SPIN_CAP (1u << 21)
__device__ __forceinline__ void scan_wait(volatile LAS int* f, int target, volatile LAS int* tmo) {
    unsigned sp = 0;
    while (*f < target) { __builtin_amdgcn_s_sleep(1); if (++sp > SCAN_SPIN_CAP || *tmo) { *tmo = 1; break; } }
    asm volatile("" ::: "memory");
}
__device__ __forceinline__ void scan_epilogue(const wkv::Tensors& T, LAS unsigned char* oent, size_t grow_c, int h, int lane, const v4u& va, const v4u& vb, const v4u& ga, const v4u& gb) {
    const int i = lane >> 2, vq = lane & 3;
    float o[16], s = 0.f;
#pragma unroll
    for (int m = 0; m < 4; ++m) { const f32x4 x = *(const LAS f32x4*)(oent + (i * 64 + 16 * vq + 4 * m) * 4); o[4 * m] = x[0]; o[4 * m + 1] = x[1]; o[4 * m + 2] = x[2]; o[4 * m + 3] = x[3]; s += (x[0] + x[1]) + (x[2] + x[3]); }
    const float bonus = *(const LAS float*)(oent + 4096 + 4 * i);
    s += __builtin_bit_cast(float, __builtin_amdgcn_update_dpp(0, __builtin_bit_cast(int, s), 0xB1, 0xf, 0xf, false));
    s += __builtin_bit_cast(float, __builtin_amdgcn_update_dpp(0, __builtin_bit_cast(int, s), 0x4E, 0xf, 0xf, false));
    const float mean = s * (1.f / 64.f); float s2 = 0.f;
#pragma unroll
    for (int m = 0; m < 16; ++m) { o[m] -= mean; s2 += o[m] * o[m]; }
    s2 += __builtin_bit_cast(float, __builtin_amdgcn_update_dpp(0, __builtin_bit_cast(int, s2), 0xB1, 0xf, 0xf, false));
    s2 += __builtin_bit_cast(float, __builtin_amdgcn_update_dpp(0, __builtin_bit_cast(int, s2), 0x4E, 0xf, 0xf, false));
    const float rstd = __builtin_amdgcn_rsqf(s2 * (1.f / 64.f) + GN_EPS);
    const size_t ge = (grow_c + i) * 2048 + h * 64 + 16 * vq;
    const unsigned vw[8] = {va.x, va.y, va.z, va.w, vb.x, vb.y, vb.z, vb.w}, gw[8] = {ga.x, ga.y, ga.z, ga.w, gb.x, gb.y, gb.z, gb.w};
    unsigned ow[8];
#pragma unroll
    for (int m = 0; m < 8; ++m) { const int col = h * 64 + 16 * vq + 2 * m;
        const float r0 = (o[2 * m] * rstd * T.gn_w[col] + T.gn_b[col] + bonus * bflo(vw[m])) * bflo(gw[m]);
        const float r1 = (o[2 * m + 1] * rstd * T.gn_w[col + 1] + T.gn_b[col + 1] + bonus * bfhi(vw[m])) * bfhi(gw[m]);
        ow[m] = pk2(r0, r1); }
    *(GAS v4u*)(T.OG + ge) = (v4u){ow[0], ow[1], ow[2], ow[3]}; *(GAS v4u*)(T.OG + ge + 8) = (v4u){ow[4], ow[5], ow[6], ow[7]};
}
constexpr int G_RG = 16, G_ESTR = 12800;
static_assert((size_t)BATCH * 32 * G_RG * G_ESTR <= 34 * MiB && wkv::SLOT <= G_ESTR, "image rings");
__device__ __forceinline__ bool gwait(unsigned* f, unsigned target, volatile LAS int* tmo) {
    unsigned sp = 0;
    while (__hip_atomic_load(f, __ATOMIC_RELAXED, __HIP_MEMORY_SCOPE_AGENT) < target) { __builtin_amdgcn_s_sleep(2); if (++sp > SCAN_SPIN_CAP || *tmo) { *tmo = 1; return false; } }
    return true;
}
__device__ __forceinline__ void scan_phase_split(Frame& F, const Args& a) {
    wkv::Tensors T;
    T.R = (const unsigned short*)(a.ws + WS_R); T.K = (const unsigned short*)(a.ws + WS_K2); T.V = (const unsigned short*)(a.ws + WS_V2); T.SG = (const unsigned short*)(a.ws + WS_SG);
    T.LOGW = (const unsigned short*)(a.ws + WS_LOGW); T.AA = (const unsigned short*)(a.ws + WS_AA); T.OG = (unsigned short*)(a.ws + WS_OG);
    T.k_k = a.in[16]; T.k_a = a.in[17]; T.r_k = a.in[18]; T.gn_w = a.in[19]; T.gn_b = a.in[20];
    PHASE_TID();
    constexpr int NCH = SEQ / 16, NP = NCH / 2, NH = BATCH * 32;
    const int j = F.vcu % NH, b = j >> 5, h = j & 31;
    const size_t grow0 = (size_t)b * SEQ;
    unsigned char* gring = a.ws + WS_GRING + (size_t)j * G_RG * G_ESTR;
    unsigned* gfl = (unsigned*)(F.ctl + CW_GFL) + j * 32;
    if (F.vcu >= 2 * NH) return;
    if (F.vcu >= NH) {
        volatile LAS int* tmo = (volatile LAS int*)(F.MISC + 16);
        if (tid == 0) *tmo = 0;
        __syncthreads();
        LAS unsigned char* slot = F.lds + RING_OFF + wave * (G_ESTR + 4096); LAS unsigned char* bk = slot + G_ESTR;
        const __amdgpu_buffer_rsrc_t rsrc = __builtin_amdgcn_make_buffer_rsrc((void*)gring, (short)0, G_RG * G_ESTR, 0x00020000);
        wkv::Raw raw;
        wkv::prep_load(T, grow0 + (size_t)(2 * wave + 1) * 16, h, lane, raw);
#pragma unroll 1
        for (int P = wave; P < NP; P += 8) {
            wkv::prep_elem(T, raw, h, slot, bk, lane, [&]() {});
            if (P + 8 < NP) wkv::prep_load(T, grow0 + (size_t)(2 * (P + 8) + 1) * 16, h, lane, raw);
            wkv::prep_mfma(slot, bk, lane);
            LDS_WAIT(); asm volatile("" ::: "memory");
            const int en = P & (G_RG - 1);
            if (P >= G_RG) (void)gwait(gfl + 16 + en, (unsigned)(P - G_RG + 1), tmo);
#pragma unroll
            for (int k = 0; k < 13; ++k) { if (k < 12 || lane < 20) { const wkv::u32x4 v = *(const LAS wkv::u32x4*)(slot + k * 1024 + lane * 16);
                __builtin_amdgcn_raw_buffer_store_b128(v, rsrc, en * G_ESTR + k * 1024 + lane * 16, 0, 16  ); } }
            asm volatile("s_waitcnt vmcnt(0)" ::: "memory");
            if (lane == 0) __hip_atomic_store(gfl + en, (unsigned)(P + 1), __ATOMIC_RELAXED, __HIP_MEMORY_SCOPE_AGENT);
        }
        __syncthreads();
        {
            constexpr int I_SQ = (DM / 64) * (DM / 32);
            LAS float* scr = (LAS float*)(F.lds + RING_OFF + wave * 16384);
            for (int it = (F.vcu - NH) * NWAVES + wave; it < I_SQ; it += NH * NWAVES) p0_transpose_item(a.in[21], DM, (bf16*)(a.ws + WS_WOT), DM, 0, scr, it, lane);
        }
        return;
    }
    volatile LAS int* FL = (volatile LAS int*)(F.lds + wkv::L_FLAGS);
    volatile LAS int* ready = FL; volatile LAS int* cons0 = FL + 8; volatile LAS int* cons1 = FL + 16; volatile LAS int* freed = FL + 24; volatile LAS int* tmo = FL + 32;
    __syncthreads();
    if (tid < 40) FL[tid] = 0;
    __syncthreads();
    if (wave < 2) {
        wkv::f32x16 S0 = {}, S1 = {};
        volatile LAS int* mycons = wave ? cons1 : cons0;
#pragma unroll 1
        for (int c = 0; c < NCH; ++c) { const int sl = c & 7;
            scan_wait(ready + sl, c + 1, tmo);
            if (c >= 8) scan_wait(freed + sl, c - 7, tmo);
            LAS unsigned char* slot = F.lds + sl * wkv::SLOT; LAS unsigned char* oent = F.lds + wkv::L_ORING + sl * wkv::OENT;
            if (wave == 0 && lane < 16) *(LAS float*)(oent + 4096 + 4 * lane) = *(const LAS float*)(slot + wkv::O_BON + 4 * lane);
            wkv::chunk_step(slot, oent, S0, S1, wave, lane);
            LDS_WAIT(); asm volatile("" ::: "memory");
            if (lane == 0) mycons[sl] = c + 1;
        }
    } else {
        const int p = wave - 2;
        LAS unsigned char* bk = F.lds + wkv::L_BK + p * 4096;
        float kkc[2], kac[2], rkc[2];
#pragma unroll
        for (int e_ = 0; e_ < 2; ++e_) { const int col = h * 64 + 2 * (lane & 31) + e_; kkc[e_] = T.k_k[col]; kac[e_] = T.k_a[col]; rkc[e_] = T.r_k[col]; }
        wkv::Raw raw;
        wkv::prep_load(T, grow0 + (size_t)(2 * p) * 16, h, lane, raw);
        unsigned nflag = __hip_atomic_load(gfl + (p & (G_RG - 1)), __ATOMIC_RELAXED, __HIP_MEMORY_SCOPE_AGENT);
#pragma unroll 1
        for (int P = p; P < NP + 2; P += 6) {
            const int c0 = 2 * P, c1 = c0 + 1, Pe = P - 2, e0 = 2 * Pe, e1 = e0 + 1;
            const bool has = P < NP, hasE = Pe >= 0, hasN = P + 6 < NP;
            v4u va0 = {0u, 0u, 0u, 0u}, vb0 = va0, ga0 = va0, gb0 = va0, va1 = va0, vb1 = va0, ga1 = va0, gb1 = va0;
            auto epi_loads = [&]() { if (hasE) {
                const size_t g0 = (grow0 + (size_t)e0 * 16 + (lane >> 2)) * 2048 + h * 64 + 16 * (lane & 3), g1 = g0 + (size_t)16 * 2048;
                va0 = *(const GAS v4u*)(T.V + g0); vb0 = *(const GAS v4u*)(T.V + g0 + 8); ga0 = *(const GAS v4u*)(T.SG + g0); gb0 = *(const GAS v4u*)(T.SG + g0 + 8);
                va1 = *(const GAS v4u*)(T.V + g1); vb1 = *(const GAS v4u*)(T.V + g1 + 8); ga1 = *(const GAS v4u*)(T.SG + g1); gb1 = *(const GAS v4u*)(T.SG + g1 + 8); } };
            if (has) { const int sl0 = c0 & 7, sl1 = c1 & 7, en = P & (G_RG - 1);
                if (c1 >= 8) { scan_wait(cons0 + sl1, c1 - 7, tmo); scan_wait(cons1 + sl1, c1 - 7, tmo); }
                if (nflag < (unsigned)(P + 1)) (void)gwait(gfl + en, (unsigned)(P + 1), tmo);
                if (hasN) nflag = __hip_atomic_load(gfl + ((P + 6) & (G_RG - 1)), __ATOMIC_RELAXED, __HIP_MEMORY_SCOPE_AGENT);
                { const unsigned char* ge = gring + (size_t)en * G_ESTR + lane * 16; LAS unsigned char* ls = F.lds + sl1 * wkv::SLOT;
#pragma unroll
                  for (int k = 0; k < 13; ++k) { if (k < 12 || lane < 20) __builtin_amdgcn_global_load_lds((const unsigned*)(ge + k * 1024), (LAS unsigned*)(ls + k * 1024), 16, 0, 17  ); } }
                wkv::prep_elem_kv(T, raw, h, F.lds + sl0 * wkv::SLOT, bk, lane, kkc, kac, rkc, [&]() { epi_loads(); if (c0 >= 8) { scan_wait(cons0 + sl0, c0 - 7, tmo); scan_wait(cons1 + sl0, c0 - 7, tmo); } });
                if (hasN) wkv::prep_load(T, grow0 + (size_t)(c0 + 12) * 16, h, lane, raw);
                wkv::prep_mfma(F.lds + sl0 * wkv::SLOT, bk, lane);
                LDS_WAIT(); asm volatile("" ::: "memory");
                if (lane == 0) ready[sl0] = c0 + 1;
                if (hasE) { if (hasN) asm volatile("s_waitcnt vmcnt(48)" ::: "memory"); else asm volatile("s_waitcnt vmcnt(8)" ::: "memory"); }
                else      { if (hasN) asm volatile("s_waitcnt vmcnt(40)" ::: "memory"); else asm volatile("s_waitcnt vmcnt(0)" ::: "memory"); }
                if (lane == 0) { ready[sl1] = c1 + 1; __hip_atomic_store(gfl + 16 + en, (unsigned)(P + 1), __ATOMIC_RELAXED, __HIP_MEMORY_SCOPE_AGENT); }
            } else epi_loads();
            if (hasE) {
#pragma unroll
                for (int i_ = 0; i_ < 8; ++i_) asm volatile("" : "+v"(raw.r[i_]), "+v"(raw.k[i_]), "+v"(raw.v[i_]), "+v"(raw.l[i_]), "+v"(raw.a[i_]));
                { const int se = e0 & 7; scan_wait(cons0 + se, e0 + 1, tmo); scan_wait(cons1 + se, e0 + 1, tmo);
                  scan_epilogue(T, F.lds + wkv::L_ORING + se * wkv::OENT, grow0 + (size_t)e0 * 16, h, lane, va0, vb0, ga0, gb0);
                  LDS_WAIT(); asm volatile("" ::: "memory"); if (lane == 0) freed[se] = e0 + 1; }
                { const int se = e1 & 7; scan_wait(cons0 + se, e1 + 1, tmo); scan_wait(cons1 + se, e1 + 1, tmo);
                  scan_epilogue(T, F.lds + wkv::L_ORING + se * wkv::OENT, grow0 + (size_t)e1 * 16, h, lane, va1, vb1, ga1, gb1);
                  LDS_WAIT(); asm volatile("" ::: "memory"); if (lane == 0) freed[se] = e1 + 1; }
            }
        }
    }
    __syncthreads();
}
__device__ __forceinline__ void scan_phase(Frame& F, const Args& a) {
    wkv::Tensors T;
    T.R = (const unsigned short*)(a.ws + WS_R); T.K = (const unsigned short*)(a.ws + WS_K2); T.V = (const unsigned short*)(a.ws + WS_V2); T.SG = (const unsigned short*)(a.ws + WS_SG);
    T.LOGW = (const unsigned short*)(a.ws + WS_LOGW); T.AA = (const unsigned short*)(a.ws + WS_AA); T.OG = (unsigned short*)(a.ws + WS_OG);
    T.k_k = a.in[16]; T.k_a = a.in[17]; T.r_k = a.in[18]; T.gn_w = a.in[19]; T.gn_b = a.in[20];
    PHASE_TID();
    constexpr int NCH = SEQ / 16, NPREP = wkv::NPREP;
    if (F.vcu >= BATCH * 32) {
        constexpr int I_SQ = (DM / 64) * (DM / 32);
        LAS float* scr = (LAS float*)(F.lds + RING_OFF + wave * 16384);
        for (int it = (F.vcu - BATCH * 32) * NWAVES + wave; it < I_SQ; it += (F.G - BATCH * 32) * NWAVES) p0_transpose_item(a.in[21], DM, (bf16*)(a.ws + WS_WOT), DM, 0, scr, it, lane);
        return;
    }
    volatile LAS int* FL = (volatile LAS int*)(F.lds + wkv::L_FLAGS);
    volatile LAS int* ready = FL; volatile LAS int* cons0 = FL + 8; volatile LAS int* cons1 = FL + 16; volatile LAS int* freed = FL + 24; volatile LAS int* tmo = FL + 32;
    for (int bh = F.vcu; bh < BATCH * 32; bh += F.G) {
        const int b = bh >> 5, h = bh & 31;
        const size_t grow0 = (size_t)b * SEQ;
        __syncthreads();
        if (tid < 40) FL[tid] = 0;
        __syncthreads();
        if (wave < 2) {
            wkv::f32x16 S0 = {}, S1 = {};
            volatile LAS int* mycons = wave ? cons1 : cons0;
#pragma unroll 1
            for (int c = 0; c < NCH; ++c) { const int sl = c & 7;
                scan_wait(ready + sl, c + 1, tmo);
                if (c >= 8) scan_wait(freed + sl, c - 7, tmo);
                LAS unsigned char* slot = F.lds + sl * wkv::SLOT; LAS unsigned char* oent = F.lds + wkv::L_ORING + sl * wkv::OENT;
                if (wave == 0 && lane < 16) *(LAS float*)(oent + 4096 + 4 * lane) = *(const LAS float*)(slot + wkv::O_BON + 4 * lane);
                wkv::chunk_step(slot, oent, S0, S1, wave, lane);
                LDS_WAIT(); asm volatile("" ::: "memory");
                if (lane == 0) mycons[sl] = c + 1;
            }
        } else {
            const int p = wave - 2;
            LAS unsigned char* bk = F.lds + wkv::L_BK + p * 4096;
            wkv::Raw raw;
            wkv::prep_load(T, grow0 + (size_t)p * 16, h, lane, raw);
#pragma unroll 1
            for (int c = p; c < NCH + NPREP; c += NPREP) {
                const int e = c - NPREP;
                v4u va = {0u, 0u, 0u, 0u}, vb = va, ga = va, gb = va;
                const size_t ge = (grow0 + (size_t)(e < 0 ? 0 : e) * 16 + (lane >> 2)) * 2048 + h * 64 + 16 * (lane & 3);
                auto epi_loads = [&]() { if (e >= 0) { va = *(const GAS v4u*)(T.V + ge); vb = *(const GAS v4u*)(T.V + ge + 8); ga = *(const GAS v4u*)(T.SG + ge); gb = *(const GAS v4u*)(T.SG + ge + 8); } };
                if (c < NCH) { const int sl = c & 7;
                    wkv::prep_elem(T, raw, h, F.lds + sl * wkv::SLOT, bk, lane, [&]() { epi_loads(); if (c >= 8) { scan_wait(cons0 + sl, c - 7, tmo); scan_wait(cons1 + sl, c - 7, tmo); } });
                    if (c + NPREP < NCH) wkv::prep_load(T, grow0 + (size_t)(c + NPREP) * 16, h, lane, raw);
                    wkv::prep_mfma(F.lds + sl * wkv::SLOT, bk, lane);
                    LDS_WAIT(); asm volatile("" ::: "memory");
                    if (lane == 0) ready[sl] = c + 1;
                }
                if (c >= NCH) epi_loads();
                if (e >= 0) { const int se = e & 7;
                    scan_wait(cons0 + se, e + 1, tmo); scan_wait(cons1 + se, e + 1, tmo);
#pragma unroll
                    for (int i_ = 0; i_ < 8; ++i_) asm volatile("" : "+v"(raw.r[i_]), "+v"(raw.k[i_]), "+v"(raw.v[i_]), "+v"(raw.l[i_]), "+v"(raw.a[i_]));
                    scan_epilogue(T, F.lds + wkv::L_ORING + se * wkv::OENT, grow0 + (size_t)e * 16, h, lane, va, vb, ga, gb);
                    LDS_WAIT(); asm volatile("" ::: "memory");
                    if (lane == 0) freed[se] = e + 1;
                }
            }
        }
    }
    __syncthreads();
    if (F.G <= BATCH * 32) {
        constexpr int I_SQ = (DM / 64) * (DM / 32);
        LAS float* scr = (LAS float*)(F.lds + RING_OFF + wave * 16384);
        for (int it = F.vcu * NWAVES + wave; it < I_SQ; it += F.G * NWAVES) p0_transpose_item(a.in[21], DM, (bf16*)(a.ws + WS_WOT), DM, 0, scr, it, lane);
    }
}

__global__ void __launch_bounds__(NWAVES * 64, 2) fwd_kernel(Args args) {
    extern __shared__ __attribute__((aligned(16))) unsigned char lds[];
    Frame F;
    F.lds = (LAS unsigned char*)lds;
    F.MISC = (volatile LAS unsigned*)(F.lds + MISC_OFF);
    F.G = gridDim.x; { const int bx = blockIdx.x; F.vcu = (F.G % 8 == 0) ? (bx % 8) * (F.G / 8) + bx / 8 : bx; }
    unsigned char* ws = args.ws;
    F.ctl = (gu32*)(ws + WS_CTL);
    for (int u = threadIdx.x; u < (LDS_BYTES - LDSCTL_OFF) / 4; u += NWAVES * 64) ((LAS unsigned*)(F.lds + LDSCTL_OFF))[u] = 0u;
    __syncthreads();
    XcdBarrier bar; bar.bar = (unsigned*)(F.ctl + CW_BAR); bar.x = 0; bar.st = nullptr;
    if (N_LAUNCHES == 1) bar = xcd_barrier_post((unsigned*)(F.ctl + CW_BAR), F.MISC + 8);
#define GRID_BAR() do { if (N_LAUNCHES == 1) xcd_barrier(bar); } while (0)
    const int lo = args.ph_lo, hi = args.ph_hi;
#ifndef PH_MASK
#define PH_MASK 0xFFF
#endif
#define IN(k) ((((PH_MASK) >> (k)) & 1) && lo <= (k) && (k) < hi)
#define BOTH(k) (IN(k) && IN((k) + 1))
#ifndef REPEAT_MASK
#define REPEAT_MASK 0
#endif
#define REPS(k) for (int rep_ = 0; rep_ < 1 + (((REPEAT_MASK) >> (k)) & 1); ++rep_) if (((rep_ > 0 && N_LAUNCHES == 1) ? (xcd_barrier(bar), 0) : 0), true)
    bf16* H = (bf16*)(ws + WS_H); bf16* MIX = (bf16*)(ws + WS_MIX);

    if (IN(0)) { REPS(0) p0_prologue(F, args); if (BOTH(0)) GRID_BAR(); }

    if (IN(1)) { REPS(1) {
        pg8::Gemm g{(const bf16*)(ws + WS_XB), (const bf16*)(ws + WS_WINT), M, EVEN_IN, DM, DM, DM, 0, 0};
        pg8::StaticOrder S; S.init(M, EVEN_IN, F.G, (int)blockIdx.x);
        pg8::EpiH E{H};
        pg8::gemm_phase<pg8::EpiH, pg8::StaticOrder>(F.lds + RING_OFF, g, S, E); }
        if (BOTH(1)) GRID_BAR();
    }

    if (IN(2)) { REPS(2) {
        const bool weights_first = (F.vcu & 1) != 0;
        if (weights_first) { late_weights(F, args); __syncthreads(); }
#ifndef NO_POOL
        for (int rp_ = 0; rp_ < 1 + (((REPEAT_MASK) >> 12) & 1); ++rp_) {
            if (rp_ > 0 && N_LAUNCHES == 1) xcd_barrier(bar);
            pg8::StaticOrder SO; SO.init(M, 1024, F.G, (int)blockIdx.x); pg8::Unit u;
            bf16* POOLED = (bf16*)(ws + WS_POOLED);
            for (int i = 0; SO.next(i, u); ++i) {
                pool_tile(F, H, POOLED, u.pm, u.pn);
                VM_WAIT(); __syncthreads();
                if (threadIdx.x == 0) { __builtin_amdgcn_fence(__ATOMIC_ACQUIRE, "agent"); VM_WAIT(); }
                __syncthreads();
                pg8::Gemm g{POOLED, (const bf16*)(ws + WS_WPOOLT), M, 1024, 256, 1024, 256, 1, 256};
                pg8::OneUnit S1{u};
                pg8::EpiPool E{MIX, H, args.in[3]};
                pg8::gemm_phase<pg8::EpiPool, pg8::OneUnit>(F.lds + RING_OFF, g, S1, E);
            }
        }
#endif
#ifndef NO_ATTN
        for (int rp_ = 0; rp_ < 1 + (((REPEAT_MASK) >> 13) & 1); ++rp_) {
            if (rp_ > 0 && N_LAUNCHES == 1) xcd_barrier(bar);
            const sba::bf16* Hb = (const sba::bf16*)H; sba::bf16* Mb = (sba::bf16*)MIX;
            for (int item = F.vcu; item < 256; item += F.G) {
                const int bh = item >> 3, x = item & 7, b = bh >> 3, h = bh & 7;
                const size_t rowbase = (size_t)b * SEQ;
                const sba::bf16* Kp = Hb + rowbase * 6144 + 1024 + h * 128; const sba::bf16* Vp = Hb + rowbase * 6144 + 2048 + h * 128;
#pragma unroll 1
                for (int pass = 0; pass < 2; ++pass) {
                    const int qb = pass ? 15 - x : x; sba::BlockRef br;
                    br.P0 = qb * 256; br.Q = Hb + (rowbase + br.P0) * 6144 + h * 128; br.K = Kp; br.V = Vp; br.G = Hb + (rowbase + br.P0) * 6144 + 3072 + h * 128; br.O = Mb + (rowbase + br.P0) * 2048 + h * 128;
                    sba::sb_block(br, (char*)lds + RING_OFF);
                }
            }
        }
#endif
        if (!weights_first) { __syncthreads(); late_weights(F, args); }
        }
        if (BOTH(2)) GRID_BAR();
    }

    if (IN(3)) { REPS(3) {
        pg8::Gemm g{MIX, (const bf16*)(ws + WS_WOUTT), M, DM, DM, DM, DM, 0, 0};
        pg8::StaticOrder S; S.init(M, DM, F.G, (int)blockIdx.x);
        pg8::EpiY E{(bf16*)(ws + WS_Y0)};
        pg8::gemm_phase<pg8::EpiY, pg8::StaticOrder>(F.lds + RING_OFF, g, S, E); }
        if (BOTH(3)) GRID_BAR();
    }

    if (IN(4)) { REPS(4) ln_mix_phase(F, args); if (BOTH(4)) GRID_BAR(); }

    if (IN(5)) { REPS(5) {
        pg8::Gemm g{(const bf16*)(ws + WS_XMIX), (const bf16*)(ws + WS_W2CAT), M, N2CAT, DM, DM, DM, 2, (size_t)M * DM};
        pg8::ArrayOrder S; S.init(M, F.G, (int)blockIdx.x);
        pg8::Epi5 E{{(bf16*)(ws + WS_R), (bf16*)(ws + WS_K2), (bf16*)(ws + WS_V2), (bf16*)(ws + WS_SG)}, (bf16*)(ws + WS_TL), (unsigned*)(F.ctl + CW_ACNT), (unsigned)((M / 256) * 8)};
        pg8::gemm_phase<pg8::Epi5, pg8::ArrayOrder, true, true, true>(F.lds + RING_OFF, g, S, E);
        { unsigned* acnt = (unsigned*)(F.ctl + CW_ACNT);
          if (threadIdx.x == 0) { unsigned sp = 0; while (__hip_atomic_load(acnt + 4, __ATOMIC_RELAXED, __HIP_MEMORY_SCOPE_AGENT) < (unsigned)(2 * (M / 256))) { __builtin_amdgcn_s_sleep(4); if (++sp > (1u << 22)) break; } }
          __syncthreads(); __builtin_amdgcn_fence(__ATOMIC_ACQUIRE, "agent");
          pg8::Gemm g8{(const bf16*)(ws + WS_TL), (const bf16*)(ws + WS_L2T), M, 4096, 256, 256, 256, 0, 0};
          pg8::TailOrder S8; S8.init(F.G, (int)blockIdx.x, 2 * (M / 256));
          pg8::Epi6 E8{(unsigned short*)(ws + WS_LOGW), (unsigned short*)(ws + WS_AA), args.in[10], args.in[13]};
          pg8::gemm_phase<pg8::Epi6, pg8::TailOrder>(F.lds + RING_OFF, g8, S8, E8); } }
        if (BOTH(5)) GRID_BAR();
    }

    if (IN(9)) { REPS(9) { if (F.G >= 2 * BATCH * 32) scan_phase_split(F, args); else scan_phase(F, args); } if (BOTH(9)) GRID_BAR(); }

    if (IN(10)) {
        pg8::Gemm g{(const bf16*)(ws + WS_OG), (const bf16*)(ws + WS_WOT), M, DM, DM, DM, DM, 0, 0};
        pg8::StaticOrder S; S.init(M, DM, F.G, (int)blockIdx.x);
        pg8::EpiY E{(bf16*)(ws + WS_Y1)};
        pg8::gemm_phase<pg8::EpiY, pg8::StaticOrder>(F.lds + RING_OFF, g, S, E);
        if (BOTH(10)) GRID_BAR();
    }

    if (IN(11)) { final_ln_phase(F, args); }
#undef IN
#undef BOTH
#undef GRID_BAR
}

extern "C" void kernel_launch(void* const* d_in, const int* in_sizes, int n_in, void* d_out, int out_size, void* d_ws, size_t ws_size, hipStream_t stream) {
    static int grid = 0;
    if (grid == 0) {
        if (n_in != 24 || in_sizes[0] != M * DM || out_size != M * DM || ws_size < WS_END) { fprintf(stderr, "kernel_launch: shape/workspace mismatch (n_in %d, in0 %d, out %d, ws %zu, need %zu)\n", n_in, n_in > 0 ? in_sizes[0] : -1, out_size, ws_size, (size_t)WS_END); grid = -1; return; }
        int dev = 0, cus = 0;
        if (hipGetDevice(&dev) != hipSuccess || hipDeviceGetAttribute(&cus, hipDeviceAttributeMultiprocessorCount, dev) != hipSuccess) { grid = -1; return; }
        if (hipFuncSetAttribute((const void*)fwd_kernel, hipFuncAttributeMaxDynamicSharedMemorySize, LDS_BYTES) != hipSuccess) { fprintf(stderr, "kernel_launch: hipFuncSetAttribute failed\n"); grid = -1; return; }
        int per_cu = 0;
        if (hipOccupancyMaxActiveBlocksPerMultiprocessor(&per_cu, (const void*)fwd_kernel, NWAVES * 64, LDS_BYTES) != hipSuccess || per_cu < 1) fprintf(stderr, "kernel_launch: occupancy query says %d\n", per_cu);
        (void)hipGetLastError();
        grid = cus;
    }
    if (grid < 0) return;
    if (hipMemsetAsync((char*)d_ws + WS_CTL, 0, CTL_ZERO_BYTES, stream) != hipSuccess) return;
    Args a{};
    for (int i = 0; i < 24; ++i) a.in[i] = (const float*)d_in[i];
    a.out = (float*)d_out; a.ws = (unsigned char*)d_ws;
    if (N_LAUNCHES == 1) { a.ph_lo = 0; a.ph_hi = N_PHASES; a.li = 0; hipLaunchKernelGGL(fwd_kernel, dim3(grid), dim3(NWAVES * 64), LDS_BYTES, stream, a); }
    else for (int li = 0; li < N_PHASES; ++li) { a.ph_lo = li; a.ph_hi = li + 1; a.li = li; hipLaunchKernelGGL(fwd_kernel, dim3(grid), dim3(NWAVES * 64), LDS_BYTES, stream, a); }
}
```

```cpp
#include <hip/hip_runtime.h>
#include <hip/hip_bf16.h>
#include <cstdio>
#include <cstdint>

#ifndef MK_N_LAUNCHES
#define MK_N_LAUNCHES 1
#endif

namespace pg8 {
#define PG8_LAS __attribute__((address_space(3)))
typedef unsigned short bf16_t;
typedef short bf16x8 __attribute__((ext_vector_type(8)));
typedef float f32x4 __attribute__((ext_vector_type(4)));
typedef float f32x2 __attribute__((ext_vector_type(2)));
typedef unsigned u32x4 __attribute__((ext_vector_type(4)));
constexpr int BM = 256, BK = 64, HALF = 128, HTB = HALF * BK * 2, STAGE_BYTES = 8 * HTB, NXCD = 8, WGM = 8;

__host__ __device__ __forceinline__ int lds_byte(int r, int c) { const int st = (r >> 4) * 2 + (c >> 5), rr = r & 15, cc = c & 31, ob = rr * 64 + cc * 2; return st * 1024 + (ob ^ (((ob >> 9) & 1) << 5)); }
__host__ __device__ __forceinline__ void stage_rc(int b, int& R, int& C) { const int st = b / 1024, sb = b % 1024, swz = sb ^ (((sb >> 9) & 1) << 5); R = (st >> 1) * 16 + swz / 64; C = (st & 1) * 32 + (swz % 64) / 2; }
__host__ __device__ __forceinline__ int perm32(int rho) { const int n = rho >> 4, i = rho & 15; return 8 * (i >> 2) + 4 * n + (i & 3); }

struct Unit { int pm, pn; };
struct Gemm { const bf16_t* A; const bf16_t* Bt; int M, N, K, lda, ldb; int asel; size_t astride; };
__device__ __forceinline__ const bf16_t* a_base(const Gemm& g, const Unit& u) {
    int idx = 0;
    if (g.asel == 1) idx = u.pn;
    else if (g.asel == 2) idx = u.pn < 32 ? (u.pn >> 3) : (u.pn - 28);
    else if (g.asel == 3) idx = u.pn >> 3;
    return g.A + (size_t)idx * g.astride;
}

struct StaticOrder {
    int nM, nN, nwg, G, c;
    __host__ __device__ void init(int M, int N, int G_, int c_) { nM = M / BM; nN = N / BM; nwg = nM * nN; G = G_; c = c_; }
    __host__ __device__ bool next(int i, Unit& u) const { return next_at((long)i * G + c, u); }
    __host__ __device__ bool next_at(long L, Unit& u) const {
        if (L >= nwg) return false;
        int wgid = (int)L; { const int q = nwg / NXCD, r = nwg % NXCD, xcd = wgid % NXCD, off = wgid / NXCD; wgid = (xcd < r ? xcd * (q + 1) : r * (q + 1) + (xcd - r) * q) + off; }
        const int nig = WGM * nN, gid = wgid / nig, fm = gid * WGM, gsz = (nM - fm) < WGM ? (nM - fm) : WGM;
        u.pm = fm + ((wgid % nig) % gsz); u.pn = (wgid % nig) / gsz; return true;
    }
};
struct ArrayOrder {
    StaticOrder sub; int nm;
    __host__ __device__ void init(int M, int G_, int c_) { sub.init(M, 2048, G_, c_); nm = M / BM; }
    __host__ __device__ bool next(int i, Unit& u) const {
        const long L0 = (long)i * sub.G + sub.c; const long per = sub.nwg, nl = 2 * nm;
        if (L0 < nl) { u.pm = (int)(L0 >> 1); u.pn = 32 + (int)(L0 & 1); return true; }
        const long L = L0 - nl; if (L >= 4 * per) return false;
        const int a = (int)(L / per); sub.next_at(L - a * per, u); u.pn += 8 * a; return true;
    }
};
struct TailOrder { int first, n;
    __host__ __device__ void init(int G_, int c_, int nlora) { const int c = c_; const bool late = c < nlora;
        const int nearly = G_ - nlora; const int per_late = nearly > 0 ? 1 : (1024 + G_ - 1) / G_, late_total = per_late * (nlora < G_ ? nlora : G_);
        if (late) { first = c * per_late; n = per_late; } else { const int rest = 1024 - late_total, per = (rest + nearly - 1) / nearly; first = late_total + (c - nlora) * per; n = per; }
        if (first > 1024) first = 1024; if (first + n > 1024) n = 1024 - first; }
    __host__ __device__ bool next(int i, Unit& u) const { if (i >= n) return false; const int j = first + i; u.pm = j >> 4; u.pn = j & 15; return true; } };
struct OneUnit { Unit u0; __device__ __forceinline__ bool next(int i, Unit& u) const { if (i != 0) return false; u = u0; return true; } };

typedef __bf16 bf16x2_t __attribute__((ext_vector_type(2)));
__device__ __forceinline__ unsigned cvt_pk_bf16(float lo, float hi) { f32x2 v = {lo, hi}; bf16x2_t b = __builtin_convertvector(v, bf16x2_t); return __builtin_bit_cast(unsigned, b); }
__device__ __forceinline__ float bf_lo(unsigned w) { return __uint_as_float(w << 16); }
__device__ __forceinline__ float bf_hi(unsigned w) { return __uint_as_float(w & 0xffff0000u); }
__device__ __forceinline__ float sigmoidf_(float x) { return __builtin_amdgcn_rcpf(1.0f + __builtin_amdgcn_exp2f(-1.4426950408889634f * x)); }
__device__ __forceinline__ float siluf_(float x) { return x * sigmoidf_(x); }
__device__ __forceinline__ float tanhf_(float x) { return 1.0f - 2.0f * __builtin_amdgcn_rcpf(1.0f + __builtin_amdgcn_exp2f(2.8853900817779268f * x)); }

constexpr float QSCALE2 = 0.08838834764831845f * 1.4426950408889634f;

struct EpiH {
    static constexpr bool PERM = true;
    bf16_t* O;
    __device__ __forceinline__ void operator()(const f32x4 (&acc)[2][2][4][2], const Unit& u, int wr, int wc, int fr, int fq) const {
        const int row0 = u.pm * BM + wr * 64 + fr, col0 = u.pn * BM + wc * 32 + 8 * fq;
        const int mode = u.pn < 4 ? 1 : (((u.pn >= 12 && u.pn < 16) || u.pn >= 20) ? 2 : 0);
#pragma unroll
        for (int ai = 0; ai < 2; ++ai)
#pragma unroll
            for (int m = 0; m < 4; ++m) { bf16_t* rowp = O + (size_t)(row0 + ai * HALF + m * 16) * 6144 + col0;
#pragma unroll
                for (int bj = 0; bj < 2; ++bj) { f32x4 v0 = acc[ai][bj][m][0], v1 = acc[ai][bj][m][1];
                    if (mode == 1) { v0 = v0 * QSCALE2; v1 = v1 * QSCALE2; }
                    else if (mode == 2) {
#pragma unroll
                        for (int e = 0; e < 4; ++e) { v0[e] = siluf_(v0[e]); v1[e] = siluf_(v1[e]); } }
                    u32x4 w; w.x = cvt_pk_bf16(v0[0], v0[1]); w.y = cvt_pk_bf16(v0[2], v0[3]); w.z = cvt_pk_bf16(v1[0], v1[1]); w.w = cvt_pk_bf16(v1[2], v1[3]);
                    *(u32x4*)(rowp + bj * HALF) = w; } }
    }
};
struct EpiPool {
    static constexpr bool PERM = true;
    bf16_t* MIX; const bf16_t* Hb; const float* pscale;
    __device__ __forceinline__ void operator()(const f32x4 (&acc)[2][2][4][2], const Unit& u, int wr, int wc, int fr, int fq) const {
        const int row0 = u.pm * BM + wr * 64 + fr, col0 = u.pn * BM + wc * 32 + 8 * fq;
#pragma unroll
        for (int ai = 0; ai < 2; ++ai)
#pragma unroll
            for (int m = 0; m < 4; ++m) { const size_t row = (size_t)(row0 + ai * HALF + m * 16);
#pragma unroll
                for (int bj = 0; bj < 2; ++bj) {
                    const f32x4 s0 = *(const f32x4*)(pscale + col0 + bj * HALF), s1 = *(const f32x4*)(pscale + col0 + bj * HALF + 4);
                    const u32x4 gb = *(const u32x4*)(Hb + row * 6144 + 5120 + col0 + bj * HALF);
                    f32x4 v0 = acc[ai][bj][m][0] * s0, v1 = acc[ai][bj][m][1] * s1;
                    v0[0] *= bf_lo(gb.x); v0[1] *= bf_hi(gb.x); v0[2] *= bf_lo(gb.y); v0[3] *= bf_hi(gb.y);
                    v1[0] *= bf_lo(gb.z); v1[1] *= bf_hi(gb.z); v1[2] *= bf_lo(gb.w); v1[3] *= bf_hi(gb.w);
                    u32x4 w; w.x = cvt_pk_bf16(v0[0], v0[1]); w.y = cvt_pk_bf16(v0[2], v0[3]); w.z = cvt_pk_bf16(v1[0], v1[1]); w.w = cvt_pk_bf16(v1[2], v1[3]);
                    *(u32x4*)(MIX + row * 2048 + 1024 + col0 + bj * HALF) = w; }
                asm volatile("" ::: "memory"); }
    }
};
struct EpiY {
    static constexpr bool PERM = true;
    bf16_t* O;
    __device__ __forceinline__ void operator()(const f32x4 (&acc)[2][2][4][2], const Unit& u, int wr, int wc, int fr, int fq) const {
        const int row0 = u.pm * BM + wr * 64 + fr, col0 = u.pn * BM + wc * 32 + 8 * fq;
#pragma unroll
        for (int ai = 0; ai < 2; ++ai)
#pragma unroll
            for (int m = 0; m < 4; ++m) { bf16_t* rowp = O + (size_t)(row0 + ai * HALF + m * 16) * 2048 + col0;
#pragma unroll
                for (int bj = 0; bj < 2; ++bj) { const f32x4 v0 = acc[ai][bj][m][0], v1 = acc[ai][bj][m][1];
                    u32x4 w; w.x = cvt_pk_bf16(v0[0], v0[1]); w.y = cvt_pk_bf16(v0[2], v0[3]); w.z = cvt_pk_bf16(v1[0], v1[1]); w.w = cvt_pk_bf16(v1[2], v1[3]);
                    *(u32x4*)(rowp + bj * HALF) = w; } }
    }
};
struct Epi5 {
    static constexpr bool PERM = true;
    bf16_t* O4[4]; bf16_t* TL; unsigned* cnt; unsigned tgt;
    __device__ __forceinline__ bool wants_publish(const Unit& u) const { return u.pn >= 32; }
    __device__ __forceinline__ void publish(const Unit&) const { __builtin_amdgcn_fence(__ATOMIC_RELEASE, "agent"); __hip_atomic_fetch_add(cnt + 4, 1u, __ATOMIC_RELAXED, __HIP_MEMORY_SCOPE_AGENT); }
    __device__ __forceinline__ void before(const Unit& u, int tid) const {
        if (u.pn >= 32) return;
        const int a = u.pn >> 3;
        if (tid == 0) { __hip_atomic_fetch_add(cnt + a, 1u, __ATOMIC_RELAXED, __HIP_MEMORY_SCOPE_AGENT);
            if (a >= 1) { unsigned sp = 0; while (__hip_atomic_load(cnt + a - 1, __ATOMIC_RELAXED, __HIP_MEMORY_SCOPE_AGENT) < tgt) { __builtin_amdgcn_s_sleep(4); if (++sp > (1u << 22)) break; } } }
        if (a >= 1) __builtin_amdgcn_s_barrier();
    }
    __device__ __forceinline__ void operator()(const f32x4 (&acc)[2][2][4][2], const Unit& u, int wr, int wc, int fr, int fq) const {
        const int row0 = u.pm * BM + wr * 64 + fr, ct = wc * 32 + 8 * fq;
#pragma unroll
        for (int ai = 0; ai < 2; ++ai)
#pragma unroll
            for (int m = 0; m < 4; ++m) { const size_t row = (size_t)(row0 + ai * HALF + m * 16);
#pragma unroll
                for (int bj = 0; bj < 2; ++bj) { f32x4 v0 = acc[ai][bj][m][0], v1 = acc[ai][bj][m][1]; const int c = ct + bj * HALF;
                    bf16_t* dst;
                    if (u.pn < 32) { const int arr = u.pn >> 3; dst = (arr == 0 ? O4[0] : arr == 1 ? O4[1] : arr == 2 ? O4[2] : O4[3]) + row * 2048 + (u.pn & 7) * BM + c;
                        if (arr == 3) {
#pragma unroll
                            for (int e = 0; e < 4; ++e) { v0[e] = siluf_(v0[e]); v1[e] = siluf_(v1[e]); } } }
                    else if (u.pn == 32) { if (c >= 128) continue; dst = TL + row * 256 + c;
#pragma unroll
                        for (int e = 0; e < 4; ++e) { v0[e] = tanhf_(v0[e]); v1[e] = tanhf_(v1[e]); } }
                    else { if (c >= 128) continue; dst = TL + row * 256 + 128 + c; }
                    u32x4 w; w.x = cvt_pk_bf16(v0[0], v0[1]); w.y = cvt_pk_bf16(v0[2], v0[3]); w.z = cvt_pk_bf16(v1[0], v1[1]); w.w = cvt_pk_bf16(v1[2], v1[3]);
                    *(u32x4*)dst = w; } }
    }
};
typedef _Float16 h16x2 __attribute__((ext_vector_type(2)));
__device__ __forceinline__ unsigned pk_h2(float a, float b) { h16x2 h = {(_Float16)a, (_Float16)b}; return __builtin_bit_cast(unsigned, h); }
struct Epi6 {
    static constexpr bool PERM = true;
    unsigned short* LOGW; unsigned short* AA; const float* w0; const float* a0;
    __device__ __forceinline__ void operator()(const f32x4 (&acc)[2][2][4][2], const Unit& u, int wr, int wc, int fr, int fq) const {
        const int row0 = u.pm * BM + wr * 64 + fr; const bool isw = u.pn < 8;
        const int col0 = (u.pn & 7) * BM + wc * 32 + 8 * fq; unsigned short* O = isw ? LOGW : AA; const float* bias = isw ? w0 : a0; const float sc = isw ? -0.6065306597126334f : 1.0f;
#pragma unroll
        for (int bj = 0; bj < 2; ++bj) { const f32x4 b0 = *(const f32x4*)(bias + col0 + bj * HALF), b1 = *(const f32x4*)(bias + col0 + bj * HALF + 4);
#pragma unroll
            for (int ai = 0; ai < 2; ++ai)
#pragma unroll
                for (int m = 0; m < 4; ++m) { f32x4 v0 = acc[ai][bj][m][0] + b0, v1 = acc[ai][bj][m][1] + b1;
#pragma unroll
                    for (int e = 0; e < 4; ++e) { v0[e] = sc * sigmoidf_(v0[e]); v1[e] = sc * sigmoidf_(v1[e]); }
                    u32x4 w; w.x = pk_h2(v0[0], v0[1]); w.y = pk_h2(v0[2], v0[3]); w.z = pk_h2(v1[0], v1[1]); w.w = pk_h2(v1[2], v1[3]);
                    *(u32x4*)(O + (size_t)(row0 + ai * HALF + m * 16) * 2048 + col0 + bj * HALF) = w; } }
    }
};
template <class Epi, class Sched, bool ALIGN_EPI = true, bool PRE = false, bool PUB = false>
__device__ __forceinline__ void gemm_phase(PG8_LAS unsigned char* lds, const Gemm g, const Sched& S, const Epi& E) {
    int tid = threadIdx.x; asm volatile("" : "+v"(tid));
    const int wid = __builtin_amdgcn_readfirstlane(tid >> 6), lane = tid & 63, wr = wid >> 2, wc = wid & 3, fr = lane & 15, fq = lane >> 4;
    const int K = g.K, nt = K / BK;
    unsigned voffA[2], voffB[2];
#pragma unroll
    for (int i = 0; i < 2; ++i) { int R, C; stage_rc(tid * 16 + i * 8192, R, C); const int Rb = Epi::PERM ? ((R & ~31) + perm32(R & 31)) : R;
        voffA[i] = (unsigned)(R * g.lda + C) * 2u; voffB[i] = (unsigned)(Rb * g.ldb + C) * 2u; }
    const size_t kstep = (size_t)(BK * 2);
    const size_t hstepA = (size_t)HALF * g.lda * 2, hstepB = (size_t)HALF * g.ldb * 2;
    const size_t tstepA = 2 * hstepA, tstepB = 2 * hstepB;
    const unsigned ldsw = (unsigned)wid * 1024u;
    const int aoff = lds_byte(wr * 64 + fr, fq * 8), boff = lds_byte(wc * 32 + fr, fq * 8);
#define PG8_SA(b, h) (((b) * 2 + (h)) * HTB)
#define PG8_SB(b, h) ((4 + (b) * 2 + (h)) * HTB)
#define PG8_STAGE(bufoff, gbase, voff) do { _Pragma("unroll") for (int _i = 0; _i < 2; ++_i) \
        __builtin_amdgcn_global_load_lds((const unsigned*)((const char*)(gbase) + (voff)[_i]), (PG8_LAS unsigned*)(lds + (bufoff) + ldsw + _i * 8192), 16, 0, 0); } while (0)
#define PG8_LDA(dst, b, h) do { _Pragma("unroll") for (int m = 0; m < 4; ++m) _Pragma("unroll") for (int k = 0; k < 2; ++k) dst[m][k] = *(const PG8_LAS bf16x8*)(lds + PG8_SA(b, h) + aoff + m * 2048 + k * 1024); } while (0)
#define PG8_LDB(dst, b, h) do { _Pragma("unroll") for (int n = 0; n < 2; ++n) _Pragma("unroll") for (int k = 0; k < 2; ++k) dst[n][k] = *(const PG8_LAS bf16x8*)(lds + PG8_SB(b, h) + boff + n * 2048 + k * 1024); } while (0)
#define PG8_MMA(ai, bj, At, Bt) do { __builtin_amdgcn_s_setprio(1); _Pragma("unroll") for (int m = 0; m < 4; ++m) _Pragma("unroll") for (int n = 0; n < 2; ++n) _Pragma("unroll") for (int k = 0; k < 2; ++k) \
        acc[ai][bj][m][n] = __builtin_amdgcn_mfma_f32_16x16x32_bf16(Bt[n][k], At[m][k], acc[ai][bj][m][n], 0, 0, 0); __builtin_amdgcn_s_setprio(0); } while (0)
#define PG8_WAIT_V(n) asm volatile("s_waitcnt vmcnt(" #n ")" ::: "memory")
#define PG8_WAIT_L(n) asm volatile("s_waitcnt lgkmcnt(" #n ")" ::: "memory")
#define PG8_BAR __builtin_amdgcn_s_barrier()
#define PG8_SCHED __builtin_amdgcn_sched_barrier(0)
    Unit cur, nxt; int ui = 0;
    if (!S.next(0, cur)) return;
    f32x4 acc[2][2][4][2];
#pragma unroll
    for (int a = 0; a < 2; ++a)
#pragma unroll
        for (int b = 0; b < 2; ++b)
#pragma unroll
            for (int m = 0; m < 4; ++m)
#pragma unroll
                for (int n = 0; n < 2; ++n) acc[a][b][m][n] = (f32x4){0.f, 0.f, 0.f, 0.f};
    bf16x8 At[4][2], B0[2][2], B1[2][2];
    const char* cA = (const char*)a_base(g, cur) + (size_t)cur.pm * tstepA; const char* cB = (const char*)g.Bt + (size_t)cur.pn * tstepB;
    PG8_STAGE(PG8_SB(0, 0), cB, voffB); PG8_STAGE(PG8_SB(0, 1), cB + hstepB, voffB); PG8_STAGE(PG8_SA(0, 0), cA, voffA); PG8_STAGE(PG8_SA(0, 1), cA + hstepA, voffA);
    if (wr == 1) PG8_BAR;
    PG8_WAIT_V(2); PG8_BAR;
    PG8_STAGE(PG8_SB(1, 0), cB + kstep, voffB); PG8_STAGE(PG8_SA(1, 0), cA + kstep, voffA); PG8_STAGE(PG8_SB(1, 1), cB + hstepB + kstep, voffB);
    PG8_WAIT_V(6); PG8_BAR;
    for (;;) {
        const bool has_next = S.next(ui + 1, nxt);
        const char* nA = has_next ? (const char*)a_base(g, nxt) + (size_t)nxt.pm * tstepA : cA; const char* nB = has_next ? (const char*)g.Bt + (size_t)nxt.pn * tstepB : cB;
        for (int t = 0; t < nt; t += 2) {
            const bool last = (t == nt - 2);
            const char* a1 = cA + (size_t)(t + 1) * kstep;
            const char* a2 = last ? nA : cA + (size_t)(t + 2) * kstep; const char* b2 = last ? nB : cB + (size_t)(t + 2) * kstep;
            const char* a3 = a2 + kstep; const char* b3 = b2 + kstep;
            PG8_LDB(B0, 0, 0); PG8_LDB(B1, 0, 1); PG8_SCHED; PG8_LDA(At, 0, 0); PG8_STAGE(PG8_SA(1, 1), a1 + hstepA, voffA);
            PG8_WAIT_V(8); PG8_WAIT_L(0); PG8_BAR; PG8_MMA(0, 0, At, B0); PG8_MMA(0, 1, At, B1); PG8_BAR; PG8_SCHED;
            PG8_LDA(At, 0, 1); PG8_STAGE(PG8_SB(0, 0), b2, voffB); PG8_STAGE(PG8_SB(0, 1), b2 + hstepB, voffB); PG8_STAGE(PG8_SA(0, 0), a2, voffA);
            PG8_WAIT_V(8); PG8_WAIT_L(0); PG8_BAR; PG8_MMA(1, 0, At, B0); PG8_MMA(1, 1, At, B1); PG8_BAR; PG8_SCHED;
            PG8_LDB(B0, 1, 0); PG8_LDB(B1, 1, 1); PG8_SCHED; PG8_LDA(At, 1, 0); PG8_STAGE(PG8_SA(0, 1), a2 + hstepA, voffA);
            PG8_WAIT_V(8); PG8_WAIT_L(0); PG8_BAR; PG8_MMA(0, 0, At, B0); PG8_MMA(0, 1, At, B1); PG8_BAR; PG8_SCHED;
            PG8_LDA(At, 1, 1); PG8_STAGE(PG8_SB(1, 0), b3, voffB); PG8_STAGE(PG8_SB(1, 1), b3 + hstepB, voffB); PG8_STAGE(PG8_SA(1, 0), a3, voffA);
            PG8_WAIT_V(8); PG8_WAIT_L(0); PG8_BAR; PG8_MMA(1, 0, At, B0); PG8_MMA(1, 1, At, B1); PG8_BAR; PG8_SCHED;
        }
        if constexpr (ALIGN_EPI) { if (wr == 0) PG8_BAR; }
        if constexpr (PRE) E.before(cur, tid);
        { int l2 = lane; asm volatile("" : "+v"(l2)); E(acc, cur, wr, wc, l2 & 15, l2 >> 4); }
        if constexpr (PUB) { if (E.wants_publish(cur)) {
            PG8_WAIT_V(0); PG8_BAR; PG8_BAR; if (wid == 0 && lane == 0) E.publish(cur); } }
        if (!has_next) break;
#pragma unroll
        for (int a = 0; a < 2; ++a)
#pragma unroll
            for (int b = 0; b < 2; ++b)
#pragma unroll
                for (int m = 0; m < 4; ++m)
#pragma unroll
                    for (int n = 0; n < 2; ++n) acc[a][b][m][n] = (f32x4){0.f, 0.f, 0.f, 0.f};
        cur = nxt; cA = nA; cB = nB; ++ui;
        if constexpr (ALIGN_EPI) { if (wr == 1) PG8_BAR; }
    }
    PG8_WAIT_V(0);
    if constexpr (!ALIGN_EPI) { if (wr == 0) PG8_BAR; }
    PG8_BAR;
#undef PG8_SA
#undef PG8_SB
#undef PG8_STAGE
#undef PG8_LDA
#undef PG8_LDB
#undef PG8_MMA
#undef PG8_WAIT_V
#undef PG8_WAIT_L
#undef PG8_BAR
#undef PG8_SCHED
}
}

namespace sba {
using bf16 = __hip_bfloat16;
typedef short bf16x8 __attribute__((ext_vector_type(8)));
typedef short s16x4 __attribute__((ext_vector_type(4)));
typedef float f32x16 __attribute__((ext_vector_type(16)));
typedef float f32x4 __attribute__((ext_vector_type(4)));
typedef unsigned u32x4 __attribute__((ext_vector_type(4)));
constexpr int NW = 8, QBLK = 32, KVBLK = 64, QB = NW * QBLK, D = 128;
constexpr int PIN = 6144, POUT = 2048;
constexpr int SHM_V = KVBLK * D * 2, SHM_K = KVBLK * D * 2;
constexpr int SHM_Q = QBLK * D * 2;
constexpr int LDS_BYTES = 2 * SHM_V + 2 * SHM_K + NW * SHM_Q;

#define KSWZ(row, colB) ((row) * 256 + ((colB) ^ (((row) & 7) << 4)))
#define SBAR() __builtin_amdgcn_sched_barrier(0)
__device__ __forceinline__ int v_st(int k, int c) { const int kk = (k & ~0xC) | ((k & 4) << 1) | ((k & 8) >> 1); return ((kk >> 3) * 4 + (c >> 5)) * 512 + ((kk & 7) * 32 + (c & 31)) * 2; }
__device__ __forceinline__ int v_rd_base(int lane) { return ((lane & 3) << 3) | (((lane >> 2) & 3) << 6) | (((lane >> 4) & 1) << 5) | (((lane >> 5) & 1) << 8); }
constexpr int v_rd_off(int d0, int ks, int half) { return d0 * 512 + ks * 4096 + half * 2048; }
__device__ __forceinline__ int crow(int r, int hi) { return (r & 3) + 8 * (r >> 2) + 4 * hi; }
typedef float f32x2_t __attribute__((ext_vector_type(2))); typedef __bf16 bf16x2_t __attribute__((ext_vector_type(2)));
__device__ __forceinline__ unsigned cvtpk(float lo, float hi) { f32x2_t v = {lo, hi}; bf16x2_t b = __builtin_convertvector(v, bf16x2_t); return __builtin_bit_cast(unsigned, b); }
__device__ __forceinline__ bf16x8 load8(const bf16* p) { return *reinterpret_cast<const bf16x8*>(p); }

__device__ __forceinline__ void mask_tile(f32x16& p0, f32x16& p1, int dq) {
    const float NEG = -__builtin_inff();
#pragma unroll
    for (int r = 0; r < 16; ++r) {
        const int c = (r & 3) + 8 * (r >> 2);
        if (dq - c < 0) p0[r] = NEG;
        if (dq - c - 32 < 0) p1[r] = NEG;
    }
}
__device__ __forceinline__ void partA_half(f32x16& p, float& C, int hi) {
    f32x16 s;
#pragma unroll
    for (int r = 0; r < 16; ++r) {
        const float E = __builtin_amdgcn_exp2f(__builtin_amdgcn_fmed3f(p[r], -1.0e30f, 60.f));
        s[r] = __builtin_amdgcn_rcpf(1.0f + E);
        p[r] = E * s[r];
    }
    float U[4], X[4];
#pragma unroll
    for (int g = 0; g < 4; ++g) { const float T = (s[4 * g] * s[4 * g + 1]) * (s[4 * g + 2] * s[4 * g + 3]);
        auto rr = __builtin_amdgcn_permlane32_swap(__float_as_uint(T), __float_as_uint(T), false, false);
        const float tl = __uint_as_float(rr[0]), th = __uint_as_float(rr[1]); U[g] = tl * th; X[g] = th; }
#pragma unroll
    for (int g = 3; g >= 0; --g) {
        float run = hi == 0 ? C * X[g] : C;
#pragma unroll
        for (int i = 3; i >= 0; --i) { const float a = p[4 * g + i] * run; run *= s[4 * g + i]; p[4 * g + i] = a; }
        C *= U[g];
    }
}
__device__ __forceinline__ void partA(f32x16& p0, f32x16& p1, float& Crun, int hi) { partA_half(p1, Crun, hi); partA_half(p0, Crun, hi); }
__device__ __forceinline__ void partB(f32x16& p0, f32x16& p1, bf16x8& pa0, bf16x8& pa1, bf16x8& pa2, bf16x8& pa3) {
#define PK4(P, B_, OUT) do { unsigned a0 = cvtpk(P[B_+0], P[B_+1]), a1 = cvtpk(P[B_+2], P[B_+3]);                          \
        unsigned b0 = cvtpk(P[B_+4], P[B_+5]), b1 = cvtpk(P[B_+6], P[B_+7]);                                             \
        auto r0 = __builtin_amdgcn_permlane32_swap(a0, b0, false, false); auto r1 = __builtin_amdgcn_permlane32_swap(a1, b1, false, false); \
        u32x4 w = {r0[0], r1[0], r0[1], r1[1]}; OUT = *reinterpret_cast<bf16x8*>(&w); } while (0)
    PK4(p0, 0, pa0); PK4(p0, 8, pa1); PK4(p1, 0, pa2); PK4(p1, 8, pa3);
#undef PK4
}
template <int KB>
__device__ __forceinline__ void qkt(f32x16& p0, f32x16& p1, const char* K_lds, int r32, int hi, const char* Qw_lds, bool act) {
    if (!act) { const float NEG = -__builtin_inff();
#pragma unroll
        for (int r = 0; r < 16; ++r) { p0[r] = NEG; p1[r] = NEG; } return; }
    p0 = f32x16{}; p1 = f32x16{};
    const char* kb[4];
#pragma unroll
    for (int dd = 0; dd < 4; ++dd) kb[dd] = K_lds + KB * SHM_K + KSWZ(r32, (dd * 16 + hi * 8) * 2);
#pragma unroll
    for (int d0 = 0; d0 < 8; ++d0) { const char* a = kb[d0 & 3] + (d0 >> 2) * 128;
        bf16x8 b0 = *reinterpret_cast<const bf16x8*>(a);
        bf16x8 b1 = *reinterpret_cast<const bf16x8*>(a + 32 * 256);
        bf16x8 q = *reinterpret_cast<const bf16x8*>(Qw_lds + (kb[d0 & 3] - (K_lds + KB * SHM_K)) + (d0 >> 2) * 128);
        p0 = __builtin_amdgcn_mfma_f32_32x32x16_bf16(b0, q, p0, 0, 0, 0);
        p1 = __builtin_amdgcn_mfma_f32_32x32x16_bf16(b1, q, p1, 0, 0, 0); }
}
template <int VB>
__device__ __forceinline__ void pv_tile(f32x16* o, int vb0, bf16x8 pa0, bf16x8 pa1, bf16x8 pa2, bf16x8 pa3, bool act) {
    if (!act) return;
#define TRRD(dst, off) asm volatile("ds_read_b64_tr_b16 %0, %1 offset:%2" : "=&v"(dst) : "v"(vb0), "i"(off) : "memory")
#define PV_D0(d0) do { s16x4 l0, l1, l2, l3, h0, h1, h2, h3; constexpr int b_ = VB * SHM_V + v_rd_off(d0, 0, 0); \
        TRRD(l0, b_); TRRD(h0, b_ + 2048); TRRD(l1, b_ + 4096); TRRD(h1, b_ + 6144); TRRD(l2, b_ + 8192); TRRD(h2, b_ + 10240); TRRD(l3, b_ + 12288); TRRD(h3, b_ + 14336); \
        asm volatile("s_waitcnt lgkmcnt(0)" ::: "memory"); SBAR();   \
        o[d0] = __builtin_amdgcn_mfma_f32_32x32x16_bf16(pa0, (bf16x8){l0[0], l0[1], l0[2], l0[3], h0[0], h0[1], h0[2], h0[3]}, o[d0], 0, 0, 0);   \
        o[d0] = __builtin_amdgcn_mfma_f32_32x32x16_bf16(pa1, (bf16x8){l1[0], l1[1], l1[2], l1[3], h1[0], h1[1], h1[2], h1[3]}, o[d0], 0, 0, 0);   \
        o[d0] = __builtin_amdgcn_mfma_f32_32x32x16_bf16(pa2, (bf16x8){l2[0], l2[1], l2[2], l2[3], h2[0], h2[1], h2[2], h2[3]}, o[d0], 0, 0, 0);   \
        o[d0] = __builtin_amdgcn_mfma_f32_32x32x16_bf16(pa3, (bf16x8){l3[0], l3[1], l3[2], l3[3], h3[0], h3[1], h3[2], h3[3]}, o[d0], 0, 0, 0); } while (0)
    PV_D0(0); PV_D0(1); PV_D0(2); PV_D0(3);
#undef PV_D0
#undef TRRD
}

struct BlockRef { const bf16* Q; const bf16* K; const bf16* V; const bf16* G; bf16* O; int P0; };
#define ROW(p, k0, rr) ((p) + (size_t)((k0) + (rr)) * PIN + sc)
#define VMW() asm volatile("s_waitcnt vmcnt(0)" ::: "memory")
#define SLOAD_H(Kp, Vp, k0) do { st_v0 = load8(ROW(Vp, k0, sr)); st_v1 = load8(ROW(Vp, k0, 32 + sr));              \
                         st_k0 = load8(ROW(Kp, k0, sr)); st_k1 = load8(ROW(Kp, k0, 32 + sr)); } while (0)
#define SWRITE_H(bf) do { *(bf16x8*)(V_lds + (bf) * SHM_V + vst0) = st_v0; *(bf16x8*)(V_lds + (bf) * SHM_V + vst1) = st_v1; \
                          *(bf16x8*)(K_lds + (bf) * SHM_K + kws) = st_k0; *(bf16x8*)(K_lds + (bf) * SHM_K + kws + 32 * 256) = st_k1; } while (0)
__device__ __forceinline__ void q_to_lds(const bf16* Q, char* Qw_lds, int wid, int r32, int hi) {
    bf16x8 qr[8];
#pragma unroll
    for (int d0 = 0; d0 < 8; ++d0) qr[d0] = load8(Q + (size_t)(wid * QBLK + r32) * PIN + d0 * 16 + hi * 8);
#pragma unroll
    for (int d0 = 0; d0 < 8; ++d0) *(bf16x8*)(Qw_lds + KSWZ(r32, (d0 * 16 + hi * 8) * 2)) = qr[d0];
}
__device__ __forceinline__ void sb_block(const BlockRef& cur, char* lds) {
    int tid = threadIdx.x; asm volatile("" : "+v"(tid));
    const int wid = __builtin_amdgcn_readfirstlane(tid >> 6), lane = tid & 63, r32 = lane & 31, hi = lane >> 5;
    const int NT = (cur.P0 + QB) / KVBLK;
    const int qlo = cur.P0 + wid * QBLK, qm = qlo + r32 - 1 - 4 * hi;
    char* V_lds = lds; char* K_lds = lds + 2 * SHM_V; char* Qw_lds = lds + 2 * SHM_V + 2 * SHM_K + wid * SHM_Q;
    float Rrun = 1.f; f32x16 o[4] = {};
    const int sr = tid >> 4, sc = (tid & 15) * 8, vst0 = v_st(sr, sc), vst1 = v_st(32 + sr, sc), kws = KSWZ(sr, sc * 2);
    const int vb0 = (int)(uintptr_t)V_lds + v_rd_base(lane);
    const bf16* Kh = cur.K; const bf16* Vh = cur.V;
    bf16x8 st_v0, st_v1, st_k0, st_k1;
#define KBASE(t) ((NT - 1 - (t)) * KVBLK)
#define ACT(t) (KBASE(t) <= qlo + QBLK - 2)
#define MASKT(P0_, P1_, t) do { const int kb_ = KBASE(t); if (ACT(t) && (kb_ + KVBLK - 1 > qlo - 1)) mask_tile(P0_, P1_, qm - kb_); } while (0)
    q_to_lds(cur.Q, Qw_lds, wid, r32, hi);
    SLOAD_H(Kh, Vh, KBASE(0)); VMW(); SWRITE_H(0);
    __syncthreads();
    f32x16 p0, p1; bf16x8 pa0, pa1, pa2, pa3;
    constexpr float SKIP_THR = 1e-30f;
    volatile int* flags = (volatile int*)(lds + 2 * SHM_V + 2 * SHM_K + NW * SHM_Q);
    bool mydone = false, alldone = false;
#define STEP(t, BF) do {                                                                                   \
        if ((t) + 1 < NT) { SLOAD_H(Kh, Vh, KBASE((t) + 1)); }                                              \
        const bool act_ = ACT(t) && !mydone;                                                                 \
        SBAR(); qkt<BF>(p0, p1, K_lds, r32, hi, Qw_lds, act_);                                          \
        if (act_) { MASKT(p0, p1, (t)); partA(p0, p1, Rrun, hi); partB(p0, p1, pa0, pa1, pa2, pa3); } SBAR();               \
        pv_tile<BF>(o, vb0, pa0, pa1, pa2, pa3, act_);                                                     \
        mydone = mydone || __all(Rrun <= SKIP_THR);                                                           \
        if (lane == 0) flags[BF * 8 + wid] = mydone ? 1 : 0;                                                 \
        if ((t) + 1 < NT) { VMW(); SWRITE_H(1 - BF); }                                                       \
        __syncthreads();                                                                                     \
        { int f_ = 1; _Pragma("unroll") for (int w_ = 0; w_ < 8; ++w_) f_ &= flags[BF * 8 + w_]; alldone = f_ != 0; } } while (0)
    for (int t = 0; t < NT; t += 2) { STEP(t, 0); if (alldone) break; STEP(t + 1, 1); if (alldone) break; }
    {
        bf16* Ow = cur.O + (size_t)(wid * QBLK) * POUT; const bf16* Gw = cur.G + (size_t)(wid * QBLK) * PIN;
        float* st = (float*)Qw_lds;
        const int erow = lane >> 1, ehalf = lane & 1;
#pragma unroll
        for (int hp = 0; hp < 2; ++hp) {
            u32x4 gq[4];
#pragma unroll
            for (int i = 0; i < 4; ++i) gq[i] = *(const u32x4*)(Gw + (size_t)erow * PIN + hp * 64 + ehalf * 32 + i * 8);
            asm volatile("s_waitcnt lgkmcnt(0)" ::: "memory");
#pragma unroll
            for (int r = 0; r < 16; ++r) { const int orow = crow(r, hi);
#pragma unroll
                for (int dl = 0; dl < 2; ++dl) { const int col = dl * 32 + r32; st[orow * 64 + ((((col >> 2) ^ (orow & 15)) << 2) | (col & 3))] = o[2 * hp + dl][r]; } }
            asm volatile("s_waitcnt lgkmcnt(0)" ::: "memory");
#pragma unroll
            for (int i = 0; i < 4; ++i) {
                const int g0 = 8 * ehalf + 2 * i;
                const f32x4 a = *(const f32x4*)(st + erow * 64 + ((g0 ^ (erow & 15)) << 2)), b = *(const f32x4*)(st + erow * 64 + (((g0 + 1) ^ (erow & 15)) << 2));
                const u32x4 g = gq[i];
                u32x4 w; w.x = cvtpk(a[0] * __uint_as_float(g.x << 16), a[1] * __uint_as_float(g.x & 0xffff0000u)); w.y = cvtpk(a[2] * __uint_as_float(g.y << 16), a[3] * __uint_as_float(g.y & 0xffff0000u));
                w.z = cvtpk(b[0] * __uint_as_float(g.z << 16), b[1] * __uint_as_float(g.z & 0xffff0000u)); w.w = cvtpk(b[2] * __uint_as_float(g.w << 16), b[3] * __uint_as_float(g.w & 0xffff0000u));
                *(u32x4*)(Ow + (size_t)erow * POUT + hp * 64 + ehalf * 32 + i * 8) = w; }
        }
        asm volatile("s_waitcnt lgkmcnt(0)" ::: "memory");
    }
#undef KBASE
#undef ACT
#undef MASKT
#undef STEP
}
#undef ROW
#undef VMW
#undef SLOAD_H
#undef SWRITE_H
#undef KSWZ
#undef SBAR
}

constexpr int NWAVES = 8;
constexpr int N_LAUNCHES = MK_N_LAUNCHES;
constexpr int N_PHASES = 12;
constexpr int BATCH = 4, SEQ = 4096, DM = 2048, M = BATCH * SEQ, MH = M / 2;
constexpr int EVEN_IN = 6144;
constexpr float LN_EPS = 1e-5f, GN_EPS = 64e-5f;
constexpr float ALPHA = 1.4142135623730951f;
constexpr int N2CAT = 4 * DM + 512;

constexpr size_t MiB = 1u << 20;
constexpr size_t WS_CTL = 0, CTL_ZERO_BYTES = 1 * MiB;
constexpr size_t WS_W2CAT = 1 * MiB, WS_WOT = 35 * MiB, WS_L2T = 43 * MiB, WS_STATS = 45 * MiB, WS_D = 46 * MiB;
constexpr size_t WS_WINT = WS_D, WS_WOUTT = WS_D + 24 * MiB, WS_WPOOLT = WS_D + 32 * MiB, WS_XB = WS_D + 33 * MiB, WS_MIX = WS_XB, WS_H = WS_D + 97 * MiB, WS_POOLED = WS_D + 289 * MiB;
constexpr size_t WS_XMIX = WS_D, WS_K2 = WS_D, WS_V2 = WS_D + 64 * MiB, WS_SG = WS_D + 128 * MiB, WS_OG = WS_D + 192 * MiB, WS_AA = WS_D + 256 * MiB, WS_LOGW = WS_D + 320 * MiB;
constexpr size_t WS_R = WS_D + 384 * MiB, WS_TL = WS_D + 448 * MiB, WS_END = WS_D + 456 * MiB;
constexpr size_t WS_Y0 = WS_R;
constexpr size_t WS_GRING = WS_W2CAT;
constexpr size_t WS_Y1 = WS_LOGW;
static_assert(WS_POOLED + 32 * MiB <= WS_END && WS_END <= 512 * MiB, "d_ws map");
constexpr int CW_TMO = 0, CW_CODE = 1, CW_BAR = 4096, CW_ACNT = 8192, CW_GFL = 16384;

constexpr int RING_OFF = 0, RING_BYTES = 159744;
constexpr int LDSCTL_OFF = RING_BYTES, MISC_OFF = LDSCTL_OFF + 320;
constexpr int LDS_BYTES = 163840;

#define GAS __attribute__((address_space(1)))
#define LAS __attribute__((address_space(3)))
typedef unsigned short bf16;
typedef unsigned v4u __attribute__((ext_vector_type(4)));
typedef unsigned v2u __attribute__((ext_vector_type(2)));
typedef float f32x4 __attribute__((ext_vector_type(4)));
typedef float f32x2v __attribute__((ext_vector_type(2)));
typedef GAS unsigned gu32;
#define RLX_AGENT __ATOMIC_RELAXED, __HIP_MEMORY_SCOPE_AGENT
#define LDS_WAIT() asm volatile("s_waitcnt lgkmcnt(0)" ::: "memory")
#define VM_WAIT() asm volatile("s_waitcnt vmcnt(0)" ::: "memory")
__device__ __forceinline__ unsigned f2bf(float f) { unsigned u = __builtin_bit_cast(unsigned, f); return (u + 0x7fffu + ((u >> 16) & 1u)) >> 16; }
__device__ __forceinline__ unsigned pk2(float lo, float hi) { return pg8::cvt_pk_bf16(lo, hi); }
__device__ __forceinline__ float bflo(unsigned w) { return __uint_as_float(w << 16); }
__device__ __forceinline__ float bfhi(unsigned w) { return __uint_as_float(w & 0xffff0000u); }

#define XB_TMO      128
#define XB_XCNT(j)  (256  + 64 * (j))
#define XB_XSUB(j)  (1280 + 64 * (j))
#define XB_XGEN(j)  (2304 + 64 * (j))
#define XB_TOP      3328
#define XB_TOPGEN   3392
#define XCD_BAR_WORDS 3456
#define XB_SPIN_CAP (1u << 23)
__device__ __forceinline__ unsigned xb_ld(unsigned* p)              { return __hip_atomic_load(p, __ATOMIC_RELAXED, __HIP_MEMORY_SCOPE_AGENT); }
__device__ __forceinline__ unsigned xb_add(unsigned* p, unsigned v) { return __hip_atomic_fetch_add(p, v, __ATOMIC_RELAXED, __HIP_MEMORY_SCOPE_AGENT); }
__device__ __forceinline__ unsigned xb_xcc_id() { return (unsigned)__builtin_amdgcn_s_getreg((3 << 11) | 20) & 0xFu; }
#define XB_SPIN(cond, bar) do { unsigned _sp = 0; while (cond) { __builtin_amdgcn_s_sleep(1); \
    if ((++_sp & 255u) == 0u) { if (xb_ld(&(bar)[XB_TMO])) break; if (_sp > XB_SPIN_CAP) { atomicAdd(&(bar)[XB_TMO], 1u); break; } } } } while (0)
struct XcdBarrier { unsigned* bar; unsigned x; volatile LAS unsigned* st; };
__device__ __forceinline__ XcdBarrier xcd_barrier_post(unsigned* bar, volatile LAS unsigned* st) {
    XcdBarrier b; b.bar = bar; b.x = xb_xcc_id(); b.st = st;
    if (threadIdx.x == 0) (void)xb_add(&bar[XB_XCNT(b.x)], 1u);
    return b;
}
__device__ __forceinline__ void xcd_barrier_complete(unsigned* bar, unsigned x, unsigned& nloc, unsigned& nx) {
    const unsigned G = gridDim.x * gridDim.y * gridDim.z;
    unsigned sum, cnt, mine, sp = 0u;
    for (;;) {
        sum = 0u; cnt = 0u; mine = 0u;
#pragma unroll
        for (unsigned j = 0; j < 16; ++j) { const unsigned c = xb_ld(&bar[XB_XCNT(j)]); sum += c; cnt += (c > 0u) ? 1u : 0u; mine = (j == x) ? c : mine; }
        if (sum == G) break;
        __builtin_amdgcn_s_sleep(1);
        if ((++sp & 255u) == 0u) { if (xb_ld(&bar[XB_TMO])) break; if (sp > XB_SPIN_CAP) { atomicAdd(&bar[XB_TMO], 1u); break; } }
    }
    nloc = mine > 0u ? mine : 1u; nx = cnt > 0u ? cnt : 1u;
}
__device__ __attribute__((noinline)) void xcd_barrier(const XcdBarrier b) {
    asm volatile("s_waitcnt vmcnt(0)" ::: "memory");
    __syncthreads();
    if (threadIdx.x == 0) {
        unsigned* bar = b.bar;
        __builtin_amdgcn_s_waitcnt(0);
        unsigned nloc = b.st[0], nx = b.st[1];
        if (nloc == 0u) { xcd_barrier_complete(bar, b.x, nloc, nx); b.st[0] = nloc; b.st[1] = nx; }
        const unsigned old = xb_add(&bar[XB_XSUB(b.x)], 1u);
        const unsigned gen = old / nloc;
        if (old + 1u == (gen + 1u) * nloc) {
            __builtin_amdgcn_fence(__ATOMIC_RELEASE, "agent");
            asm volatile("s_waitcnt vmcnt(0)" ::: "memory");
            const unsigned og = xb_add(&bar[XB_TOP], 1u);
            const unsigned tg = og / nx;
            if (og + 1u == (tg + 1u) * nx) xb_add(&bar[XB_TOPGEN], 1u);
            else XB_SPIN(xb_ld(&bar[XB_TOPGEN]) == tg, bar);
            __builtin_amdgcn_fence(__ATOMIC_ACQUIRE, "agent");
            xb_add(&bar[XB_XGEN(b.x)], 1u);
            asm volatile("s_waitcnt vmcnt(0)" ::: "memory");
        } else {
            XB_SPIN(xb_ld(&bar[XB_XGEN(b.x)]) == gen, bar);
            __builtin_amdgcn_fence(__ATOMIC_ACQUIRE, "agent");
            asm volatile("s_waitcnt vmcnt(0)" ::: "memory");
        }
    }
    __syncthreads();
}

struct Frame {
    LAS unsigned char* lds;
    volatile LAS unsigned* MISC;
    gu32* ctl;
    int vcu, G;
};
#define PHASE_TID() int tid_ = threadIdx.x; asm volatile("" : "+v"(tid_)); const int tid = tid_, lane = tid & 63, wave = __builtin_amdgcn_readfirstlane(tid >> 6); (void)lane; (void)wave
__device__ __forceinline__ float wave_sum(float v) {
#pragma unroll
    for (int o = 1; o < 64; o <<= 1) v += __shfl_xor(v, o);
    return v;
}
__device__ __forceinline__ void p0_transpose_item(const float* W, int N, bf16* WT, int ldwt, int row_off, LAS float* scr, int item, int lane) {
    const int nblk = N / 32, kb = item / nblk, nb = item % nblk, k0 = 64 * kb, n0 = 32 * nb;
    { const int kk8 = lane >> 3, c4 = lane & 7; f32x4 t[8];
#pragma unroll
      for (int i = 0; i < 8; ++i) t[i] = *(const GAS f32x4*)(W + (size_t)(k0 + 8 * i + kk8) * N + n0 + 4 * c4);
#pragma unroll
      for (int i = 0; i < 8; ++i) { LAS float* d = scr + (8 * i + kk8) * 33 + 4 * c4; d[0] = t[i].x; d[1] = t[i].y; d[2] = t[i].z; d[3] = t[i].w; } }
    LDS_WAIT(); asm volatile("" ::: "memory");
    const int c = lane & 7;
#pragma unroll
    for (int j = 0; j < 4; ++j) { const int n = (lane >> 3) + 8 * j; const LAS float* s = scr + (8 * c) * 33 + n;
        v4u o; o.x = pk2(s[0 * 33], s[1 * 33]); o.y = pk2(s[2 * 33], s[3 * 33]); o.z = pk2(s[4 * 33], s[5 * 33]); o.w = pk2(s[6 * 33], s[7 * 33]);
        *(GAS v4u*)(WT + (size_t)(row_off + n0 + n) * ldwt + k0 + 8 * c) = o; }
    LDS_WAIT(); asm volatile("" ::: "memory");
}

struct Args { const float* in[24]; float* out; unsigned char* ws; int ph_lo, ph_hi, li, pad; };

__device__ __forceinline__ void p0_prologue(Frame& F, const Args& a) {
    PHASE_TID();
    unsigned char* ws = a.ws;
    LAS float* scr = (LAS float*)(F.lds + RING_OFF + wave * 16384);
    const int gw = F.vcu * NWAVES + wave, NGW = F.G * NWAVES;
    bf16* WINT = (bf16*)(ws + WS_WINT); bf16* WPOOLT = (bf16*)(ws + WS_WPOOLT);
    constexpr int I_IN = (DM / 64) * (EVEN_IN / 32), I_POOL = (256 / 64) * (256 / 32);
    constexpr int NITEMS = I_IN + 4 * I_POOL;
    for (int it = gw; it < NITEMS; it += NGW) {
        int r = it;
        if (r < I_IN) { p0_transpose_item(a.in[1], EVEN_IN, WINT, DM, 0, scr, r, lane); continue; } r -= I_IN;
        { const int g = r / I_POOL; p0_transpose_item(a.in[2] + (size_t)g * 65536, 256, WPOOLT + (size_t)g * 65536, 256, 0, scr, r % I_POOL, lane); }
    }
    const int gt = F.vcu * (NWAVES * 64) + tid, NGT = F.G * NWAVES * 64;
    { const float* x = a.in[0]; bf16* XB = (bf16*)(ws + WS_XB);
      for (size_t i = (size_t)gt * 2; i < (size_t)M * DM / 8; i += (size_t)2 * NGT) {
          const f32x4 u0 = *(const GAS f32x4*)(x + i * 8), u1 = *(const GAS f32x4*)(x + i * 8 + 4), u2 = *(const GAS f32x4*)(x + i * 8 + 8), u3 = *(const GAS f32x4*)(x + i * 8 + 12);
          *(GAS v4u*)(XB + i * 8) = (v4u){pk2(u0.x, u0.y), pk2(u0.z, u0.w), pk2(u1.x, u1.y), pk2(u1.z, u1.w)};
          *(GAS v4u*)(XB + i * 8 + 8) = (v4u){pk2(u2.x, u2.y), pk2(u2.z, u2.w), pk2(u3.x, u3.y), pk2(u3.z, u3.w)}; } }
}
__device__ __forceinline__ void late_weights(Frame& F, const Args& a) {
    PHASE_TID();
    unsigned char* ws = a.ws;
    LAS float* scr = (LAS float*)(F.lds + RING_OFF + wave * 16384);
    const int gw = F.vcu * NWAVES + wave, NGW = F.G * NWAVES;
    bf16* WOUTT = (bf16*)(ws + WS_WOUTT); bf16* W2CAT = (bf16*)(ws + WS_W2CAT);
    constexpr int I_SQ = (DM / 64) * (DM / 32), I_LORA = (DM / 64) * (96 / 32);
    constexpr int NITEMS = 5 * I_SQ + 2 * I_LORA;
    for (int it = gw; it < NITEMS; it += NGW) {
        int r = it;
        if (r < I_SQ) { p0_transpose_item(a.in[4], DM, WOUTT, DM, 0, scr, r, lane); continue; } r -= I_SQ;
        if (r < 4 * I_SQ) { const int w = r / I_SQ; p0_transpose_item(a.in[6 + w], DM, W2CAT, DM, w * DM, scr, r % I_SQ, lane); continue; } r -= 4 * I_SQ;
        if (r < I_LORA) { p0_transpose_item(a.in[11], 96, W2CAT, DM, 4 * DM, scr, r, lane); continue; } r -= I_LORA;
        p0_transpose_item(a.in[14], 96, W2CAT, DM, 4 * DM + 256, scr, r, lane);
    }
    const int gt = F.vcu * (NWAVES * 64) + tid, NGT = F.G * NWAVES * 64;
    for (int i = gt; i < 2 * 160 * (DM / 8); i += NGT) { const int blk = i / (160 * (DM / 8)), rr = (i / (DM / 8)) % 160, c8 = i % (DM / 8);
        *(GAS v4u*)(W2CAT + (size_t)(4 * DM + blk * 256 + 96 + rr) * DM + c8 * 8) = (v4u){0u, 0u, 0u, 0u}; }
    { bf16* L2T = (bf16*)(ws + WS_L2T); const float* w2 = a.in[12]; const float* a2 = a.in[15];
      for (int i = gt; i < 4096 * 16; i += NGT) { const int n = i % 4096, c8 = i / 4096; const int k0 = c8 * 8; float v[8];
#pragma unroll
          for (int e = 0; e < 8; ++e) { const int k = k0 + e; float x = 0.f;
              if (k < 96) x = (n < 2048) ? w2[(size_t)k * DM + n] : a2[(size_t)k * DM + (n - 2048)];
              v[e] = x; }
          *(GAS v4u*)(L2T + (size_t)n * 128 + k0) = (v4u){pk2(v[0], v[1]), pk2(v[2], v[3]), pk2(v[4], v[5]), pk2(v[6], v[7])}; } }
}

template <int WIN>
__device__ __forceinline__ void pool_tile_w(const bf16* Hb, bf16* POOLED, int pm, int g, int tid) {
    const int c4 = (tid & 63) * 4, rw = tid >> 6;
    const int row0 = pm * 256 + rw * 32, t0 = row0 & (SEQ - 1);
    const bf16* up = Hb + (size_t)row0 * 6144 + 4096 + g * 256 + c4;
    v2u ring[WIN]; float s0 = 0.f, s1 = 0.f, s2 = 0.f, s3 = 0.f;
#pragma unroll
    for (int i = 1; i < WIN; ++i) {
        v2u w = {0u, 0u};
        if (t0 - i >= 0) w = *(const GAS v2u*)(up - (size_t)i * 6144);
        ring[(WIN - i) % WIN] = w; s0 += bflo(w.x); s1 += bfhi(w.x); s2 += bflo(w.y); s3 += bfhi(w.y); }
    v2u cur[32];
#pragma unroll
    for (int rr = 0; rr < 32; ++rr) cur[rr] = *(const GAS v2u*)(up + (size_t)rr * 6144);
#pragma unroll
    for (int rr = 0; rr < 32; ++rr) {
        const v2u w = cur[rr]; const float u0 = bflo(w.x), u1 = bfhi(w.x), u2 = bflo(w.y), u3 = bfhi(w.y);
        s0 += u0; s1 += u1; s2 += u2; s3 += u3;
        const int t = t0 + rr; const float inv = (t + 1 >= WIN) ? (1.0f / (float)WIN) : __builtin_amdgcn_rcpf((float)(t + 1));
        *(GAS v2u*)(POOLED + (size_t)(row0 + rr) * 1024 + g * 256 + c4) = (v2u){pk2(s0 * inv - u0, s1 * inv - u1), pk2(s2 * inv - u2, s3 * inv - u3)};
        const v2u old = ring[(rr + 1) % WIN];
        s0 -= bflo(old.x); s1 -= bfhi(old.x); s2 -= bflo(old.y); s3 -= bfhi(old.y);
        ring[rr % WIN] = w;
    }
}
__device__ __forceinline__ void pool_tile(Frame& F, const bf16* Hb, bf16* POOLED, int pm, int g) {
    PHASE_TID();
    if (g == 0) pool_tile_w<2>(Hb, POOLED, pm, g, tid); else if (g == 1) pool_tile_w<4>(Hb, POOLED, pm, g, tid);
    else if (g == 2) pool_tile_w<8>(Hb, POOLED, pm, g, tid); else pool_tile_w<16>(Hb, POOLED, pm, g, tid);
}

struct Row32 { f32x4 a[4], b[4]; };
template <bool XBF = false>
__device__ __forceinline__ void ln_row(const float* xr, const bf16* yr, const Row32& G, const Row32& B, int lane, Row32& v) {
    float s = 0.f;
#pragma unroll
    for (int j = 0; j < 4; ++j) { const int c = 8 * lane + 512 * j; f32x4 x0, x1;
        if (XBF) { const v4u xw = *(const GAS v4u*)((const bf16*)xr + c); x0 = (f32x4){bflo(xw.x), bfhi(xw.x), bflo(xw.y), bfhi(xw.y)}; x1 = (f32x4){bflo(xw.z), bfhi(xw.z), bflo(xw.w), bfhi(xw.w)}; }
        else { x0 = *(const GAS f32x4*)(xr + c); x1 = *(const GAS f32x4*)(xr + c + 4); }
        const v4u y = *(const GAS v4u*)(yr + c);
        v.a[j] = x0 * ALPHA + (f32x4){bflo(y.x), bfhi(y.x), bflo(y.y), bfhi(y.y)}; v.b[j] = x1 * ALPHA + (f32x4){bflo(y.z), bfhi(y.z), bflo(y.w), bfhi(y.w)};
        s += ((v.a[j].x + v.a[j].y) + (v.a[j].z + v.a[j].w)) + ((v.b[j].x + v.b[j].y) + (v.b[j].z + v.b[j].w)); }
    const float mean = wave_sum(s) * (1.f / DM); float s2 = 0.f;
#pragma unroll
    for (int j = 0; j < 4; ++j) { v.a[j] = v.a[j] - mean; v.b[j] = v.b[j] - mean;
        s2 += ((v.a[j].x * v.a[j].x + v.a[j].y * v.a[j].y) + (v.a[j].z * v.a[j].z + v.a[j].w * v.a[j].w)) + ((v.b[j].x * v.b[j].x + v.b[j].y * v.b[j].y) + (v.b[j].z * v.b[j].z + v.b[j].w * v.b[j].w)); }
    const float rstd = __builtin_amdgcn_rsqf(wave_sum(s2) * (1.f / DM) + LN_EPS);
#pragma unroll
    for (int j = 0; j < 4; ++j) { v.a[j] = v.a[j] * rstd * G.a[j] + B.a[j]; v.b[j] = v.b[j] * rstd * G.b[j] + B.b[j]; }
}
template <bool XBF = false>
__device__ __forceinline__ void ln_row_ld(const float* xr, const bf16* yr, const float* lg, const float* lb, int lane, Row32& v) {
    asm volatile("" : "+s"(lg), "+s"(lb));
    Row32 G, B;
#pragma unroll
    for (int j = 0; j < 4; ++j) { const int c = 8 * lane + 512 * j; G.a[j] = *(const f32x4*)(lg + c); G.b[j] = *(const f32x4*)(lg + c + 4); B.a[j] = *(const f32x4*)(lb + c); B.b[j] = *(const f32x4*)(lb + c + 4); }
    ln_row<XBF>(xr, yr, G, B, lane, v);
}
__device__ __forceinline__ void load_row32(const float* p, int lane, Row32& r) {
#pragma unroll
    for (int j = 0; j < 4; ++j) { const int c = 8 * lane + 512 * j; r.a[j] = *(const f32x4*)(p + c); r.b[j] = *(const f32x4*)(p + c + 4); }
}
__device__ __forceinline__ void ln_mix_phase(Frame& F, const Args& a) {
    const float* X = a.in[0]; const bf16* Y0 = (const bf16*)(a.ws + WS_Y0); float* X1 = a.out; bf16* XMIX = (bf16*)(a.ws + WS_XMIX);
    const float* lg = a.in[22]; const float* lb = a.in[23]; const float* mu = a.in[5];
    PHASE_TID();
    const int gw = F.vcu * NWAVES + wave, NGW = F.G * NWAVES;
    constexpr int STRIP = 4;
    for (int sidx = gw; sidx < M / STRIP; sidx += NGW) {
        const int r0 = sidx * STRIP;
        Row32 prev;
        if ((r0 & (SEQ - 1)) == 0) {
#pragma unroll
            for (int j = 0; j < 4; ++j) { prev.a[j] = (f32x4){0.f, 0.f, 0.f, 0.f}; prev.b[j] = (f32x4){0.f, 0.f, 0.f, 0.f}; }
        } else ln_row_ld(X + (size_t)(r0 - 1) * DM, Y0 + (size_t)(r0 - 1) * DM, lg, lb, lane, prev);
        for (int rr = 0; rr < STRIP; ++rr) {
            const int row = r0 + rr; Row32 v;
            ln_row_ld(X + (size_t)row * DM, Y0 + (size_t)row * DM, lg, lb, lane, v);
            const size_t orow = (size_t)row * DM;
#pragma unroll
            for (int j = 0; j < 4; ++j) { const int c = 8 * lane + 512 * j;
                *(GAS v4u*)((bf16*)(X1 + (size_t)row * DM) + c) = (v4u){pk2(v.a[j].x, v.a[j].y), pk2(v.a[j].z, v.a[j].w), pk2(v.b[j].x, v.b[j].y), pk2(v.b[j].z, v.b[j].w)};
                const f32x4 xa = prev.a[j] - v.a[j], xb = prev.b[j] - v.b[j];
#pragma unroll
                for (int q = 0; q < 6; ++q) { const int mrow = (q == 0) ? 0 : (q == 1) ? 2 : (q == 2) ? 3 : (q == 3) ? 5 : (q == 4) ? 1 : 4;
                    const f32x4 m0 = *(const f32x4*)(mu + (size_t)mrow * DM + c), m1 = *(const f32x4*)(mu + (size_t)mrow * DM + c + 4); const f32x4 o0 = v.a[j] + xa * m0, o1 = v.b[j] + xb * m1;
                    *(GAS v4u*)(XMIX + (size_t)q * M * DM + orow + c) = (v4u){pk2(o0.x, o0.y), pk2(o0.z, o0.w), pk2(o1.x, o1.y), pk2(o1.z, o1.w)}; }
                prev.a[j] = v.a[j]; prev.b[j] = v.b[j]; asm volatile("" ::: "memory"); }
        }
    }
}
__device__ __forceinline__ void final_ln_phase(Frame& F, const Args& a) {
    float* X1 = a.out; const bf16* Y1 = (const bf16*)(a.ws + WS_Y1); const float* lg = a.in[22] + DM; const float* lb = a.in[23] + DM;
    PHASE_TID();
    const int gw = F.vcu * NWAVES + wave, NGW = F.G * NWAVES;
    for (int row = gw; row < M; row += NGW) {
        Row32 v; ln_row_ld<true>(X1 + (size_t)row * DM, Y1 + (size_t)row * DM, lg, lb, lane, v);
#pragma unroll
        for (int j = 0; j < 4; ++j) { const int c = 8 * lane + 512 * j; *(GAS f32x4*)(X1 + (size_t)row * DM + c) = v.a[j]; *(GAS f32x4*)(X1 + (size_t)row * DM + c + 4) = v.b[j]; }
    }
}

namespace wkv {
constexpr int NSLOT_ = 8;
typedef short bf16x8 __attribute__((ext_vector_type(8)));
typedef float f32x16 __attribute__((ext_vector_type(16)));
typedef float f32x4 __attribute__((ext_vector_type(4)));
typedef unsigned u32x4 __attribute__((ext_vector_type(4)));
typedef unsigned u32x2 __attribute__((ext_vector_type(2)));
typedef _Float16 h16x2 __attribute__((ext_vector_type(2)));
constexpr int O_KR = 0, O_BGT = 4096, O_KGT = 6144, O_VT = 8192, O_AM = 10240, O_LC = 11264, O_GC = 12288, O_BON = 12544, SLOT = 12608;
constexpr int OENT = 4096 + 64;
constexpr int NPREP = 6, L_SLOTS = 0, L_BK = NSLOT_ * SLOT, L_ORING = L_BK + NPREP * 4096, L_FLAGS = L_ORING + NSLOT_ * OENT, L_END = L_FLAGS + 256;
constexpr int NSLOT = 8;
constexpr float L2E = 1.4426950408889634f;
__device__ __forceinline__ int kr_off(int row, int chunk) { return row * 128 + ((chunk ^ ((row >> 1) & 7)) << 4); }
__device__ __forceinline__ int t_off(int row, int half) { return row * 32 + ((half ^ ((row >> 3) & 1)) << 4); }
typedef float f32x2_t __attribute__((ext_vector_type(2))); typedef __bf16 bf16x2_t __attribute__((ext_vector_type(2)));
__device__ __forceinline__ unsigned cvtpk(float lo, float hi) { f32x2_t v = {lo, hi}; bf16x2_t b = __builtin_convertvector(v, bf16x2_t); return __builtin_bit_cast(unsigned, b); }
__device__ __forceinline__ int rho(int j, int h) { return (j & 3) + 8 * (j >> 2) + 4 * h; }
template <int B> __device__ __forceinline__ bf16x8 frag(const f32x16& x) {
    u32x4 w = {cvtpk(x[B + 0], x[B + 1]), cvtpk(x[B + 2], x[B + 3]), cvtpk(x[B + 4], x[B + 5]), cvtpk(x[B + 6], x[B + 7])};
    return __builtin_bit_cast(bf16x8, w);
}
template <int B> __device__ __forceinline__ bf16x8 frag_pI(const f32x16& x, const float (&dI)[8]) {
    u32x4 w = {cvtpk(x[B + 0] + dI[0], x[B + 1] + dI[1]), cvtpk(x[B + 2] + dI[2], x[B + 3] + dI[3]), cvtpk(x[B + 4] + dI[4], x[B + 5] + dI[5]), cvtpk(x[B + 6] + dI[6], x[B + 7] + dI[7])};
    return __builtin_bit_cast(bf16x8, w);
}
__device__ __forceinline__ float dppf(float v, int) { return v; }
__device__ __forceinline__ float sum16(float v) {
    v += __builtin_bit_cast(float, __builtin_amdgcn_update_dpp(0, __builtin_bit_cast(int, v), 0xB1, 0xf, 0xf, false));
    v += __builtin_bit_cast(float, __builtin_amdgcn_update_dpp(0, __builtin_bit_cast(int, v), 0x4E, 0xf, 0xf, false));
    v += __builtin_bit_cast(float, __builtin_amdgcn_update_dpp(0, __builtin_bit_cast(int, v), 0x141, 0xf, 0xf, false));
    v += __builtin_bit_cast(float, __builtin_amdgcn_update_dpp(0, __builtin_bit_cast(int, v), 0x140, 0xf, 0xf, false));
    return v;
}
__device__ __forceinline__ float sum32(float v) { v = sum16(v); return v + __shfl_xor(v, 16); }
#define MF(A_, B_, C_) __builtin_amdgcn_mfma_f32_32x32x16_bf16((A_), (B_), (C_), 0, 0, 0)

struct Tensors { const unsigned short* R; const unsigned short* K; const unsigned short* V; const unsigned short* SG; const unsigned short* LOGW; const unsigned short* AA; unsigned short* OG;
                 const float* k_k; const float* k_a; const float* r_k; const float* gn_w; const float* gn_b; };

struct Raw { unsigned r[8], k[8], v[8], l[8], a[8]; };
__device__ __forceinline__ void prep_load(const Tensors& T, size_t grow0, int h, int lane, Raw& w) {
    const int cp = lane & 31, hh = lane >> 5;
    const size_t ub = grow0 * 2048 + h * 64;
    const unsigned lo = (unsigned)(hh * 8 * 2048 + 2 * cp);
    const unsigned short* pr = T.R + ub; const unsigned short* pk = T.K + ub; const unsigned short* pv = T.V + ub; const unsigned short* pl = T.LOGW + ub; const unsigned short* pa = T.AA + ub;
#pragma unroll
    for (int i = 0; i < 8; ++i) { const unsigned e = lo + (unsigned)i * 2048u;
        w.r[i] = *(const GAS unsigned*)(pr + e); w.k[i] = *(const GAS unsigned*)(pk + e); w.v[i] = *(const GAS unsigned*)(pv + e);
        w.l[i] = *(const GAS unsigned*)(pl + e); w.a[i] = *(const GAS unsigned*)(pa + e); }
}
template <class WaitSlot>
__device__ __forceinline__ void prep_elem(const Tensors& T, const Raw& w, int h, LAS unsigned char* slot, LAS unsigned char* bk, int lane, const WaitSlot& wait_slot) {
    const int cp = lane & 31, hh = lane >> 5;
    float lw[8][2], aa[8][2], rr[8][2], kr[8][2];
#pragma unroll
    for (int i = 0; i < 8; ++i) {
        const unsigned wr_ = w.r[i], wk_ = w.k[i], wl_ = w.l[i], wa_ = w.a[i];
        rr[i][0] = bflo(wr_); rr[i][1] = bfhi(wr_); kr[i][0] = bflo(wk_); kr[i][1] = bfhi(wk_);
        const h16x2 hl = __builtin_bit_cast(h16x2, wl_), ha = __builtin_bit_cast(h16x2, wa_);
        lw[i][0] = (float)hl[0]; lw[i][1] = (float)hl[1]; aa[i][0] = (float)ha[0]; aa[i][1] = (float)ha[1]; }
    float kkc[2], kac[2], rkc[2];
#pragma unroll
    for (int e = 0; e < 2; ++e) { kkc[e] = T.k_k[h * 64 + 2 * cp + e]; kac[e] = T.k_a[h * 64 + 2 * cp + e]; rkc[e] = T.r_k[h * 64 + 2 * cp + e]; }
    float g[8][2], e0x[2], gam[2];
#pragma unroll
    for (int e = 0; e < 2; ++e) { float run = 0.f;
#pragma unroll
        for (int i = 0; i < 8; ++i) { run += lw[i][e]; g[i][e] = run; }
        auto sw = __builtin_amdgcn_permlane32_swap(__float_as_uint(run), __float_as_uint(run), false, false);
        const float lo_tot = __uint_as_float(sw[0]), hi_tot = __uint_as_float(sw[1]);
        const float off = hh ? lo_tot : 0.f;
#pragma unroll
        for (int i = 0; i < 8; ++i) g[i][e] += off;
        e0x[e] = hh ? __builtin_amdgcn_exp2f(lo_tot * L2E) : 1.0f;
        gam[e] = __builtin_amdgcn_exp2f((lo_tot + hi_tot) * L2E); }
    float inv[8], bon[8], kp[8][2];
#pragma unroll
    for (int i = 0; i < 8; ++i) { const float q0 = kr[i][0] * kkc[0], q1 = kr[i][1] * kkc[1];
        const float ss = sum32(q0 * q0 + q1 * q1); inv[i] = __builtin_amdgcn_rsqf(fmaxf(ss, 1e-24f));
        kp[i][0] = kr[i][0] * (1.0f + (aa[i][0] - 1.0f) * kac[0]); kp[i][1] = kr[i][1] * (1.0f + (aa[i][1] - 1.0f) * kac[1]);
        bon[i] = sum32(rr[i][0] * kp[i][0] * rkc[0] + rr[i][1] * kp[i][1] * rkc[1]); }
    unsigned pBg[2][4], pKg[2][4], pKn[8], pRq[8];
    float eprev[2] = {e0x[0], e0x[1]};
    const int ch = cp >> 2, wo = (cp & 3) * 4;
#pragma unroll
    for (int ip = 0; ip < 4; ++ip) {
        float Bg[2][2], Kg[2][2];
#pragma unroll
        for (int q = 0; q < 2; ++q) { const int i = 2 * ip + q;
            float Kn[2], Rq[2], Bd[2], Kd[2];
#pragma unroll
            for (int e = 0; e < 2; ++e) { const float E1 = __builtin_amdgcn_exp2f(g[i][e] * L2E), Ei = __builtin_amdgcn_exp2f(-g[i][e] * L2E);
                const float kkn = kr[i][e] * kkc[e] * inv[i];
                Kn[e] = -kkn * eprev[e]; Rq[e] = rr[i][e] * E1; Bd[e] = kkn * aa[i][e] * Ei; Kd[e] = kp[i][e] * Ei; Bg[q][e] = Bd[e] * gam[e]; Kg[q][e] = Kd[e] * gam[e]; eprev[e] = E1; }
            const int tt = 8 * hh + i;
            pKn[i] = cvtpk(Kn[0], Kn[1]); pRq[i] = cvtpk(Rq[0], Rq[1]);
            *(LAS unsigned*)(bk + kr_off(tt, ch) + wo) = cvtpk(Bd[0], Bd[1]);
            *(LAS unsigned*)(bk + kr_off(16 + tt, ch) + wo) = cvtpk(Kd[0], Kd[1]); }
#pragma unroll
        for (int e = 0; e < 2; ++e) { pBg[e][ip] = cvtpk(Bg[0][e], Bg[1][e]); pKg[e][ip] = cvtpk(Kg[0][e], Kg[1][e]); }
    }
    wait_slot();
#pragma unroll
    for (int i = 0; i < 8; ++i) { const int tt = 8 * hh + i;
        *(LAS unsigned*)(slot + O_KR + kr_off(tt, ch) + wo) = pKn[i];
        *(LAS unsigned*)(slot + O_KR + kr_off(16 + tt, ch) + wo) = pRq[i]; }
    unsigned pV[2][4];
#pragma unroll
    for (int ip = 0; ip < 4; ++ip) { const unsigned a_ = w.v[2 * ip], b_ = w.v[2 * ip + 1]; pV[0][ip] = (a_ & 0xffffu) | (b_ << 16); pV[1][ip] = (a_ >> 16) | (b_ & 0xffff0000u); }
#pragma unroll
    for (int e = 0; e < 2; ++e) { const int row = 2 * cp + e;
        *(LAS u32x2*)(slot + O_BGT + t_off(row, 0) + 8 * hh) = (u32x2){pBg[e][0], pBg[e][1]}; *(LAS u32x2*)(slot + O_BGT + t_off(row, 1) + 8 * hh) = (u32x2){pBg[e][2], pBg[e][3]};
        *(LAS u32x2*)(slot + O_KGT + t_off(row, 0) + 8 * hh) = (u32x2){pKg[e][0], pKg[e][1]}; *(LAS u32x2*)(slot + O_KGT + t_off(row, 1) + 8 * hh) = (u32x2){pKg[e][2], pKg[e][3]};
        *(LAS u32x2*)(slot + O_VT + t_off(row, 0) + 8 * hh) = (u32x2){pV[e][0], pV[e][1]}; *(LAS u32x2*)(slot + O_VT + t_off(row, 1) + 8 * hh) = (u32x2){pV[e][2], pV[e][3]}; }
    if (hh == 0) *(LAS f32x2v*)(slot + O_GC + 8 * cp) = (f32x2v){gam[0], gam[1]};
    if (cp == 0) {
#pragma unroll
        for (int i = 0; i < 8; ++i) *(LAS float*)(slot + O_BON + 4 * (8 * hh + i)) = bon[i]; }
    LDS_WAIT(); asm volatile("" ::: "memory");
}
template <class WaitSlot>
__device__ __forceinline__ void prep_elem_kv(const Tensors& T, const Raw& w, int h, LAS unsigned char* slot, LAS unsigned char* bk, int lane, const float (&kkc)[2], const float (&kac)[2], const float (&rkc)[2], const WaitSlot& wait_slot) {
    const int cp = lane & 31, hh = lane >> 5;
    float lw[8][2], aa[8][2], rr[8][2], kr[8][2];
#pragma unroll
    for (int i = 0; i < 8; ++i) {
        const unsigned wr_ = w.r[i], wk_ = w.k[i], wl_ = w.l[i], wa_ = w.a[i];
        rr[i][0] = bflo(wr_); rr[i][1] = bfhi(wr_); kr[i][0] = bflo(wk_); kr[i][1] = bfhi(wk_);
        const h16x2 hl = __builtin_bit_cast(h16x2, wl_), ha = __builtin_bit_cast(h16x2, wa_);
        lw[i][0] = (float)hl[0]; lw[i][1] = (float)hl[1]; aa[i][0] = (float)ha[0]; aa[i][1] = (float)ha[1]; }
    float g[8][2], e0x[2], gam[2];
#pragma unroll
    for (int e = 0; e < 2; ++e) { float run = 0.f;
#pragma unroll
        for (int i = 0; i < 8; ++i) { run += lw[i][e]; g[i][e] = run; }
        auto sw = __builtin_amdgcn_permlane32_swap(__float_as_uint(run), __float_as_uint(run), false, false);
        const float lo_tot = __uint_as_float(sw[0]), hi_tot = __uint_as_float(sw[1]);
        const float off = hh ? lo_tot : 0.f;
#pragma unroll
        for (int i = 0; i < 8; ++i) g[i][e] += off;
        e0x[e] = hh ? __builtin_amdgcn_exp2f(lo_tot * L2E) : 1.0f;
        gam[e] = __builtin_amdgcn_exp2f((lo_tot + hi_tot) * L2E); }
    float inv[8], bon[8], kp[8][2];
#pragma unroll
    for (int i = 0; i < 8; ++i) { const float q0 = kr[i][0] * kkc[0], q1 = kr[i][1] * kkc[1];
        const float ss = sum32(q0 * q0 + q1 * q1); inv[i] = __builtin_amdgcn_rsqf(fmaxf(ss, 1e-24f));
        kp[i][0] = kr[i][0] * (1.0f + (aa[i][0] - 1.0f) * kac[0]); kp[i][1] = kr[i][1] * (1.0f + (aa[i][1] - 1.0f) * kac[1]);
        bon[i] = sum32(rr[i][0] * kp[i][0] * rkc[0] + rr[i][1] * kp[i][1] * rkc[1]); }
    unsigned pBg[2][4], pKg[2][4], pKn[8], pRq[8];
    float eprev[2] = {e0x[0], e0x[1]};
    const int ch = cp >> 2, wo = (cp & 3) * 4;
#pragma unroll
    for (int ip = 0; ip < 4; ++ip) {
        float Bg[2][2], Kg[2][2];
#pragma unroll
        for (int q = 0; q < 2; ++q) { const int i = 2 * ip + q;
            float Kn[2], Rq[2], Bd[2], Kd[2];
#pragma unroll
            for (int e = 0; e < 2; ++e) { const float E1 = __builtin_amdgcn_exp2f(g[i][e] * L2E), Ei = __builtin_amdgcn_exp2f(-g[i][e] * L2E);
                const float kkn = kr[i][e] * kkc[e] * inv[i];
                Kn[e] = -kkn * eprev[e]; Rq[e] = rr[i][e] * E1; Bd[e] = kkn * aa[i][e] * Ei; Kd[e] = kp[i][e] * Ei; Bg[q][e] = Bd[e] * gam[e]; Kg[q][e] = Kd[e] * gam[e]; eprev[e] = E1; }
            const int tt = 8 * hh + i;
            pKn[i] = cvtpk(Kn[0], Kn[1]); pRq[i] = cvtpk(Rq[0], Rq[1]);
            *(LAS unsigned*)(bk + kr_off(tt, ch) + wo) = cvtpk(Bd[0], Bd[1]);
            *(LAS unsigned*)(bk + kr_off(16 + tt, ch) + wo) = cvtpk(Kd[0], Kd[1]); }
#pragma unroll
        for (int e = 0; e < 2; ++e) { pBg[e][ip] = cvtpk(Bg[0][e], Bg[1][e]); pKg[e][ip] = cvtpk(Kg[0][e], Kg[1][e]); }
    }
    wait_slot();
#pragma unroll
    for (int i = 0; i < 8; ++i) { const int tt = 8 * hh + i;
        *(LAS unsigned*)(slot + O_KR + kr_off(tt, ch) + wo) = pKn[i];
        *(LAS unsigned*)(slot + O_KR + kr_off(16 + tt, ch) + wo) = pRq[i]; }
    unsigned pV[2][4];
#pragma unroll
    for (int ip = 0; ip < 4; ++ip) { const unsigned a_ = w.v[2 * ip], b_ = w.v[2 * ip + 1]; pV[0][ip] = (a_ & 0xffffu) | (b_ << 16); pV[1][ip] = (a_ >> 16) | (b_ & 0xffff0000u); }
#pragma unroll
    for (int e = 0; e < 2; ++e) { const int row = 2 * cp + e;
        *(LAS u32x2*)(slot + O_BGT + t_off(row, 0) + 8 * hh) = (u32x2){pBg[e][0], pBg[e][1]}; *(LAS u32x2*)(slot + O_BGT + t_off(row, 1) + 8 * hh) = (u32x2){pBg[e][2], pBg[e][3]};
        *(LAS u32x2*)(slot + O_KGT + t_off(row, 0) + 8 * hh) = (u32x2){pKg[e][0], pKg[e][1]}; *(LAS u32x2*)(slot + O_KGT + t_off(row, 1) + 8 * hh) = (u32x2){pKg[e][2], pKg[e][3]};
        *(LAS u32x2*)(slot + O_VT + t_off(row, 0) + 8 * hh) = (u32x2){pV[e][0], pV[e][1]}; *(LAS u32x2*)(slot + O_VT + t_off(row, 1) + 8 * hh) = (u32x2){pV[e][2], pV[e][3]}; }
    if (hh == 0) *(LAS f32x2v*)(slot + O_GC + 8 * cp) = (f32x2v){gam[0], gam[1]};
    if (cp == 0) {
#pragma unroll
        for (int i = 0; i < 8; ++i) *(LAS float*)(slot + O_BON + 4 * (8 * hh + i)) = bon[i]; }
    LDS_WAIT(); asm volatile("" ::: "memory");
}
__device__ __forceinline__ void prep_mfma(LAS unsigned char* slot, LAS unsigned char* bk, int lane) {
    const int r = lane & 31, hq = lane >> 5;
    bf16x8 fKR[4], fBK[4];
#pragma unroll
    for (int s4 = 0; s4 < 4; ++s4) { fKR[s4] = *(const LAS bf16x8*)(slot + O_KR + kr_off(r, 2 * s4 + hq)); fBK[s4] = *(const LAS bf16x8*)(bk + kr_off(r, 2 * s4 + hq)); }
    f32x16 P = {}, PT = {};
#pragma unroll
    for (int s4 = 0; s4 < 4; ++s4) { P = MF(fKR[s4], fBK[s4], P); PT = MF(fBK[s4], fKR[s4], PT); }
    {
        const int jc = r & 15;
#pragma unroll
        for (int gg = 0; gg < 16; ++gg) { const int tr = (gg & 3) + 8 * ((gg >> 2) & 1) + 4 * hq;
            const bool keepP = (gg < 8) ? (jc < tr) : (jc <= tr);
            const bool keepT = (r < 16) ? (tr < jc) : (tr <= jc);
            P[gg] = keepP ? P[gg] : 0.f; PT[gg] = keepT ? PT[gg] : 0.f; }
    }
    float dI[8];
#pragma unroll
    for (int j = 0; j < 8; ++j) dI[j] = (r == rho(j, hq)) ? 1.0f : 0.f;
    const f32x16 Z = {};
    const bf16x8 opN = frag<0>(P), opNt = frag<0>(PT);
    const f32x16 N2 = MF(opNt, opN, Z), N2t = MF(opN, opNt, Z);
    const bf16x8 opN2 = frag<0>(N2), opN2t = frag<0>(N2t);
    const f32x16 N4 = MF(opN2t, opN2, Z), N4t = MF(opN2, opN2t, Z);
    const bf16x8 opN4 = frag<0>(N4), opN4t = frag<0>(N4t);
    const f32x16 N8 = MF(opN4t, opN4, Z);
    const f32x16 G1t = MF(frag_pI<0>(N2, dI), frag_pI<0>(PT, dI), Z);
    const f32x16 G2 = MF(frag_pI<0>(N4t, dI), frag_pI<0>(N8, dI), Z);
    const f32x16 Tm = MF(frag<0>(G1t), frag<0>(G2), Z);
    const f32x16 Dm = MF(frag<0>(Tm), opNt, Z);
    *(LAS bf16x8*)(slot + O_LC + lane * 16) = frag_pI<0>(Dm, dI);
    *(LAS bf16x8*)(slot + O_AM + lane * 16) = frag<8>(PT);
}

__device__ __forceinline__ void chunk_step(LAS unsigned char* slot, LAS unsigned char* oent, f32x16& S0, f32x16& S1, int vh, int lane) {
    const int r = lane & 31, hq = lane >> 5, vrow = 32 * vh + r;
    const bf16x8 fVT = *(const LAS bf16x8*)(slot + O_VT + t_off(vrow, hq));
    const bf16x8 fAM = *(const LAS bf16x8*)(slot + O_AM + lane * 16);
    const f32x16 Z = {};
    f32x16 X = MF(fAM, fVT, Z);
#define LFRAG(tau, u) ({ const u32x2 a_ = *(const LAS u32x2*)(slot + O_KR + kr_off(r, 4 * (tau) + 2 * (u)) + 8 * hq), b_ = *(const LAS u32x2*)(slot + O_KR + kr_off(r, 4 * (tau) + 2 * (u) + 1) + 8 * hq); \
                         u32x4 w_ = {a_.x, a_.y, b_.x, b_.y}; __builtin_bit_cast(bf16x8, w_); })
    X = MF(LFRAG(0, 0), frag<0>(S0), X);
    X = MF(LFRAG(0, 1), frag<8>(S0), X);
    X = MF(LFRAG(1, 0), frag<0>(S1), X);
    X = MF(LFRAG(1, 1), frag<8>(S1), X);
#undef LFRAG
    const bf16x8 fLC = *(const LAS bf16x8*)(slot + O_LC + lane * 16);
    const f32x16 D2 = MF(fLC, frag<0>(X), Z);
#pragma unroll
    for (int j = 0; j < 8; ++j) *(LAS float*)(oent + (rho(j, hq) * 64 + vrow) * 4) = X[8 + j] + D2[8 + j];
    const bf16x8 fU = frag<0>(D2);
#pragma unroll
    for (int q = 0; q < 4; ++q) { const f32x4 g0 = *(const LAS f32x4*)(slot + O_GC + (8 * q + 4 * hq) * 4), g1 = *(const LAS f32x4*)(slot + O_GC + (32 + 8 * q + 4 * hq) * 4);
#pragma unroll
        for (int e = 0; e < 4; ++e) { S0[4 * q + e] *= g0[e]; S1[4 * q + e] *= g1[e]; } }
    S0 = MF(*(const LAS bf16x8*)(slot + O_BGT + t_off(r, hq)), fU, S0);
    S1 = MF(*(const LAS bf16x8*)(slot + O_BGT + t_off(32 + r, hq)), fU, S1);
    S0 = MF(*(const LAS bf16x8*)(slot + O_KGT + t_off(r, hq)), fVT, S0);
    S1 = MF(*(const LAS bf16x8*)(slot + O_KGT + t_off(32 + r, hq)), fVT, S1);
}
#undef MF
}

#define SCAN_SPIN_CAP (1u << 21)
__device__ __forceinline__ void scan_wait(volatile LAS int* f, int target, volatile LAS int* tmo) {
    unsigned sp = 0;
    while (*f < target) { __builtin_amdgcn_s_sleep(1); if (++sp > SCAN_SPIN_CAP || *tmo) { *tmo = 1; break; } }
    asm volatile("" ::: "memory");
}
__device__ __forceinline__ void scan_epilogue(const wkv::Tensors& T, LAS unsigned char* oent, size_t grow_c, int h, int lane, const v4u& va, const v4u& vb, const v4u& ga, const v4u& gb) {
    const int i = lane >> 2, vq = lane & 3;
    float o[16], s = 0.f;
#pragma unroll
    for (int m = 0; m < 4; ++m) { const f32x4 x = *(const LAS f32x4*)(oent + (i * 64 + 16 * vq + 4 * m) * 4); o[4 * m] = x[0]; o[4 * m + 1] = x[1]; o[4 * m + 2] = x[2]; o[4 * m + 3] = x[3]; s += (x[0] + x[1]) + (x[2] + x[3]); }
    const float bonus = *(const LAS float*)(oent + 4096 + 4 * i);
    s += __builtin_bit_cast(float, __builtin_amdgcn_update_dpp(0, __builtin_bit_cast(int, s), 0xB1, 0xf, 0xf, false));
    s += __builtin_bit_cast(float, __builtin_amdgcn_update_dpp(0, __builtin_bit_cast(int, s), 0x4E, 0xf, 0xf, false));
    const float mean = s * (1.f / 64.f); float s2 = 0.f;
#pragma unroll
    for (int m = 0; m < 16; ++m) { o[m] -= mean; s2 += o[m] * o[m]; }
    s2 += __builtin_bit_cast(float, __builtin_amdgcn_update_dpp(0, __builtin_bit_cast(int, s2), 0xB1, 0xf, 0xf, false));
    s2 += __builtin_bit_cast(float, __builtin_amdgcn_update_dpp(0, __builtin_bit_cast(int, s2), 0x4E, 0xf, 0xf, false));
    const float rstd = __builtin_amdgcn_rsqf(s2 * (1.f / 64.f) + GN_EPS);
    const size_t ge = (grow_c + i) * 2048 + h * 64 + 16 * vq;
    const unsigned vw[8] = {va.x, va.y, va.z, va.w, vb.x, vb.y, vb.z, vb.w}, gw[8] = {ga.x, ga.y, ga.z, ga.w, gb.x, gb.y, gb.z, gb.w};
    unsigned ow[8];
#pragma unroll
    for (int m = 0; m < 8; ++m) { const int col = h * 64 + 16 * vq + 2 * m;
        const float r0 = (o[2 * m] * rstd * T.gn_w[col] + T.gn_b[col] + bonus * bflo(vw[m])) * bflo(gw[m]);
        const float r1 = (o[2 * m + 1] * rstd * T.gn_w[col + 1] + T.gn_b[col + 1] + bonus * bfhi(vw[m])) * bfhi(gw[m]);
        ow[m] = pk2(r0, r1); }
    *(GAS v4u*)(T.OG + ge) = (v4u){ow[0], ow[1], ow[2], ow[3]}; *(GAS v4u*)(T.OG + ge + 8) = (v4u){ow[4], ow[5], ow[6], ow[7]};
}
constexpr int G_RG = 16, G_ESTR = 12800;
static_assert((size_t)BATCH * 32 * G_RG * G_ESTR <= 34 * MiB && wkv::SLOT <= G_ESTR, "image rings");
__device__ __forceinline__ bool gwait(unsigned* f, unsigned target, volatile LAS int* tmo) {
    unsigned sp = 0;
    while (__hip_atomic_load(f, __ATOMIC_RELAXED, __HIP_MEMORY_SCOPE_AGENT) < target) { __builtin_amdgcn_s_sleep(2); if (++sp > SCAN_SPIN_CAP || *tmo) { *tmo = 1; return false; } }
    return true;
}
__device__ __forceinline__ void scan_phase_split(Frame& F, const Args& a) {
    wkv::Tensors T;
    T.R = (const unsigned short*)(a.ws + WS_R); T.K = (const unsigned short*)(a.ws + WS_K2); T.V = (const unsigned short*)(a.ws + WS_V2); T.SG = (const unsigned short*)(a.ws + WS_SG);
    T.LOGW = (const unsigned short*)(a.ws + WS_LOGW); T.AA = (const unsigned short*)(a.ws + WS_AA); T.OG = (unsigned short*)(a.ws + WS_OG);
    T.k_k = a.in[16]; T.k_a = a.in[17]; T.r_k = a.in[18]; T.gn_w = a.in[19]; T.gn_b = a.in[20];
    PHASE_TID();
    constexpr int NCH = SEQ / 16, NP = NCH / 2, NH = BATCH * 32;
    const int j = F.vcu % NH, b = j >> 5, h = j & 31;
    const size_t grow0 = (size_t)b * SEQ;
    unsigned char* gring = a.ws + WS_GRING + (size_t)j * G_RG * G_ESTR;
    unsigned* gfl = (unsigned*)(F.ctl + CW_GFL) + j * 32;
    if (F.vcu >= 2 * NH) return;
    if (F.vcu >= NH) {
        volatile LAS int* tmo = (volatile LAS int*)(F.MISC + 16);
        if (tid == 0) *tmo = 0;
        __syncthreads();
        LAS unsigned char* slot = F.lds + RING_OFF + wave * (G_ESTR + 4096); LAS unsigned char* bk = slot + G_ESTR;
        const __amdgpu_buffer_rsrc_t rsrc = __builtin_amdgcn_make_buffer_rsrc((void*)gring, (short)0, G_RG * G_ESTR, 0x00020000);
        wkv::Raw raw;
        wkv::prep_load(T, grow0 + (size_t)(2 * wave + 1) * 16, h, lane, raw);
#pragma unroll 1
        for (int P = wave; P < NP; P += 8) {
            wkv::prep_elem(T, raw, h, slot, bk, lane, [&]() {});
            if (P + 8 < NP) wkv::prep_load(T, grow0 + (size_t)(2 * (P + 8) + 1) * 16, h, lane, raw);
            wkv::prep_mfma(slot, bk, lane);
            LDS_WAIT(); asm volatile("" ::: "memory");
            const int en = P & (G_RG - 1);
            if (P >= G_RG) (void)gwait(gfl + 16 + en, (unsigned)(P - G_RG + 1), tmo);
#pragma unroll
            for (int k = 0; k < 13; ++k) { if (k < 12 || lane < 20) { const wkv::u32x4 v = *(const LAS wkv::u32x4*)(slot + k * 1024 + lane * 16);
                __builtin_amdgcn_raw_buffer_store_b128(v, rsrc, en * G_ESTR + k * 1024 + lane * 16, 0, 16  ); } }
            asm volatile("s_waitcnt vmcnt(0)" ::: "memory");
            if (lane == 0) __hip_atomic_store(gfl + en, (unsigned)(P + 1), __ATOMIC_RELAXED, __HIP_MEMORY_SCOPE_AGENT);
        }
        __syncthreads();
        {
            constexpr int I_SQ = (DM / 64) * (DM / 32);
            LAS float* scr = (LAS float*)(F.lds + RING_OFF + wave * 16384);
            for (int it = (F.vcu - NH) * NWAVES + wave; it < I_SQ; it += NH * NWAVES) p0_transpose_item(a.in[21], DM, (bf16*)(a.ws + WS_WOT), DM, 0, scr, it, lane);
        }
        return;
    }
    volatile LAS int* FL = (volatile LAS int*)(F.lds + wkv::L_FLAGS);
    volatile LAS int* ready = FL; volatile LAS int* cons0 = FL + 8; volatile LAS int* cons1 = FL + 16; volatile LAS int* freed = FL + 24; volatile LAS int* tmo = FL + 32;
    __syncthreads();
    if (tid < 40) FL[tid] = 0;
    __syncthreads();
    if (wave < 2) {
        wkv::f32x16 S0 = {}, S1 = {};
        volatile LAS int* mycons = wave ? cons1 : cons0;
#pragma unroll 1
        for (int c = 0; c < NCH; ++c) { const int sl = c & 7;
            scan_wait(ready + sl, c + 1, tmo);
            if (c >= 8) scan_wait(freed + sl, c - 7, tmo);
            LAS unsigned char* slot = F.lds + sl * wkv::SLOT; LAS unsigned char* oent = F.lds + wkv::L_ORING + sl * wkv::OENT;
            if (wave == 0 && lane < 16) *(LAS float*)(oent + 4096 + 4 * lane) = *(const LAS float*)(slot + wkv::O_BON + 4 * lane);
            wkv::chunk_step(slot, oent, S0, S1, wave, lane);
            LDS_WAIT(); asm volatile("" ::: "memory");
            if (lane == 0) mycons[sl] = c + 1;
        }
    } else {
        const int p = wave - 2;
        LAS unsigned char* bk = F.lds + wkv::L_BK + p * 4096;
        float kkc[2], kac[2], rkc[2];
#pragma unroll
        for (int e_ = 0; e_ < 2; ++e_) { const int col = h * 64 + 2 * (lane & 31) + e_; kkc[e_] = T.k_k[col]; kac[e_] = T.k_a[col]; rkc[e_] = T.r_k[col]; }
        wkv::Raw raw;
        wkv::prep_load(T, grow0 + (size_t)(2 * p) * 16, h, lane, raw);
        unsigned nflag = __hip_atomic_load(gfl + (p & (G_RG - 1)), __ATOMIC_RELAXED, __HIP_MEMORY_SCOPE_AGENT);
#pragma unroll 1
        for (int P = p; P < NP + 2; P += 6) {
            const int c0 = 2 * P, c1 = c0 + 1, Pe = P - 2, e0 = 2 * Pe, e1 = e0 + 1;
            const bool has = P < NP, hasE = Pe >= 0, hasN = P + 6 < NP;
            v4u va0 = {0u, 0u, 0u, 0u}, vb0 = va0, ga0 = va0, gb0 = va0, va1 = va0, vb1 = va0, ga1 = va0, gb1 = va0;
            auto epi_loads = [&]() { if (hasE) {
                const size_t g0 = (grow0 + (size_t)e0 * 16 + (lane >> 2)) * 2048 + h * 64 + 16 * (lane & 3), g1 = g0 + (size_t)16 * 2048;
                va0 = *(const GAS v4u*)(T.V + g0); vb0 = *(const GAS v4u*)(T.V + g0 + 8); ga0 = *(const GAS v4u*)(T.SG + g0); gb0 = *(const GAS v4u*)(T.SG + g0 + 8);
                va1 = *(const GAS v4u*)(T.V + g1); vb1 = *(const GAS v4u*)(T.V + g1 + 8); ga1 = *(const GAS v4u*)(T.SG + g1); gb1 = *(const GAS v4u*)(T.SG + g1 + 8); } };
            if (has) { const int sl0 = c0 & 7, sl1 = c1 & 7, en = P & (G_RG - 1);
                if (c1 >= 8) { scan_wait(cons0 + sl1, c1 - 7, tmo); scan_wait(cons1 + sl1, c1 - 7, tmo); }
                if (nflag < (unsigned)(P + 1)) (void)gwait(gfl + en, (unsigned)(P + 1), tmo);
                if (hasN) nflag = __hip_atomic_load(gfl + ((P + 6) & (G_RG - 1)), __ATOMIC_RELAXED, __HIP_MEMORY_SCOPE_AGENT);
                { const unsigned char* ge = gring + (size_t)en * G_ESTR + lane * 16; LAS unsigned char* ls = F.lds + sl1 * wkv::SLOT;
#pragma unroll
                  for (int k = 0; k < 13; ++k) { if (k < 12 || lane < 20) __builtin_amdgcn_global_load_lds((const unsigned*)(ge + k * 1024), (LAS unsigned*)(ls + k * 1024), 16, 0, 17  ); } }
                wkv::prep_elem_kv(T, raw, h, F.lds + sl0 * wkv::SLOT, bk, lane, kkc, kac, rkc, [&]() { epi_loads(); if (c0 >= 8) { scan_wait(cons0 + sl0, c0 - 7, tmo); scan_wait(cons1 + sl0, c0 - 7, tmo); } });
                if (hasN) wkv::prep_load(T, grow0 + (size_t)(c0 + 12) * 16, h, lane, raw);
                wkv::prep_mfma(F.lds + sl0 * wkv::SLOT, bk, lane);
                LDS_WAIT(); asm volatile("" ::: "memory");
                if (lane == 0) ready[sl0] = c0 + 1;
                if (hasE) { if (hasN) asm volatile("s_waitcnt vmcnt(48)" ::: "memory"); else asm volatile("s_waitcnt vmcnt(8)" ::: "memory"); }
                else      { if (hasN) asm volatile("s_waitcnt vmcnt(40)" ::: "memory"); else asm volatile("s_waitcnt vmcnt(0)" ::: "memory"); }
                if (lane == 0) { ready[sl1] = c1 + 1; __hip_atomic_store(gfl + 16 + en, (unsigned)(P + 1), __ATOMIC_RELAXED, __HIP_MEMORY_SCOPE_AGENT); }
            } else epi_loads();
            if (hasE) {
#pragma unroll
                for (int i_ = 0; i_ < 8; ++i_) asm volatile("" : "+v"(raw.r[i_]), "+v"(raw.k[i_]), "+v"(raw.v[i_]), "+v"(raw.l[i_]), "+v"(raw.a[i_]));
                { const int se = e0 & 7; scan_wait(cons0 + se, e0 + 1, tmo); scan_wait(cons1 + se, e0 + 1, tmo);
                  scan_epilogue(T, F.lds + wkv::L_ORING + se * wkv::OENT, grow0 + (size_t)e0 * 16, h, lane, va0, vb0, ga0, gb0);
                  LDS_WAIT(); asm volatile("" ::: "memory"); if (lane == 0) freed[se] = e0 + 1; }
                { const int se = e1 & 7; scan_wait(cons0 + se, e1 + 1, tmo); scan_wait(cons1 + se, e1 + 1, tmo);
                  scan_epilogue(T, F.lds + wkv::L_ORING + se * wkv::OENT, grow0 + (size_t)e1 * 16, h, lane, va1, vb1, ga1, gb1);
                  LDS_WAIT(); asm volatile("" ::: "memory"); if (lane == 0) freed[se] = e1 + 1; }
            }
        }
    }
    __syncthreads();
}
__device__ __forceinline__ void scan_phase(Frame& F, const Args& a) {
    wkv::Tensors T;
    T.R = (const unsigned short*)(a.ws + WS_R); T.K = (const unsigned short*)(a.ws + WS_K2); T.V = (const unsigned short*)(a.ws + WS_V2); T.SG = (const unsigned short*)(a.ws + WS_SG);
    T.LOGW = (const unsigned short*)(a.ws + WS_LOGW); T.AA = (const unsigned short*)(a.ws + WS_AA); T.OG = (unsigned short*)(a.ws + WS_OG);
    T.k_k = a.in[16]; T.k_a = a.in[17]; T.r_k = a.in[18]; T.gn_w = a.in[19]; T.gn_b = a.in[20];
    PHASE_TID();
    constexpr int NCH = SEQ / 16, NPREP = wkv::NPREP;
    if (F.vcu >= BATCH * 32) {
        constexpr int I_SQ = (DM / 64) * (DM / 32);
        LAS float* scr = (LAS float*)(F.lds + RING_OFF + wave * 16384);
        for (int it = (F.vcu - BATCH * 32) * NWAVES + wave; it < I_SQ; it += (F.G - BATCH * 32) * NWAVES) p0_transpose_item(a.in[21], DM, (bf16*)(a.ws + WS_WOT), DM, 0, scr, it, lane);
        return;
    }
    volatile LAS int* FL = (volatile LAS int*)(F.lds + wkv::L_FLAGS);
    volatile LAS int* ready = FL; volatile LAS int* cons0 = FL + 8; volatile LAS int* cons1 = FL + 16; volatile LAS int* freed = FL + 24; volatile LAS int* tmo = FL + 32;
    for (int bh = F.vcu; bh < BATCH * 32; bh += F.G) {
        const int b = bh >> 5, h = bh & 31;
        const size_t grow0 = (size_t)b * SEQ;
        __syncthreads();
        if (tid < 40) FL[tid] = 0;
        __syncthreads();
        if (wave < 2) {
            wkv::f32x16 S0 = {}, S1 = {};
            volatile LAS int* mycons = wave ? cons1 : cons0;
#pragma unroll 1
            for (int c = 0; c < NCH; ++c) { const int sl = c & 7;
                scan_wait(ready + sl, c + 1, tmo);
                if (c >= 8) scan_wait(freed + sl, c - 7, tmo);
                LAS unsigned char* slot = F.lds + sl * wkv::SLOT; LAS unsigned char* oent = F.lds + wkv::L_ORING + sl * wkv::OENT;
                if (wave == 0 && lane < 16) *(LAS float*)(oent + 4096 + 4 * lane) = *(const LAS float*)(slot + wkv::O_BON + 4 * lane);
                wkv::chunk_step(slot, oent, S0, S1, wave, lane);
                LDS_WAIT(); asm volatile("" ::: "memory");
                if (lane == 0) mycons[sl] = c + 1;
            }
        } else {
            const int p = wave - 2;
            LAS unsigned char* bk = F.lds + wkv::L_BK + p * 4096;
            wkv::Raw raw;
            wkv::prep_load(T, grow0 + (size_t)p * 16, h, lane, raw);
#pragma unroll 1
            for (int c = p; c < NCH + NPREP; c += NPREP) {
                const int e = c - NPREP;
                v4u va = {0u, 0u, 0u, 0u}, vb = va, ga = va, gb = va;
                const size_t ge = (grow0 + (size_t)(e < 0 ? 0 : e) * 16 + (lane >> 2)) * 2048 + h * 64 + 16 * (lane & 3);
                auto epi_loads = [&]() { if (e >= 0) { va = *(const GAS v4u*)(T.V + ge); vb = *(const GAS v4u*)(T.V + ge + 8); ga = *(const GAS v4u*)(T.SG + ge); gb = *(const GAS v4u*)(T.SG + ge + 8); } };
                if (c < NCH) { const int sl = c & 7;
                    wkv::prep_elem(T, raw, h, F.lds + sl * wkv::SLOT, bk, lane, [&]() { epi_loads(); if (c >= 8) { scan_wait(cons0 + sl, c - 7, tmo); scan_wait(cons1 + sl, c - 7, tmo); } });
                    if (c + NPREP < NCH) wkv::prep_load(T, grow0 + (size_t)(c + NPREP) * 16, h, lane, raw);
                    wkv::prep_mfma(F.lds + sl * wkv::SLOT, bk, lane);
                    LDS_WAIT(); asm volatile("" ::: "memory");
                    if (lane == 0) ready[sl] = c + 1;
                }
                if (c >= NCH) epi_loads();
                if (e >= 0) { const int se = e & 7;
                    scan_wait(cons0 + se, e + 1, tmo); scan_wait(cons1 + se, e + 1, tmo);
#pragma unroll
                    for (int i_ = 0; i_ < 8; ++i_) asm volatile("" : "+v"(raw.r[i_]), "+v"(raw.k[i_]), "+v"(raw.v[i_]), "+v"(raw.l[i_]), "+v"(raw.a[i_]));
                    scan_epilogue(T, F.lds + wkv::L_ORING + se * wkv::OENT, grow0 + (size_t)e * 16, h, lane, va, vb, ga, gb);
                    LDS_WAIT(); asm volatile("" ::: "memory");
                    if (lane == 0) freed[se] = e + 1;
                }
            }
        }
    }
    __syncthreads();
    if (F.G <= BATCH * 32) {
        constexpr int I_SQ = (DM / 64) * (DM / 32);
        LAS float* scr = (LAS float*)(F.lds + RING_OFF + wave * 16384);
        for (int it = F.vcu * NWAVES + wave; it < I_SQ; it += F.G * NWAVES) p0_transpose_item(a.in[21], DM, (bf16*)(a.ws + WS_WOT), DM, 0, scr, it, lane);
    }
}

__global__ void __launch_bounds__(NWAVES * 64, 2) fwd_kernel(Args args) {
    extern __shared__ __attribute__((aligned(16))) unsigned char lds[];
    Frame F;
    F.lds = (LAS unsigned char*)lds;
    F.MISC = (volatile LAS unsigned*)(F.lds + MISC_OFF);
    F.G = gridDim.x; { const int bx = blockIdx.x; F.vcu = (F.G % 8 == 0) ? (bx % 8) * (F.G / 8) + bx / 8 : bx; }
    unsigned char* ws = args.ws;
    F.ctl = (gu32*)(ws + WS_CTL);
    for (int u = threadIdx.x; u < (LDS_BYTES - LDSCTL_OFF) / 4; u += NWAVES * 64) ((LAS unsigned*)(F.lds + LDSCTL_OFF))[u] = 0u;
    __syncthreads();
    XcdBarrier bar; bar.bar = (unsigned*)(F.ctl + CW_BAR); bar.x = 0; bar.st = nullptr;
    if (N_LAUNCHES == 1) bar = xcd_barrier_post((unsigned*)(F.ctl + CW_BAR), F.MISC + 8);
#define GRID_BAR() do { if (N_LAUNCHES == 1) xcd_barrier(bar); } while (0)
    const int lo = args.ph_lo, hi = args.ph_hi;
#ifndef PH_MASK
#define PH_MASK 0xFFF
#endif
#define IN(k) ((((PH_MASK) >> (k)) & 1) && lo <= (k) && (k) < hi)
#define BOTH(k) (IN(k) && IN((k) + 1))
#ifndef REPEAT_MASK
#define REPEAT_MASK 0
#endif
#define REPS(k) for (int rep_ = 0; rep_ < 1 + (((REPEAT_MASK) >> (k)) & 1); ++rep_) if (((rep_ > 0 && N_LAUNCHES == 1) ? (xcd_barrier(bar), 0) : 0), true)
    bf16* H = (bf16*)(ws + WS_H); bf16* MIX = (bf16*)(ws + WS_MIX);

    if (IN(0)) { REPS(0) p0_prologue(F, args); if (BOTH(0)) GRID_BAR(); }

    if (IN(1)) { REPS(1) {
        pg8::Gemm g{(const bf16*)(ws + WS_XB), (const bf16*)(ws + WS_WINT), M, EVEN_IN, DM, DM, DM, 0, 0};
        pg8::StaticOrder S; S.init(M, EVEN_IN, F.G, (int)blockIdx.x);
        pg8::EpiH E{H};
        pg8::gemm_phase<pg8::EpiH, pg8::StaticOrder>(F.lds + RING_OFF, g, S, E); }
        if (BOTH(1)) GRID_BAR();
    }

    if (IN(2)) { REPS(2) {
        const bool weights_first = (F.vcu & 1) != 0;
        if (weights_first) { late_weights(F, args); __syncthreads(); }
#ifndef NO_POOL
        for (int rp_ = 0; rp_ < 1 + (((REPEAT_MASK) >> 12) & 1); ++rp_) {
            if (rp_ > 0 && N_LAUNCHES == 1) xcd_barrier(bar);
            pg8::StaticOrder SO; SO.init(M, 1024, F.G, (int)blockIdx.x); pg8::Unit u;
            bf16* POOLED = (bf16*)(ws + WS_POOLED);
            for (int i = 0; SO.next(i, u); ++i) {
                pool_tile(F, H, POOLED, u.pm, u.pn);
                VM_WAIT(); __syncthreads();
                if (threadIdx.x == 0) { __builtin_amdgcn_fence(__ATOMIC_ACQUIRE, "agent"); VM_WAIT(); }
                __syncthreads();
                pg8::Gemm g{POOLED, (const bf16*)(ws + WS_WPOOLT), M, 1024, 256, 1024, 256, 1, 256};
                pg8::OneUnit S1{u};
                pg8::EpiPool E{MIX, H, args.in[3]};
                pg8::gemm_phase<pg8::EpiPool, pg8::OneUnit>(F.lds + RING_OFF, g, S1, E);
            }
        }
#endif
#ifndef NO_ATTN
        for (int rp_ = 0; rp_ < 1 + (((REPEAT_MASK) >> 13) & 1); ++rp_) {
            if (rp_ > 0 && N_LAUNCHES == 1) xcd_barrier(bar);
            const sba::bf16* Hb = (const sba::bf16*)H; sba::bf16* Mb = (sba::bf16*)MIX;
            for (int item = F.vcu; item < 256; item += F.G) {
                const int bh = item >> 3, x = item & 7, b = bh >> 3, h = bh & 7;
                const size_t rowbase = (size_t)b * SEQ;
                const sba::bf16* Kp = Hb + rowbase * 6144 + 1024 + h * 128; const sba::bf16* Vp = Hb + rowbase * 6144 + 2048 + h * 128;
#pragma unroll 1
                for (int pass = 0; pass < 2; ++pass) {
                    const int qb = pass ? 15 - x : x; sba::BlockRef br;
                    br.P0 = qb * 256; br.Q = Hb + (rowbase + br.P0) * 6144 + h * 128; br.K = Kp; br.V = Vp; br.G = Hb + (rowbase + br.P0) * 6144 + 3072 + h * 128; br.O = Mb + (rowbase + br.P0) * 2048 + h * 128;
                    sba::sb_block(br, (char*)lds + RING_OFF);
                }
            }
        }
#endif
        if (!weights_first) { __syncthreads(); late_weights(F, args); }
        }
        if (BOTH(2)) GRID_BAR();
    }

    if (IN(3)) { REPS(3) {
        pg8::Gemm g{MIX, (const bf16*)(ws + WS_WOUTT), M, DM, DM, DM, DM, 0, 0};
        pg8::StaticOrder S; S.init(M, DM, F.G, (int)blockIdx.x);
        pg8::EpiY E{(bf16*)(ws + WS_Y0)};
        pg8::gemm_phase<pg8::EpiY, pg8::StaticOrder>(F.lds + RING_OFF, g, S, E); }
        if (BOTH(3)) GRID_BAR();
    }

    if (IN(4)) { REPS(4) ln_mix_phase(F, args); if (BOTH(4)) GRID_BAR(); }

    if (IN(5)) { REPS(5) {
        pg8::Gemm g{(const bf16*)(ws + WS_XMIX), (const bf16*)(ws + WS_W2CAT), M, N2CAT, DM, DM, DM, 2, (size_t)M * DM};
        pg8::ArrayOrder S; S.init(M, F.G, (int)blockIdx.x);
        pg8::Epi5 E{{(bf16*)(ws + WS_R), (bf16*)(ws + WS_K2), (bf16*)(ws + WS_V2), (bf16*)(ws + WS_SG)}, (bf16*)(ws + WS_TL), (unsigned*)(F.ctl + CW_ACNT), (unsigned)((M / 256) * 8)};
        pg8::gemm_phase<pg8::Epi5, pg8::ArrayOrder, true, true, true>(F.lds + RING_OFF, g, S, E);
        { unsigned* acnt = (unsigned*)(F.ctl + CW_ACNT);
          if (threadIdx.x == 0) { unsigned sp = 0; while (__hip_atomic_load(acnt + 4, __ATOMIC_RELAXED, __HIP_MEMORY_SCOPE_AGENT) < (unsigned)(2 * (M / 256))) { __builtin_amdgcn_s_sleep(4); if (++sp > (1u << 22)) break; } }
          __syncthreads(); __builtin_amdgcn_fence(__ATOMIC_ACQUIRE, "agent");
          pg8::Gemm g8{(const bf16*)(ws + WS_TL), (const bf16*)(ws + WS_L2T), M, 4096, 128, 256, 128, 3, 128};
          pg8::TailOrder S8; S8.init(F.G, (int)blockIdx.x, 2 * (M / 256));
          pg8::Epi6 E8{(unsigned short*)(ws + WS_LOGW), (unsigned short*)(ws + WS_AA), args.in[10], args.in[13]};
          pg8::gemm_phase<pg8::Epi6, pg8::TailOrder>(F.lds + RING_OFF, g8, S8, E8); } }
        if (BOTH(5)) GRID_BAR();
    }

    if (IN(9)) { REPS(9) { if (F.G >= 2 * BATCH * 32) scan_phase_split(F, args); else scan_phase(F, args); } if (BOTH(9)) GRID_BAR(); }

    if (IN(10)) {
        pg8::Gemm g{(const bf16*)(ws + WS_OG), (const bf16*)(ws + WS_WOT), M, DM, DM, DM, DM, 0, 0};
        pg8::StaticOrder S; S.init(M, DM, F.G, (int)blockIdx.x);
        pg8::EpiY E{(bf16*)(ws + WS_Y1)};
        pg8::gemm_phase<pg8::EpiY, pg8::StaticOrder>(F.lds + RING_OFF, g, S, E);
        if (BOTH(10)) GRID_BAR();
    }

    if (IN(11)) { final_ln_phase(F, args); }
#undef IN
#undef BOTH
#undef GRID_BAR
}

extern "C" void kernel_launch(void* const* d_in, const int* in_sizes, int n_in, void* d_out, int out_size, void* d_ws, size_t ws_size, hipStream_t stream) {
    static int grid = 0;
    if (grid == 0) {
        if (n_in != 24 || in_sizes[0] != M * DM || out_size != M * DM || ws_size < WS_END) { fprintf(stderr, "kernel_launch: shape/workspace mismatch (n_in %d, in0 %d, out %d, ws %zu, need %zu)\n", n_in, n_in > 0 ? in_sizes[0] : -1, out_size, ws_size, (size_t)WS_END); grid = -1; return; }
        int dev = 0, cus = 0;
        if (hipGetDevice(&dev) != hipSuccess || hipDeviceGetAttribute(&cus, hipDeviceAttributeMultiprocessorCount, dev) != hipSuccess) { grid = -1; return; }
        if (hipFuncSetAttribute((const void*)fwd_kernel, hipFuncAttributeMaxDynamicSharedMemorySize, LDS_BYTES) != hipSuccess) { fprintf(stderr, "kernel_launch: hipFuncSetAttribute failed\n"); grid = -1; return; }
        int per_cu = 0;
        if (hipOccupancyMaxActiveBlocksPerMultiprocessor(&per_cu, (const void*)fwd_kernel, NWAVES * 64, LDS_BYTES) != hipSuccess || per_cu < 1) fprintf(stderr, "kernel_launch: occupancy query says %d\n", per_cu);
        (void)hipGetLastError();
        grid = cus;
    }
    if (grid < 0) return;
    if (hipMemsetAsync((char*)d_ws + WS_CTL, 0, CTL_ZERO_BYTES, stream) != hipSuccess) return;
    Args a{};
    for (int i = 0; i < 24; ++i) a.in[i] = (const float*)d_in[i];
    a.out = (float*)d_out; a.ws = (unsigned char*)d_ws;
    if (N_LAUNCHES == 1) { a.ph_lo = 0; a.ph_hi = N_PHASES; a.li = 0; hipLaunchKernelGGL(fwd_kernel, dim3(grid), dim3(NWAVES * 64), LDS_BYTES, stream, a); }
    else for (int li = 0; li < N_PHASES; ++li) { a.ph_lo = li; a.ph_hi = li + 1; a.li = li; hipLaunchKernelGGL(fwd_kernel, dim3(grid), dim3(NWAVES * 64), LDS_BYTES, stream, a); }
}
```

```cpp
#include <hip/hip_runtime.h>
#include <hip/hip_bf16.h>
#include <cstdio>
#include <cstdint>

#ifndef MK_N_LAUNCHES
#define MK_N_LAUNCHES 1
#endif

namespace pg8 {
#define PG8_LAS __attribute__((address_space(3)))
typedef unsigned short bf16_t;
typedef short bf16x8 __attribute__((ext_vector_type(8)));
typedef float f32x4 __attribute__((ext_vector_type(4)));
typedef float f32x2 __attribute__((ext_vector_type(2)));
typedef unsigned u32x4 __attribute__((ext_vector_type(4)));
constexpr int BM = 256, BK = 64, HALF = 128, HTB = HALF * BK * 2, STAGE_BYTES = 8 * HTB, NXCD = 8, WGM = 8;

__host__ __device__ __forceinline__ int lds_byte(int r, int c) { const int st = (r >> 4) * 2 + (c >> 5), rr = r & 15, cc = c & 31, ob = rr * 64 + cc * 2; return st * 1024 + (ob ^ (((ob >> 9) & 1) << 5)); }
__host__ __device__ __forceinline__ void stage_rc(int b, int& R, int& C) { const int st = b / 1024, sb = b % 1024, swz = sb ^ (((sb >> 9) & 1) << 5); R = (st >> 1) * 16 + swz / 64; C = (st & 1) * 32 + (swz % 64) / 2; }
__host__ __device__ __forceinline__ int perm32(int rho) { const int n = rho >> 4, i = rho & 15; return 8 * (i >> 2) + 4 * n + (i & 3); }

struct Unit { int pm, pn; };
struct Gemm { const bf16_t* A; const bf16_t* Bt; int M, N, K, lda, ldb; int asel; size_t astride; };
__device__ __forceinline__ const bf16_t* a_base(const Gemm& g, const Unit& u) {
    int idx = 0;
    if (g.asel == 1) idx = u.pn;
    else if (g.asel == 2) idx = u.pn < 32 ? (u.pn >> 3) : (u.pn - 28);
    else if (g.asel == 3) idx = u.pn >> 3;
    return g.A + (size_t)idx * g.astride;
}

struct StaticOrder {
    int nM, nN, nwg, G, c;
    __host__ __device__ void init(int M, int N, int G_, int c_) { nM = M / BM; nN = N / BM; nwg = nM * nN; G = G_; c = c_; }
    __host__ __device__ bool next(int i, Unit& u) const { return next_at((long)i * G + c, u); }
    __host__ __device__ bool next_at(long L, Unit& u) const {
        if (L >= nwg) return false;
        int wgid = (int)L; { const int q = nwg / NXCD, r = nwg % NXCD, xcd = wgid % NXCD, off = wgid / NXCD; wgid = (xcd < r ? xcd * (q + 1) : r * (q + 1) + (xcd - r) * q) + off; }
        const int nig = WGM * nN, gid = wgid / nig, fm = gid * WGM, gsz = (nM - fm) < WGM ? (nM - fm) : WGM;
        u.pm = fm + ((wgid % nig) % gsz); u.pn = (wgid % nig) / gsz; return true;
    }
};
struct ArrayOrder {
    StaticOrder sub; int nm;
    __host__ __device__ void init(int M, int G_, int c_) { sub.init(M, 2048, G_, c_); nm = M / BM; }
    __host__ __device__ bool next(int i, Unit& u) const {
        const long L0 = (long)i * sub.G + sub.c; const long per = sub.nwg, nl = 2 * nm;
        if (L0 < nl) { u.pm = (int)(L0 >> 1); u.pn = 32 + (int)(L0 & 1); return true; }
        const long L = L0 - nl; if (L >= 4 * per) return false;
        const int a = (int)(L / per); sub.next_at(L - a * per, u); u.pn += 8 * a; return true;
    }
};
struct TailOrder { int first, n;
    __host__ __device__ void init(int G_, int c_, int nlora) { const int c = c_; const bool late = c < nlora;
        const int nearly = G_ - nlora; const int per_late = nearly > 0 ? 1 : (1024 + G_ - 1) / G_, late_total = per_late * (nlora < G_ ? nlora : G_);
        if (late) { first = c * per_late; n = per_late; } else { const int rest = 1024 - late_total, per = (rest + nearly - 1) / nearly; first = late_total + (c - nlora) * per; n = per; }
        if (first > 1024) first = 1024; if (first + n > 1024) n = 1024 - first; }
    __host__ __device__ bool next(int i, Unit& u) const { if (i >= n) return false; const int j = first + i; u.pm = j >> 4; u.pn = j & 15; return true; } };
struct OneUnit { Unit u0; __device__ __forceinline__ bool next(int i, Unit& u) const { if (i != 0) return false; u = u0; return true; } };

typedef __bf16 bf16x2_t __attribute__((ext_vector_type(2)));
__device__ __forceinline__ unsigned cvt_pk_bf16(float lo, float hi) { f32x2 v = {lo, hi}; bf16x2_t b = __builtin_convertvector(v, bf16x2_t); return __builtin_bit_cast(unsigned, b); }
__device__ __forceinline__ float bf_lo(unsigned w) { return __uint_as_float(w << 16); }
__device__ __forceinline__ float bf_hi(unsigned w) { return __uint_as_float(w & 0xffff0000u); }
__device__ __forceinline__ float sigmoidf_(float x) { return __builtin_amdgcn_rcpf(1.0f + __builtin_amdgcn_exp2f(-1.4426950408889634f * x)); }
__device__ __forceinline__ float siluf_(float x) { return x * sigmoidf_(x); }
__device__ __forceinline__ float tanhf_(float x) { return 1.0f - 2.0f * __builtin_amdgcn_rcpf(1.0f + __builtin_amdgcn_exp2f(2.8853900817779268f * x)); }

constexpr float QSCALE2 = 0.08838834764831845f * 1.4426950408889634f;

struct EpiH {
    static constexpr bool PERM = true;
    bf16_t* O;
    __device__ __forceinline__ void operator()(const f32x4 (&acc)[2][2][4][2], const Unit& u, int wr, int wc, int fr, int fq) const {
        const int row0 = u.pm * BM + wr * 64 + fr, col0 = u.pn * BM + wc * 32 + 8 * fq;
        const int mode = u.pn < 4 ? 1 : (((u.pn >= 12 && u.pn < 16) || u.pn >= 20) ? 2 : 0);
#pragma unroll
        for (int ai = 0; ai < 2; ++ai)
#pragma unroll
            for (int m = 0; m < 4; ++m) { bf16_t* rowp = O + (size_t)(row0 + ai * HALF + m * 16) * 6144 + col0;
#pragma unroll
                for (int bj = 0; bj < 2; ++bj) { f32x4 v0 = acc[ai][bj][m][0], v1 = acc[ai][bj][m][1];
                    if (mode == 1) { v0 = v0 * QSCALE2; v1 = v1 * QSCALE2; }
                    else if (mode == 2) {
#pragma unroll
                        for (int e = 0; e < 4; ++e) { v0[e] = siluf_(v0[e]); v1[e] = siluf_(v1[e]); } }
                    u32x4 w; w.x = cvt_pk_bf16(v0[0], v0[1]); w.y = cvt_pk_bf16(v0[2], v0[3]); w.z = cvt_pk_bf16(v1[0], v1[1]); w.w = cvt_pk_bf16(v1[2], v1[3]);
                    *(u32x4*)(rowp + bj * HALF) = w; } }
    }
};
struct EpiPool {
    static constexpr bool PERM = true;
    bf16_t* MIX; const bf16_t* Hb; const float* pscale;
    __device__ __forceinline__ void operator()(const f32x4 (&acc)[2][2][4][2], const Unit& u, int wr, int wc, int fr, int fq) const {
        const int row0 = u.pm * BM + wr * 64 + fr, col0 = u.pn * BM + wc * 32 + 8 * fq;
#pragma unroll
        for (int ai = 0; ai < 2; ++ai)
#pragma unroll
            for (int m = 0; m < 4; ++m) { const size_t row = (size_t)(row0 + ai * HALF + m * 16);
#pragma unroll
                for (int bj = 0; bj < 2; ++bj) {
                    const f32x4 s0 = *(const f32x4*)(pscale + col0 + bj * HALF), s1 = *(const f32x4*)(pscale + col0 + bj * HALF + 4);
                    const u32x4 gb = *(const u32x4*)(Hb + row * 6144 + 5120 + col0 + bj * HALF);
                    f32x4 v0 = acc[ai][bj][m][0] * s0, v1 = acc[ai][bj][m][1] * s1;
                    v0[0] *= bf_lo(gb.x); v0[1] *= bf_hi(gb.x); v0[2] *= bf_lo(gb.y); v0[3] *= bf_hi(gb.y);
                    v1[0] *= bf_lo(gb.z); v1[1] *= bf_hi(gb.z); v1[2] *= bf_lo(gb.w); v1[3] *= bf_hi(gb.w);
                    u32x4 w; w.x = cvt_pk_bf16(v0[0], v0[1]); w.y = cvt_pk_bf16(v0[2], v0[3]); w.z = cvt_pk_bf16(v1[0], v1[1]); w.w = cvt_pk_bf16(v1[2], v1[3]);
                    *(u32x4*)(MIX + row * 2048 + 1024 + col0 + bj * HALF) = w; }
                asm volatile("" ::: "memory"); }
    }
};
struct EpiY {
    static constexpr bool PERM = true;
    bf16_t* O;
    __device__ __forceinline__ void operator()(const f32x4 (&acc)[2][2][4][2], const Unit& u, int wr, int wc, int fr, int fq) const {
        const int row0 = u.pm * BM + wr * 64 + fr, col0 = u.pn * BM + wc * 32 + 8 * fq;
#pragma unroll
        for (int ai = 0; ai < 2; ++ai)
#pragma unroll
            for (int m = 0; m < 4; ++m) { bf16_t* rowp = O + (size_t)(row0 + ai * HALF + m * 16) * 2048 + col0;
#pragma unroll
                for (int bj = 0; bj < 2; ++bj) { const f32x4 v0 = acc[ai][bj][m][0], v1 = acc[ai][bj][m][1];
                    u32x4 w; w.x = cvt_pk_bf16(v0[0], v0[1]); w.y = cvt_pk_bf16(v0[2], v0[3]); w.z = cvt_pk_bf16(v1[0], v1[1]); w.w = cvt_pk_bf16(v1[2], v1[3]);
                    *(u32x4*)(rowp + bj * HALF) = w; } }
    }
};
struct Epi5 {
    static constexpr bool PERM = true;
    bf16_t* O4[4]; bf16_t* TL; unsigned* cnt; unsigned tgt; volatile PG8_LAS unsigned* seen;
    __device__ __forceinline__ bool wants_publish(const Unit& u) const { return u.pn >= 32; }
    __device__ __forceinline__ void publish(const Unit&) const { __builtin_amdgcn_fence(__ATOMIC_RELEASE, "agent"); __hip_atomic_fetch_add(cnt + 4, 1u, __ATOMIC_RELAXED, __HIP_MEMORY_SCOPE_AGENT); }
    __device__ __forceinline__ void before(const Unit& u, int tid) const {
        if (u.pn >= 32) return;
        const int a = u.pn >> 3;
        if (tid == 0) { __hip_atomic_fetch_add(cnt + a, 1u, __ATOMIC_RELAXED, __HIP_MEMORY_SCOPE_AGENT);
            if (a >= 1 && seen[a - 1] == 0u) { unsigned sp = 0; while (__hip_atomic_load(cnt + a - 1, __ATOMIC_RELAXED, __HIP_MEMORY_SCOPE_AGENT) < tgt) { __builtin_amdgcn_s_sleep(4); if (++sp > (1u << 22)) break; }
                seen[a - 1] = 1u; } }
        if (a >= 1) __builtin_amdgcn_s_barrier();
    }
    __device__ __forceinline__ void operator()(const f32x4 (&acc)[2][2][4][2], const Unit& u, int wr, int wc, int fr, int fq) const {
        const int row0 = u.pm * BM + wr * 64 + fr, ct = wc * 32 + 8 * fq;
#pragma unroll
        for (int ai = 0; ai < 2; ++ai)
#pragma unroll
            for (int m = 0; m < 4; ++m) { const size_t row = (size_t)(row0 + ai * HALF + m * 16);
#pragma unroll
                for (int bj = 0; bj < 2; ++bj) { f32x4 v0 = acc[ai][bj][m][0], v1 = acc[ai][bj][m][1]; const int c = ct + bj * HALF;
                    bf16_t* dst;
                    if (u.pn < 32) { const int arr = u.pn >> 3; dst = (arr == 0 ? O4[0] : arr == 1 ? O4[1] : arr == 2 ? O4[2] : O4[3]) + row * 2048 + (u.pn & 7) * BM + c;
                        if (arr == 3) {
#pragma unroll
                            for (int e = 0; e < 4; ++e) { v0[e] = siluf_(v0[e]); v1[e] = siluf_(v1[e]); } } }
                    else if (u.pn == 32) { if (c >= 128) continue; dst = TL + row * 256 + c;
#pragma unroll
                        for (int e = 0; e < 4; ++e) { v0[e] = tanhf_(v0[e]); v1[e] = tanhf_(v1[e]); } }
                    else { if (c >= 128) continue; dst = TL + row * 256 + 128 + c; }
                    u32x4 w; w.x = cvt_pk_bf16(v0[0], v0[1]); w.y = cvt_pk_bf16(v0[2], v0[3]); w.z = cvt_pk_bf16(v1[0], v1[1]); w.w = cvt_pk_bf16(v1[2], v1[3]);
                    *(u32x4*)dst = w; } }
    }
};
typedef _Float16 h16x2 __attribute__((ext_vector_type(2)));
__device__ __forceinline__ unsigned pk_h2(float a, float b) { h16x2 h = {(_Float16)a, (_Float16)b}; return __builtin_bit_cast(unsigned, h); }
struct Epi6 {
    static constexpr bool PERM = true;
    unsigned short* LOGW; unsigned short* AA; const float* w0; const float* a0;
    __device__ __forceinline__ void operator()(const f32x4 (&acc)[2][2][4][2], const Unit& u, int wr, int wc, int fr, int fq) const {
        const int row0 = u.pm * BM + wr * 64 + fr; const bool isw = u.pn < 8;
        const int col0 = (u.pn & 7) * BM + wc * 32 + 8 * fq; unsigned short* O = isw ? LOGW : AA; const float* bias = isw ? w0 : a0; const float sc = isw ? -0.6065306597126334f : 1.0f;
#pragma unroll
        for (int bj = 0; bj < 2; ++bj) { const f32x4 b0 = *(const f32x4*)(bias + col0 + bj * HALF), b1 = *(const f32x4*)(bias + col0 + bj * HALF + 4);
#pragma unroll
            for (int ai = 0; ai < 2; ++ai)
#pragma unroll
                for (int m = 0; m < 4; ++m) { f32x4 v0 = acc[ai][bj][m][0] + b0, v1 = acc[ai][bj][m][1] + b1;
#pragma unroll
                    for (int e = 0; e < 4; ++e) { v0[e] = sc * sigmoidf_(v0[e]); v1[e] = sc * sigmoidf_(v1[e]); }
                    u32x4 w; w.x = pk_h2(v0[0], v0[1]); w.y = pk_h2(v0[2], v0[3]); w.z = pk_h2(v1[0], v1[1]); w.w = pk_h2(v1[2], v1[3]);
                    *(u32x4*)(O + (size_t)(row0 + ai * HALF + m * 16) * 2048 + col0 + bj * HALF) = w; } }
    }
};
template <class Epi, class Sched, bool ALIGN_EPI = true, bool PRE = false, bool PUB = false>
__device__ __forceinline__ void gemm_phase(PG8_LAS unsigned char* lds, const Gemm g, const Sched& S, const Epi& E) {
    int tid = threadIdx.x; asm volatile("" : "+v"(tid));
    const int wid = __builtin_amdgcn_readfirstlane(tid >> 6), lane = tid & 63, wr = wid >> 2, wc = wid & 3, fr = lane & 15, fq = lane >> 4;
    const int K = g.K, nt = K / BK;
    const int kmask = nt - 1, rot = ((int)(((unsigned)blockIdx.x & 7u) * (unsigned)nt) >> 3) + (nt >= 32 ? (int)((blockIdx.x >> 3) & 3u) : 0);
#define PG8_KO(s_) ((size_t)(((s_) + rot) & kmask) * kstep)
    unsigned voffA[2], voffB[2];
#pragma unroll
    for (int i = 0; i < 2; ++i) { int R, C; stage_rc(tid * 16 + i * 8192, R, C); const int Rb = Epi::PERM ? ((R & ~31) + perm32(R & 31)) : R;
        voffA[i] = (unsigned)(R * g.lda + C) * 2u; voffB[i] = (unsigned)(Rb * g.ldb + C) * 2u; }
    const size_t kstep = (size_t)(BK * 2);
    const size_t hstepA = (size_t)HALF * g.lda * 2, hstepB = (size_t)HALF * g.ldb * 2;
    const size_t tstepA = 2 * hstepA, tstepB = 2 * hstepB;
    const unsigned ldsw = (unsigned)wid * 1024u;
    const int aoff = lds_byte(wr * 64 + fr, fq * 8), boff = lds_byte(wc * 32 + fr, fq * 8);
#define PG8_SA(b, h) (((b) * 2 + (h)) * HTB)
#define PG8_SB(b, h) ((4 + (b) * 2 + (h)) * HTB)
#define PG8_STAGE(bufoff, gbase, voff) do { _Pragma("unroll") for (int _i = 0; _i < 2; ++_i) \
        __builtin_amdgcn_global_load_lds((const unsigned*)((const char*)(gbase) + (voff)[_i]), (PG8_LAS unsigned*)(lds + (bufoff) + ldsw + _i * 8192), 16, 0, 0); } while (0)
#define PG8_LDA(dst, b, h) do { _Pragma("unroll") for (int m = 0; m < 4; ++m) _Pragma("unroll") for (int k = 0; k < 2; ++k) dst[m][k] = *(const PG8_LAS bf16x8*)(lds + PG8_SA(b, h) + aoff + m * 2048 + k * 1024); } while (0)
#define PG8_LDB(dst, b, h) do { _Pragma("unroll") for (int n = 0; n < 2; ++n) _Pragma("unroll") for (int k = 0; k < 2; ++k) dst[n][k] = *(const PG8_LAS bf16x8*)(lds + PG8_SB(b, h) + boff + n * 2048 + k * 1024); } while (0)
#define PG8_MMA(ai, bj, At, Bt) do { __builtin_amdgcn_s_setprio(1); _Pragma("unroll") for (int m = 0; m < 4; ++m) _Pragma("unroll") for (int n = 0; n < 2; ++n) _Pragma("unroll") for (int k = 0; k < 2; ++k) \
        acc[ai][bj][m][n] = __builtin_amdgcn_mfma_f32_16x16x32_bf16(Bt[n][k], At[m][k], acc[ai][bj][m][n], 0, 0, 0); __builtin_amdgcn_s_setprio(0); } while (0)
#define PG8_WAIT_V(n) asm volatile("s_waitcnt vmcnt(" #n ")" ::: "memory")
#define PG8_WAIT_L(n) asm volatile("s_waitcnt lgkmcnt(" #n ")" ::: "memory")
#define PG8_BAR __builtin_amdgcn_s_barrier()
#define PG8_SCHED __builtin_amdgcn_sched_barrier(0)
    Unit cur, nxt; int ui = 0;
    if (!S.next(0, cur)) return;
    f32x4 acc[2][2][4][2];
#pragma unroll
    for (int a = 0; a < 2; ++a)
#pragma unroll
        for (int b = 0; b < 2; ++b)
#pragma unroll
            for (int m = 0; m < 4; ++m)
#pragma unroll
                for (int n = 0; n < 2; ++n) acc[a][b][m][n] = (f32x4){0.f, 0.f, 0.f, 0.f};
    bf16x8 At[4][2], B0[2][2], B1[2][2];
    const char* cA = (const char*)a_base(g, cur) + (size_t)cur.pm * tstepA; const char* cB = (const char*)g.Bt + (size_t)cur.pn * tstepB;
    PG8_STAGE(PG8_SB(0, 0), cB + PG8_KO(0), voffB); PG8_STAGE(PG8_SB(0, 1), cB + hstepB + PG8_KO(0), voffB); PG8_STAGE(PG8_SA(0, 0), cA + PG8_KO(0), voffA); PG8_STAGE(PG8_SA(0, 1), cA + hstepA + PG8_KO(0), voffA);
    if (wr == 1) PG8_BAR;
    PG8_WAIT_V(2); PG8_BAR;
    PG8_STAGE(PG8_SB(1, 0), cB + PG8_KO(1), voffB); PG8_STAGE(PG8_SA(1, 0), cA + PG8_KO(1), voffA); PG8_STAGE(PG8_SB(1, 1), cB + hstepB + PG8_KO(1), voffB);
    PG8_WAIT_V(6); PG8_BAR;
    for (;;) {
        const bool has_next = S.next(ui + 1, nxt);
        const char* nA = has_next ? (const char*)a_base(g, nxt) + (size_t)nxt.pm * tstepA : cA; const char* nB = has_next ? (const char*)g.Bt + (size_t)nxt.pn * tstepB : cB;
        for (int t = 0; t < nt; t += 2) {
            const bool last = (t == nt - 2);
            const char* a1 = cA + PG8_KO(t + 1);
            const size_t o2 = last ? PG8_KO(0) : PG8_KO(t + 2), o3 = last ? PG8_KO(1) : PG8_KO(t + 3);
            const char* a2 = (last ? nA : cA) + o2; const char* b2 = (last ? nB : cB) + o2;
            const char* a3 = (last ? nA : cA) + o3; const char* b3 = (last ? nB : cB) + o3;
            PG8_LDB(B0, 0, 0); PG8_LDB(B1, 0, 1); PG8_SCHED; PG8_LDA(At, 0, 0); PG8_STAGE(PG8_SA(1, 1), a1 + hstepA, voffA);
            PG8_WAIT_V(8); PG8_WAIT_L(0); PG8_BAR; PG8_MMA(0, 0, At, B0); PG8_MMA(0, 1, At, B1); PG8_BAR; PG8_SCHED;
            PG8_LDA(At, 0, 1); PG8_STAGE(PG8_SB(0, 0), b2, voffB); PG8_STAGE(PG8_SB(0, 1), b2 + hstepB, voffB); PG8_STAGE(PG8_SA(0, 0), a2, voffA);
            PG8_WAIT_V(8); PG8_WAIT_L(0); PG8_BAR; PG8_MMA(1, 0, At, B0); PG8_MMA(1, 1, At, B1); PG8_BAR; PG8_SCHED;
            PG8_LDB(B0, 1, 0); PG8_LDB(B1, 1, 1); PG8_SCHED; PG8_LDA(At, 1, 0); PG8_STAGE(PG8_SA(0, 1), a2 + hstepA, voffA);
            PG8_WAIT_V(8); PG8_WAIT_L(0); PG8_BAR; PG8_MMA(0, 0, At, B0); PG8_MMA(0, 1, At, B1); PG8_BAR; PG8_SCHED;
            PG8_LDA(At, 1, 1); PG8_STAGE(PG8_SB(1, 0), b3, voffB); PG8_STAGE(PG8_SB(1, 1), b3 + hstepB, voffB); PG8_STAGE(PG8_SA(1, 0), a3, voffA);
            PG8_WAIT_V(8); PG8_WAIT_L(0); PG8_BAR; PG8_MMA(1, 0, At, B0); PG8_MMA(1, 1, At, B1); PG8_BAR; PG8_SCHED;
        }
        if constexpr (ALIGN_EPI) { if (wr == 0) PG8_BAR; }
        if constexpr (PRE) E.before(cur, tid);
        { int l2 = lane; asm volatile("" : "+v"(l2)); E(acc, cur, wr, wc, l2 & 15, l2 >> 4); }
        if constexpr (PUB) { if (E.wants_publish(cur)) {
            PG8_WAIT_V(0); PG8_BAR; PG8_BAR; if (wid == 0 && lane == 0) E.publish(cur); } }
        if (!has_next) break;
#pragma unroll
        for (int a = 0; a < 2; ++a)
#pragma unroll
            for (int b = 0; b < 2; ++b)
#pragma unroll
                for (int m = 0; m < 4; ++m)
#pragma unroll
                    for (int n = 0; n < 2; ++n) acc[a][b][m][n] = (f32x4){0.f, 0.f, 0.f, 0.f};
        cur = nxt; cA = nA; cB = nB; ++ui;
        if constexpr (ALIGN_EPI) { if (wr == 1) PG8_BAR; }
    }
    PG8_WAIT_V(0);
    if constexpr (!ALIGN_EPI) { if (wr == 0) PG8_BAR; }
    PG8_BAR;
#undef PG8_KO
#undef PG8_SA
#undef PG8_SB
#undef PG8_STAGE
#undef PG8_LDA
#undef PG8_LDB
#undef PG8_MMA
#undef PG8_WAIT_V
#undef PG8_WAIT_L
#undef PG8_BAR
#undef PG8_SCHED
}
}

namespace sba {
using bf16 = __hip_bfloat16;
typedef short bf16x8 __attribute__((ext_vector_type(8)));
typedef short s16x4 __attribute__((ext_vector_type(4)));
typedef float f32x16 __attribute__((ext_vector_type(16)));
typedef float f32x4 __attribute__((ext_vector_type(4)));
typedef unsigned u32x4 __attribute__((ext_vector_type(4)));
constexpr int NW = 8, QBLK = 32, KVBLK = 64, QB = NW * QBLK, D = 128;
constexpr int PIN = 6144, POUT = 2048;
constexpr int SHM_V = KVBLK * D * 2, SHM_K = KVBLK * D * 2;
constexpr int SHM_Q = QBLK * D * 2;
constexpr int LDS_BYTES = 2 * SHM_V + 2 * SHM_K + NW * SHM_Q;

#define KSWZ(row, colB) ((row) * 256 + ((colB) ^ (((row) & 7) << 4)))
#define SBAR() __builtin_amdgcn_sched_barrier(0)
__device__ __forceinline__ int v_st(int k, int c) { const int kk = (k & ~0xC) | ((k & 4) << 1) | ((k & 8) >> 1); return ((kk >> 3) * 4 + (c >> 5)) * 512 + ((kk & 7) * 32 + (c & 31)) * 2; }
__device__ __forceinline__ int v_rd_base(int lane) { return ((lane & 3) << 3) | (((lane >> 2) & 3) << 6) | (((lane >> 4) & 1) << 5) | (((lane >> 5) & 1) << 8); }
constexpr int v_rd_off(int d0, int ks, int half) { return d0 * 512 + ks * 4096 + half * 2048; }
__device__ __forceinline__ int crow(int r, int hi) { return (r & 3) + 8 * (r >> 2) + 4 * hi; }
typedef float f32x2_t __attribute__((ext_vector_type(2))); typedef __bf16 bf16x2_t __attribute__((ext_vector_type(2)));
__device__ __forceinline__ unsigned cvtpk(float lo, float hi) { f32x2_t v = {lo, hi}; bf16x2_t b = __builtin_convertvector(v, bf16x2_t); return __builtin_bit_cast(unsigned, b); }
__device__ __forceinline__ bf16x8 load8(const bf16* p) { return *reinterpret_cast<const bf16x8*>(p); }

__device__ __forceinline__ void mask_tile(f32x16& p0, f32x16& p1, int dq) {
    const float NEG = -__builtin_inff();
#pragma unroll
    for (int r = 0; r < 16; ++r) {
        const int c = (r & 3) + 8 * (r >> 2);
        if (dq - c < 0) p0[r] = NEG;
        if (dq - c - 32 < 0) p1[r] = NEG;
    }
}
__device__ __forceinline__ void partA_half(f32x16& p, float& C, int hi) {
    f32x16 s;
#pragma unroll
    for (int r = 0; r < 16; ++r) {
        const float E = __builtin_amdgcn_exp2f(__builtin_amdgcn_fmed3f(p[r], -1.0e30f, 60.f));
        s[r] = __builtin_amdgcn_rcpf(1.0f + E);
        p[r] = E * s[r];
    }
    float U[4], X[4];
#pragma unroll
    for (int g = 0; g < 4; ++g) { const float T = (s[4 * g] * s[4 * g + 1]) * (s[4 * g + 2] * s[4 * g + 3]);
        auto rr = __builtin_amdgcn_permlane32_swap(__float_as_uint(T), __float_as_uint(T), false, false);
        const float tl = __uint_as_float(rr[0]), th = __uint_as_float(rr[1]); U[g] = tl * th; X[g] = th; }
#pragma unroll
    for (int g = 3; g >= 0; --g) {
        float run = hi == 0 ? C * X[g] : C;
#pragma unroll
        for (int i = 3; i >= 0; --i) { const float a = p[4 * g + i] * run; run *= s[4 * g + i]; p[4 * g + i] = a; }
        C *= U[g];
    }
}
__device__ __forceinline__ void partA(f32x16& p0, f32x16& p1, float& Crun, int hi) { partA_half(p1, Crun, hi); partA_half(p0, Crun, hi); }
__device__ __forceinline__ void partB(f32x16& p0, f32x16& p1, bf16x8& pa0, bf16x8& pa1, bf16x8& pa2, bf16x8& pa3) {
#define PK4(P, B_, OUT) do { unsigned a0 = cvtpk(P[B_+0], P[B_+1]), a1 = cvtpk(P[B_+2], P[B_+3]);                          \
        unsigned b0 = cvtpk(P[B_+4], P[B_+5]), b1 = cvtpk(P[B_+6], P[B_+7]);                                             \
        auto r0 = __builtin_amdgcn_permlane32_swap(a0, b0, false, false); auto r1 = __builtin_amdgcn_permlane32_swap(a1, b1, false, false); \
        u32x4 w = {r0[0], r1[0], r0[1], r1[1]}; OUT = *reinterpret_cast<bf16x8*>(&w); } while (0)
    PK4(p0, 0, pa0); PK4(p0, 8, pa1); PK4(p1, 0, pa2); PK4(p1, 8, pa3);
#undef PK4
}
template <int KB>
__device__ __forceinline__ void qkt(f32x16& p0, f32x16& p1, const char* K_lds, int r32, int hi, const char* Qw_lds, bool act) {
    if (!act) { const float NEG = -__builtin_inff();
#pragma unroll
        for (int r = 0; r < 16; ++r) { p0[r] = NEG; p1[r] = NEG; } return; }
    p0 = f32x16{}; p1 = f32x16{};
    const char* kb[4];
#pragma unroll
    for (int dd = 0; dd < 4; ++dd) kb[dd] = K_lds + KB * SHM_K + KSWZ(r32, (dd * 16 + hi * 8) * 2);
#pragma unroll
    for (int d0 = 0; d0 < 8; ++d0) { const char* a = kb[d0 & 3] + (d0 >> 2) * 128;
        bf16x8 b0 = *reinterpret_cast<const bf16x8*>(a);
        bf16x8 b1 = *reinterpret_cast<const bf16x8*>(a + 32 * 256);
        bf16x8 q = *reinterpret_cast<const bf16x8*>(Qw_lds + (kb[d0 & 3] - (K_lds + KB * SHM_K)) + (d0 >> 2) * 128);
        p0 = __builtin_amdgcn_mfma_f32_32x32x16_bf16(b0, q, p0, 0, 0, 0);
        p1 = __builtin_amdgcn_mfma_f32_32x32x16_bf16(b1, q, p1, 0, 0, 0); }
}
template <int VB>
__device__ __forceinline__ void pv_tile(f32x16* o, int vb0, bf16x8 pa0, bf16x8 pa1, bf16x8 pa2, bf16x8 pa3, bool act) {
    if (!act) return;
#define TRRD(dst, off) asm volatile("ds_read_b64_tr_b16 %0, %1 offset:%2" : "=&v"(dst) : "v"(vb0), "i"(off) : "memory")
#define PV_D0(d0) do { s16x4 l0, l1, l2, l3, h0, h1, h2, h3; constexpr int b_ = VB * SHM_V + v_rd_off(d0, 0, 0); \
        TRRD(l0, b_); TRRD(h0, b_ + 2048); TRRD(l1, b_ + 4096); TRRD(h1, b_ + 6144); TRRD(l2, b_ + 8192); TRRD(h2, b_ + 10240); TRRD(l3, b_ + 12288); TRRD(h3, b_ + 14336); \
        asm volatile("s_waitcnt lgkmcnt(0)" ::: "memory"); SBAR();   \
        o[d0] = __builtin_amdgcn_mfma_f32_32x32x16_bf16(pa0, (bf16x8){l0[0], l0[1], l0[2], l0[3], h0[0], h0[1], h0[2], h0[3]}, o[d0], 0, 0, 0);   \
        o[d0] = __builtin_amdgcn_mfma_f32_32x32x16_bf16(pa1, (bf16x8){l1[0], l1[1], l1[2], l1[3], h1[0], h1[1], h1[2], h1[3]}, o[d0], 0, 0, 0);   \
        o[d0] = __builtin_amdgcn_mfma_f32_32x32x16_bf16(pa2, (bf16x8){l2[0], l2[1], l2[2], l2[3], h2[0], h2[1], h2[2], h2[3]}, o[d0], 0, 0, 0);   \
        o[d0] = __builtin_amdgcn_mfma_f32_32x32x16_bf16(pa3, (bf16x8){l3[0], l3[1], l3[2], l3[3], h3[0], h3[1], h3[2], h3[3]}, o[d0], 0, 0, 0); } while (0)
    PV_D0(0); PV_D0(1); PV_D0(2); PV_D0(3);
#undef PV_D0
#undef TRRD
}

struct BlockRef { const bf16* Q; const bf16* K; const bf16* V; const bf16* G; bf16* O; int P0; };
#define ROW(p, k0, rr) ((p) + (size_t)((k0) + (rr)) * PIN + sc)
#define VMW() asm volatile("s_waitcnt vmcnt(0)" ::: "memory")
#define SLOAD_H(Kp, Vp, k0) do { st_v0 = load8(ROW(Vp, k0, sr)); st_v1 = load8(ROW(Vp, k0, 32 + sr));              \
                         st_k0 = load8(ROW(Kp, k0, sr)); st_k1 = load8(ROW(Kp, k0, 32 + sr)); } while (0)
#define SWRITE_H(bf) do { *(bf16x8*)(V_lds + (bf) * SHM_V + vst0) = st_v0; *(bf16x8*)(V_lds + (bf) * SHM_V + vst1) = st_v1; \
                          *(bf16x8*)(K_lds + (bf) * SHM_K + kws) = st_k0; *(bf16x8*)(K_lds + (bf) * SHM_K + kws + 32 * 256) = st_k1; } while (0)
__device__ __forceinline__ void q_to_lds(const bf16* Q, char* Qw_lds, int wid, int r32, int hi) {
    bf16x8 qr[8];
#pragma unroll
    for (int d0 = 0; d0 < 8; ++d0) qr[d0] = load8(Q + (size_t)(wid * QBLK + r32) * PIN + d0 * 16 + hi * 8);
#pragma unroll
    for (int d0 = 0; d0 < 8; ++d0) *(bf16x8*)(Qw_lds + KSWZ(r32, (d0 * 16 + hi * 8) * 2)) = qr[d0];
}
__device__ __forceinline__ void sb_block(const BlockRef& cur, char* lds) {
    int tid = threadIdx.x; asm volatile("" : "+v"(tid));
    const int wid = __builtin_amdgcn_readfirstlane(tid >> 6), lane = tid & 63, r32 = lane & 31, hi = lane >> 5;
    const int NT = (cur.P0 + QB) / KVBLK;
    const int qlo = cur.P0 + wid * QBLK, qm = qlo + r32 - 1 - 4 * hi;
    char* V_lds = lds; char* K_lds = lds + 2 * SHM_V; char* Qw_lds = lds + 2 * SHM_V + 2 * SHM_K + wid * SHM_Q;
    float Rrun = 1.f; f32x16 o[4] = {};
    const int sr = tid >> 4, sc = (tid & 15) * 8, vst0 = v_st(sr, sc), vst1 = v_st(32 + sr, sc), kws = KSWZ(sr, sc * 2);
    const int vb0 = (int)(uintptr_t)V_lds + v_rd_base(lane);
    const bf16* Kh = cur.K; const bf16* Vh = cur.V;
    bf16x8 st_v0, st_v1, st_k0, st_k1;
#define KBASE(t) ((NT - 1 - (t)) * KVBLK)
#define ACT(t) (KBASE(t) <= qlo + QBLK - 2)
#define MASKT(P0_, P1_, t) do { const int kb_ = KBASE(t); if (ACT(t) && (kb_ + KVBLK - 1 > qlo - 1)) mask_tile(P0_, P1_, qm - kb_); } while (0)
    q_to_lds(cur.Q, Qw_lds, wid, r32, hi);
    SLOAD_H(Kh, Vh, KBASE(0)); VMW(); SWRITE_H(0);
    __syncthreads();
    f32x16 p0, p1; bf16x8 pa0, pa1, pa2, pa3;
    constexpr float SKIP_THR = 1e-30f;
    volatile int* flags = (volatile int*)(lds + 2 * SHM_V + 2 * SHM_K + NW * SHM_Q);
    bool mydone = false, alldone = false;
#define STEP(t, BF) do {                                                                                   \
        if ((t) + 1 < NT) { SLOAD_H(Kh, Vh, KBASE((t) + 1)); }                                              \
        const bool act_ = ACT(t) && !mydone;                                                                 \
        SBAR(); qkt<BF>(p0, p1, K_lds, r32, hi, Qw_lds, act_);                                          \
        if (act_) { MASKT(p0, p1, (t)); partA(p0, p1, Rrun, hi); partB(p0, p1, pa0, pa1, pa2, pa3); } SBAR();               \
        pv_tile<BF>(o, vb0, pa0, pa1, pa2, pa3, act_);                                                     \
        mydone = mydone || __all(Rrun <= SKIP_THR);                                                           \
        if (lane == 0) flags[BF * 8 + wid] = mydone ? 1 : 0;                                                 \
        if ((t) + 1 < NT) { VMW(); SWRITE_H(1 - BF); }                                                       \
        __syncthreads();                                                                                     \
        { int f_ = 1; _Pragma("unroll") for (int w_ = 0; w_ < 8; ++w_) f_ &= flags[BF * 8 + w_]; alldone = f_ != 0; } } while (0)
    for (int t = 0; t < NT; t += 2) { STEP(t, 0); if (alldone) break; STEP(t + 1, 1); if (alldone) break; }
    {
        bf16* Ow = cur.O + (size_t)(wid * QBLK) * POUT; const bf16* Gw = cur.G + (size_t)(wid * QBLK) * PIN;
        float* st = (float*)Qw_lds;
        const int erow = lane >> 1, ehalf = lane & 1;
#pragma unroll
        for (int hp = 0; hp < 2; ++hp) {
            u32x4 gq[4];
#pragma unroll
            for (int i = 0; i < 4; ++i) gq[i] = *(const u32x4*)(Gw + (size_t)erow * PIN + hp * 64 + ehalf * 32 + i * 8);
            asm volatile("s_waitcnt lgkmcnt(0)" ::: "memory");
#pragma unroll
            for (int r = 0; r < 16; ++r) { const int orow = crow(r, hi);
#pragma unroll
                for (int dl = 0; dl < 2; ++dl) { const int col = dl * 32 + r32; st[orow * 64 + ((((col >> 2) ^ (orow & 15)) << 2) | (col & 3))] = o[2 * hp + dl][r]; } }
            asm volatile("s_waitcnt lgkmcnt(0)" ::: "memory");
#pragma unroll
            for (int i = 0; i < 4; ++i) {
                const int g0 = 8 * ehalf + 2 * i;
                const f32x4 a = *(const f32x4*)(st + erow * 64 + ((g0 ^ (erow & 15)) << 2)), b = *(const f32x4*)(st + erow * 64 + (((g0 + 1) ^ (erow & 15)) << 2));
                const u32x4 g = gq[i];
                u32x4 w; w.x = cvtpk(a[0] * __uint_as_float(g.x << 16), a[1] * __uint_as_float(g.x & 0xffff0000u)); w.y = cvtpk(a[2] * __uint_as_float(g.y << 16), a[3] * __uint_as_float(g.y & 0xffff0000u));
                w.z = cvtpk(b[0] * __uint_as_float(g.z << 16), b[1] * __uint_as_float(g.z & 0xffff0000u)); w.w = cvtpk(b[2] * __uint_as_float(g.w << 16), b[3] * __uint_as_float(g.w & 0xffff0000u));
                *(u32x4*)(Ow + (size_t)erow * POUT + hp * 64 + ehalf * 32 + i * 8) = w; }
        }
        asm volatile("s_waitcnt lgkmcnt(0)" ::: "memory");
    }
#undef KBASE
#undef ACT
#undef MASKT
#undef STEP
}
#undef ROW
#undef VMW
#undef SLOAD_H
#undef SWRITE_H
#undef KSWZ
#undef SBAR
}

constexpr int NWAVES = 8;
constexpr int N_LAUNCHES = MK_N_LAUNCHES;
constexpr int N_PHASES = 12;
constexpr int BATCH = 4, SEQ = 4096, DM = 2048, M = BATCH * SEQ, MH = M / 2;
constexpr int EVEN_IN = 6144;
constexpr float LN_EPS = 1e-5f, GN_EPS = 64e-5f;
constexpr float ALPHA = 1.4142135623730951f;
constexpr int N2CAT = 4 * DM + 512;

constexpr size_t MiB = 1u << 20;
constexpr size_t WS_CTL = 0, CTL_ZERO_BYTES = 1 * MiB;
constexpr size_t WS_W2CAT = 1 * MiB, WS_WOT = 35 * MiB, WS_L2T = 43 * MiB, WS_STATS = 45 * MiB, WS_D = 46 * MiB;
constexpr size_t WS_WINT = WS_D, WS_WOUTT = WS_D + 24 * MiB, WS_WPOOLT = WS_D + 32 * MiB, WS_XB = WS_D + 33 * MiB, WS_MIX = WS_XB, WS_H = WS_D + 97 * MiB, WS_POOLED = WS_D + 289 * MiB;
constexpr size_t AST = 64 * MiB + 1 * MiB + 9472;
constexpr size_t WS_XMIX = WS_D, WS_K2 = WS_D, WS_V2 = WS_D + AST, WS_SG = WS_D + 2 * AST, WS_OG = WS_D + 3 * AST, WS_AA = WS_D + 4 * AST, WS_LOGW = WS_D + 5 * AST;
constexpr size_t WS_R = WS_D + 6 * AST, WS_TL = WS_D + 7 * AST, WS_END = WS_TL + 8 * MiB;
constexpr size_t WS_Y0 = WS_R;
constexpr size_t WS_GRING = WS_W2CAT;
constexpr size_t WS_Y1 = WS_LOGW;
static_assert(WS_POOLED + 32 * MiB <= WS_END && WS_END <= 512 * MiB, "d_ws map");
constexpr int CW_TMO = 0, CW_CODE = 1, CW_BAR = 4096, CW_ACNT = 8192, CW_GFL = 16384;

constexpr int RING_OFF = 0, RING_BYTES = 159744;
constexpr int LDSCTL_OFF = RING_BYTES, MISC_OFF = LDSCTL_OFF + 320;
constexpr int LDS_BYTES = 163840;

#define GAS __attribute__((address_space(1)))
#define LAS __attribute__((address_space(3)))
typedef unsigned short bf16;
typedef unsigned v4u __attribute__((ext_vector_type(4)));
typedef unsigned v2u __attribute__((ext_vector_type(2)));
typedef float f32x4 __attribute__((ext_vector_type(4)));
typedef float f32x2v __attribute__((ext_vector_type(2)));
typedef GAS unsigned gu32;
#define RLX_AGENT __ATOMIC_RELAXED, __HIP_MEMORY_SCOPE_AGENT
#define LDS_WAIT() asm volatile("s_waitcnt lgkmcnt(0)" ::: "memory")
#define VM_WAIT() asm volatile("s_waitcnt vmcnt(0)" ::: "memory")
__device__ __forceinline__ unsigned f2bf(float f) { unsigned u = __builtin_bit_cast(unsigned, f); return (u + 0x7fffu + ((u >> 16) & 1u)) >> 16; }
__device__ __forceinline__ unsigned pk2(float lo, float hi) { return pg8::cvt_pk_bf16(lo, hi); }
__device__ __forceinline__ float bflo(unsigned w) { return __uint_as_float(w << 16); }
__device__ __forceinline__ float bfhi(unsigned w) { return __uint_as_float(w & 0xffff0000u); }

#define XB_TMO      128
#define XB_XCNT(j)  (256  + 64 * (j))
#define XB_XSUB(j)  (1280 + 64 * (j))
#define XB_XGEN(j)  (2304 + 64 * (j))
#define XB_TOP      3328
#define XB_TOPGEN   3392
#define XCD_BAR_WORDS 3456
#define XB_SPIN_CAP (1u << 23)
__device__ __forceinline__ unsigned xb_ld(unsigned* p)              { return __hip_atomic_load(p, __ATOMIC_RELAXED, __HIP_MEMORY_SCOPE_AGENT); }
__device__ __forceinline__ unsigned xb_add(unsigned* p, unsigned v) { return __hip_atomic_fetch_add(p, v, __ATOMIC_RELAXED, __HIP_MEMORY_SCOPE_AGENT); }
__device__ __forceinline__ unsigned xb_xcc_id() { return (unsigned)__builtin_amdgcn_s_getreg((3 << 11) | 20) & 0xFu; }
#define XB_SPIN(cond, bar) do { unsigned _sp = 0; while (cond) { __builtin_amdgcn_s_sleep(1); \
    if ((++_sp & 255u) == 0u) { if (xb_ld(&(bar)[XB_TMO])) break; if (_sp > XB_SPIN_CAP) { atomicAdd(&(bar)[XB_TMO], 1u); break; } } } } while (0)
struct XcdBarrier { unsigned* bar; unsigned x; volatile LAS unsigned* st; };
__device__ __forceinline__ XcdBarrier xcd_barrier_post(unsigned* bar, volatile LAS unsigned* st) {
    XcdBarrier b; b.bar = bar; b.x = xb_xcc_id(); b.st = st;
    if (threadIdx.x == 0) (void)xb_add(&bar[XB_XCNT(b.x)], 1u);
    return b;
}
__device__ __forceinline__ void xcd_barrier_complete(unsigned* bar, unsigned x, unsigned& nloc, unsigned& nx) {
    const unsigned G = gridDim.x * gridDim.y * gridDim.z;
    unsigned sum, cnt, mine, sp = 0u;
    for (;;) {
        sum = 0u; cnt = 0u; mine = 0u;
#pragma unroll
        for (unsigned j = 0; j < 16; ++j) { const unsigned c = xb_ld(&bar[XB_XCNT(j)]); sum += c; cnt += (c > 0u) ? 1u : 0u; mine = (j == x) ? c : mine; }
        if (sum == G) break;
        __builtin_amdgcn_s_sleep(1);
        if ((++sp & 255u) == 0u) { if (xb_ld(&bar[XB_TMO])) break; if (sp > XB_SPIN_CAP) { atomicAdd(&bar[XB_TMO], 1u); break; } }
    }
    nloc = mine > 0u ? mine : 1u; nx = cnt > 0u ? cnt : 1u;
}
__device__ __attribute__((noinline)) void xcd_barrier(const XcdBarrier b) {
    asm volatile("s_waitcnt vmcnt(0)" ::: "memory");
    __syncthreads();
    if (threadIdx.x == 0) {
        unsigned* bar = b.bar;
        __builtin_amdgcn_s_waitcnt(0);
        unsigned nloc = b.st[0], nx = b.st[1];
        if (nloc == 0u) { xcd_barrier_complete(bar, b.x, nloc, nx); b.st[0] = nloc; b.st[1] = nx; }
        const unsigned old = xb_add(&bar[XB_XSUB(b.x)], 1u);
        const unsigned gen = old / nloc;
        if (old + 1u == (gen + 1u) * nloc) {
            __builtin_amdgcn_fence(__ATOMIC_RELEASE, "agent");
            asm volatile("s_waitcnt vmcnt(0)" ::: "memory");
            const unsigned og = xb_add(&bar[XB_TOP], 1u);
            const unsigned tg = og / nx;
            if (og + 1u == (tg + 1u) * nx) xb_add(&bar[XB_TOPGEN], 1u);
            else XB_SPIN(xb_ld(&bar[XB_TOPGEN]) == tg, bar);
            __builtin_amdgcn_fence(__ATOMIC_ACQUIRE, "agent");
            xb_add(&bar[XB_XGEN(b.x)], 1u);
            asm volatile("s_waitcnt vmcnt(0)" ::: "memory");
        } else {
            XB_SPIN(xb_ld(&bar[XB_XGEN(b.x)]) == gen, bar);
            __builtin_amdgcn_fence(__ATOMIC_ACQUIRE, "agent");
            asm volatile("s_waitcnt vmcnt(0)" ::: "memory");
        }
    }
    __syncthreads();
}

struct Frame {
    LAS unsigned char* lds;
    volatile LAS unsigned* MISC;
    gu32* ctl;
    int vcu, G;
};
#define PHASE_TID() int tid_ = threadIdx.x; asm volatile("" : "+v"(tid_)); const int tid = tid_, lane = tid & 63, wave = __builtin_amdgcn_readfirstlane(tid >> 6); (void)lane; (void)wave
__device__ __forceinline__ float wave_sum(float v) {
#pragma unroll
    for (int o = 1; o < 64; o <<= 1) v += __shfl_xor(v, o);
    return v;
}
__device__ __forceinline__ void p0_transpose_item(const float* W, int N, bf16* WT, int ldwt, int row_off, LAS float* scr, int item, int lane) {
    const int nblk = N / 32, kb = item / nblk, nb = item % nblk, k0 = 64 * kb, n0 = 32 * nb;
    { const int kk8 = lane >> 3, c4 = lane & 7; f32x4 t[8];
#pragma unroll
      for (int i = 0; i < 8; ++i) t[i] = __builtin_nontemporal_load((const GAS f32x4*)(W + (size_t)(k0 + 8 * i + kk8) * N + n0 + 4 * c4));
#pragma unroll
      for (int i = 0; i < 8; ++i) { LAS float* d = scr + (8 * i + kk8) * 33 + 4 * c4; d[0] = t[i].x; d[1] = t[i].y; d[2] = t[i].z; d[3] = t[i].w; } }
    LDS_WAIT(); asm volatile("" ::: "memory");
    const int c = lane & 7;
#pragma unroll
    for (int j = 0; j < 4; ++j) { const int n = (lane >> 3) + 8 * j; const LAS float* s = scr + (8 * c) * 33 + n;
        v4u o; o.x = pk2(s[0 * 33], s[1 * 33]); o.y = pk2(s[2 * 33], s[3 * 33]); o.z = pk2(s[4 * 33], s[5 * 33]); o.w = pk2(s[6 * 33], s[7 * 33]);
        *(GAS v4u*)(WT + (size_t)(row_off + n0 + n) * ldwt + k0 + 8 * c) = o; }
    LDS_WAIT(); asm volatile("" ::: "memory");
}

struct Args { const float* in[24]; float* out; unsigned char* ws; int ph_lo, ph_hi, li, pad; };

__device__ __forceinline__ void p0_prologue(Frame& F, const Args& a) {
    PHASE_TID();
    unsigned char* ws = a.ws;
    LAS float* scr = (LAS float*)(F.lds + RING_OFF + wave * 16384);
    const int gw = F.vcu * NWAVES + wave, NGW = F.G * NWAVES;
    bf16* WINT = (bf16*)(ws + WS_WINT); bf16* WPOOLT = (bf16*)(ws + WS_WPOOLT);
    constexpr int I_IN = (DM / 64) * (EVEN_IN / 32), I_POOL = (256 / 64) * (256 / 32);
    constexpr int NITEMS = I_IN + 4 * I_POOL;
    for (int it = gw; it < NITEMS; it += NGW) {
        int r = it;
        if (r < I_IN) { p0_transpose_item(a.in[1], EVEN_IN, WINT, DM, 0, scr, r, lane); continue; } r -= I_IN;
        { const int g = r / I_POOL; p0_transpose_item(a.in[2] + (size_t)g * 65536, 256, WPOOLT + (size_t)g * 65536, 256, 0, scr, r % I_POOL, lane); }
    }
    const int gt = F.vcu * (NWAVES * 64) + tid, NGT = F.G * NWAVES * 64;
    { const float* x = a.in[0]; bf16* XB = (bf16*)(ws + WS_XB);
      const int gwv = F.vcu * NWAVES + wave, NGWV = F.G * NWAVES;
      for (int wb = gwv; wb < M * DM / 2048; wb += NGWV) {
          const size_t e0 = (size_t)wb * 2048 + lane * 4; f32x4 u[8];
#pragma unroll
          for (int q = 0; q < 8; ++q) u[q] = __builtin_nontemporal_load((const GAS f32x4*)(x + e0 + q * 256));
#pragma unroll
          for (int q = 0; q < 8; ++q) *(GAS v2u*)(XB + e0 + q * 256) = (v2u){pk2(u[q].x, u[q].y), pk2(u[q].z, u[q].w)}; } }
}
__device__ __forceinline__ void late_weights(Frame& F, const Args& a) {
    PHASE_TID();
    unsigned char* ws = a.ws;
    LAS float* scr = (LAS float*)(F.lds + RING_OFF + wave * 16384);
    const int gw = F.vcu * NWAVES + wave, NGW = F.G * NWAVES;
    bf16* WOUTT = (bf16*)(ws + WS_WOUTT); bf16* W2CAT = (bf16*)(ws + WS_W2CAT);
    constexpr int I_SQ = (DM / 64) * (DM / 32), I_LORA = (DM / 64) * (96 / 32);
    constexpr int NITEMS = 5 * I_SQ + 2 * I_LORA;
    for (int it = gw; it < NITEMS; it += NGW) {
        int r = it;
        if (r < I_SQ) { p0_transpose_item(a.in[4], DM, WOUTT, DM, 0, scr, r, lane); continue; } r -= I_SQ;
        if (r < 4 * I_SQ) { const int w = r / I_SQ; p0_transpose_item(a.in[6 + w], DM, W2CAT, DM, w * DM, scr, r % I_SQ, lane); continue; } r -= 4 * I_SQ;
        if (r < I_LORA) { p0_transpose_item(a.in[11], 96, W2CAT, DM, 4 * DM, scr, r, lane); continue; } r -= I_LORA;
        p0_transpose_item(a.in[14], 96, W2CAT, DM, 4 * DM + 256, scr, r, lane);
    }
    const int gt = F.vcu * (NWAVES * 64) + tid, NGT = F.G * NWAVES * 64;
    for (int i = gt; i < 2 * 160 * (DM / 8); i += NGT) { const int blk = i / (160 * (DM / 8)), rr = (i / (DM / 8)) % 160, c8 = i % (DM / 8);
        *(GAS v4u*)(W2CAT + (size_t)(4 * DM + blk * 256 + 96 + rr) * DM + c8 * 8) = (v4u){0u, 0u, 0u, 0u}; }
    { bf16* L2T = (bf16*)(ws + WS_L2T); const float* w2 = a.in[12]; const float* a2 = a.in[15];
      for (int i = gt; i < 4096 * 16; i += NGT) { const int n = i % 4096, c8 = i / 4096; const int k0 = c8 * 8; float v[8];
#pragma unroll
          for (int e = 0; e < 8; ++e) { const int k = k0 + e; float x = 0.f;
              if (k < 96) x = (n < 2048) ? w2[(size_t)k * DM + n] : a2[(size_t)k * DM + (n - 2048)];
              v[e] = x; }
          *(GAS v4u*)(L2T + (size_t)n * 128 + k0) = (v4u){pk2(v[0], v[1]), pk2(v[2], v[3]), pk2(v[4], v[5]), pk2(v[6], v[7])}; } }
}

template <int WIN>
__device__ __forceinline__ void pool_tile_w(const bf16* Hb, bf16* POOLED, int pm, int g, int tid) {
    const int c4 = (tid & 63) * 4, rw = tid >> 6;
    const int row0 = pm * 256 + rw * 32, t0 = row0 & (SEQ - 1);
    const bf16* up = Hb + (size_t)row0 * 6144 + 4096 + g * 256 + c4;
    v2u ring[WIN]; float s0 = 0.f, s1 = 0.f, s2 = 0.f, s3 = 0.f;
#pragma unroll
    for (int i = 1; i < WIN; ++i) {
        v2u w = {0u, 0u};
        if (t0 - i >= 0) w = *(const GAS v2u*)(up - (size_t)i * 6144);
        ring[(WIN - i) % WIN] = w; s0 += bflo(w.x); s1 += bfhi(w.x); s2 += bflo(w.y); s3 += bfhi(w.y); }
    v2u cur[32];
#pragma unroll
    for (int rr = 0; rr < 32; ++rr) cur[rr] = *(const GAS v2u*)(up + (size_t)rr * 6144);
#pragma unroll
    for (int rr = 0; rr < 32; ++rr) {
        const v2u w = cur[rr]; const float u0 = bflo(w.x), u1 = bfhi(w.x), u2 = bflo(w.y), u3 = bfhi(w.y);
        s0 += u0; s1 += u1; s2 += u2; s3 += u3;
        const int t = t0 + rr; const float inv = (t + 1 >= WIN) ? (1.0f / (float)WIN) : __builtin_amdgcn_rcpf((float)(t + 1));
        *(GAS v2u*)(POOLED + (size_t)(row0 + rr) * 1024 + g * 256 + c4) = (v2u){pk2(s0 * inv - u0, s1 * inv - u1), pk2(s2 * inv - u2, s3 * inv - u3)};
        const v2u old = ring[(rr + 1) % WIN];
        s0 -= bflo(old.x); s1 -= bfhi(old.x); s2 -= bflo(old.y); s3 -= bfhi(old.y);
        ring[rr % WIN] = w;
    }
}
__device__ __forceinline__ void pool_tile(Frame& F, const bf16* Hb, bf16* POOLED, int pm, int g) {
    PHASE_TID();
    if (g == 0) pool_tile_w<2>(Hb, POOLED, pm, g, tid); else if (g == 1) pool_tile_w<4>(Hb, POOLED, pm, g, tid);
    else if (g == 2) pool_tile_w<8>(Hb, POOLED, pm, g, tid); else pool_tile_w<16>(Hb, POOLED, pm, g, tid);
}

struct Row32 { f32x4 a[4], b[4]; };
template <bool XBF = false>
__device__ __forceinline__ void ln_row(const float* xr, const bf16* yr, const Row32& G, const Row32& B, int lane, Row32& v) {
    float s = 0.f;
#pragma unroll
    for (int j = 0; j < 4; ++j) { const int c = 8 * lane + 512 * j; f32x4 x0, x1;
        if (XBF) { const v4u xw = *(const GAS v4u*)((const bf16*)xr + c); x0 = (f32x4){bflo(xw.x), bfhi(xw.x), bflo(xw.y), bfhi(xw.y)}; x1 = (f32x4){bflo(xw.z), bfhi(xw.z), bflo(xw.w), bfhi(xw.w)}; }
        else { x0 = *(const GAS f32x4*)(xr + c); x1 = *(const GAS f32x4*)(xr + c + 4); }
        const v4u y = *(const GAS v4u*)(yr + c);
        v.a[j] = x0 * ALPHA + (f32x4){bflo(y.x), bfhi(y.x), bflo(y.y), bfhi(y.y)}; v.b[j] = x1 * ALPHA + (f32x4){bflo(y.z), bfhi(y.z), bflo(y.w), bfhi(y.w)};
        s += ((v.a[j].x + v.a[j].y) + (v.a[j].z + v.a[j].w)) + ((v.b[j].x + v.b[j].y) + (v.b[j].z + v.b[j].w)); }
    const float mean = wave_sum(s) * (1.f / DM); float s2 = 0.f;
#pragma unroll
    for (int j = 0; j < 4; ++j) { v.a[j] = v.a[j] - mean; v.b[j] = v.b[j] - mean;
        s2 += ((v.a[j].x * v.a[j].x + v.a[j].y * v.a[j].y) + (v.a[j].z * v.a[j].z + v.a[j].w * v.a[j].w)) + ((v.b[j].x * v.b[j].x + v.b[j].y * v.b[j].y) + (v.b[j].z * v.b[j].z + v.b[j].w * v.b[j].w)); }
    const float rstd = __builtin_amdgcn_rsqf(wave_sum(s2) * (1.f / DM) + LN_EPS);
#pragma unroll
    for (int j = 0; j < 4; ++j) { v.a[j] = v.a[j] * rstd * G.a[j] + B.a[j]; v.b[j] = v.b[j] * rstd * G.b[j] + B.b[j]; }
}
template <bool XBF = false>
__device__ __forceinline__ void ln_row_ld(const float* xr, const bf16* yr, const float* lg, const float* lb, int lane, Row32& v) {
    asm volatile("" : "+s"(lg), "+s"(lb));
    Row32 G, B;
#pragma unroll
    for (int j = 0; j < 4; ++j) { const int c = 8 * lane + 512 * j; G.a[j] = *(const f32x4*)(lg + c); G.b[j] = *(const f32x4*)(lg + c + 4); B.a[j] = *(const f32x4*)(lb + c); B.b[j] = *(const f32x4*)(lb + c + 4); }
    ln_row<XBF>(xr, yr, G, B, lane, v);
}
__device__ __forceinline__ int cv_off(int c) { return ((((c >> 9) * 2 + ((c >> 2) & 1)) * 64 + ((c >> 3) & 63)) << 2) + (c & 3); }
__device__ __forceinline__ void cv_fill(LAS float* dst, const float* src, int tid) {
    for (int c4 = tid * 4; c4 < DM; c4 += NWAVES * 64 * 4) *(LAS f32x4*)(dst + cv_off(c4)) = *(const GAS f32x4*)(src + c4);
}
__device__ __forceinline__ void cv_row(const LAS float* v, int lane, Row32& r) {
#pragma unroll
    for (int j = 0; j < 4; ++j) { r.a[j] = *(const LAS f32x4*)(v + ((2 * j) * 64 + lane) * 4); r.b[j] = *(const LAS f32x4*)(v + ((2 * j + 1) * 64 + lane) * 4); }
}
template <bool XBF = false>
__device__ __forceinline__ void ln_row_cv(const float* xr, const bf16* yr, const LAS float* cg, const LAS float* cb, int lane, Row32& v) {
    Row32 G, B; cv_row(cg, lane, G); cv_row(cb, lane, B);
    ln_row<XBF>(xr, yr, G, B, lane, v);
}
__device__ __forceinline__ void load_row32(const float* p, int lane, Row32& r) {
#pragma unroll
    for (int j = 0; j < 4; ++j) { const int c = 8 * lane + 512 * j; r.a[j] = *(const f32x4*)(p + c); r.b[j] = *(const f32x4*)(p + c + 4); }
}
__device__ __forceinline__ void ln_mix_phase(Frame& F, const Args& a) {
    const float* X = a.in[0]; const bf16* Y0 = (const bf16*)(a.ws + WS_Y0); float* X1 = a.out; bf16* XMIX = (bf16*)(a.ws + WS_XMIX);
    const float* lg = a.in[22]; const float* lb = a.in[23]; const float* mu = a.in[5];
    PHASE_TID();
    LAS float* cv = (LAS float*)(F.lds + RING_OFF);
    cv_fill(cv, lg, tid); cv_fill(cv + DM, lb, tid);
#pragma unroll
    for (int q = 0; q < 6; ++q) { const int mrow = (q == 0) ? 0 : (q == 1) ? 2 : (q == 2) ? 3 : (q == 3) ? 5 : (q == 4) ? 1 : 4; cv_fill(cv + (2 + q) * DM, mu + (size_t)mrow * DM, tid); }
    LDS_WAIT(); __syncthreads();
    const int gw = F.vcu * NWAVES + wave, NGW = F.G * NWAVES;
    constexpr int STRIP = 4;
    for (int sidx = gw; sidx < M / STRIP; sidx += NGW) {
        const int r0 = sidx * STRIP;
        Row32 prev;
        if ((r0 & (SEQ - 1)) == 0) {
#pragma unroll
            for (int j = 0; j < 4; ++j) { prev.a[j] = (f32x4){0.f, 0.f, 0.f, 0.f}; prev.b[j] = (f32x4){0.f, 0.f, 0.f, 0.f}; }
        } else ln_row_cv(X + (size_t)(r0 - 1) * DM, Y0 + (size_t)(r0 - 1) * DM, cv, cv + DM, lane, prev);
        for (int rr = 0; rr < STRIP; ++rr) {
            const int row = r0 + rr; Row32 v;
            ln_row_cv(X + (size_t)row * DM, Y0 + (size_t)row * DM, cv, cv + DM, lane, v);
            const size_t orow = (size_t)row * DM;
#pragma unroll
            for (int j = 0; j < 4; ++j) { const int c = 8 * lane + 512 * j;
                *(GAS v4u*)((bf16*)(X1 + (size_t)row * DM) + ((row >> 3) & 1) * DM + c) = (v4u){pk2(v.a[j].x, v.a[j].y), pk2(v.a[j].z, v.a[j].w), pk2(v.b[j].x, v.b[j].y), pk2(v.b[j].z, v.b[j].w)};
                const f32x4 xa = prev.a[j] - v.a[j], xb = prev.b[j] - v.b[j];
#pragma unroll
                for (int q = 0; q < 6; ++q) {
                    const f32x4 m0 = *(const LAS f32x4*)(cv + (2 + q) * DM + ((2 * j) * 64 + lane) * 4), m1 = *(const LAS f32x4*)(cv + (2 + q) * DM + ((2 * j + 1) * 64 + lane) * 4); const f32x4 o0 = v.a[j] + xa * m0, o1 = v.b[j] + xb * m1;
                    __builtin_nontemporal_store((v4u){pk2(o0.x, o0.y), pk2(o0.z, o0.w), pk2(o1.x, o1.y), pk2(o1.z, o1.w)}, (GAS v4u*)(XMIX + (size_t)q * (AST / 2) + orow + c)); }
                prev.a[j] = v.a[j]; prev.b[j] = v.b[j]; asm volatile("" ::: "memory"); }
        }
    }
    __syncthreads();
}
__device__ __forceinline__ void final_ln_phase(Frame& F, const Args& a) {
    float* X1 = a.out; const bf16* Y1 = (const bf16*)(a.ws + WS_Y1); const float* lg = a.in[22] + DM; const float* lb = a.in[23] + DM;
    PHASE_TID();
    LAS float* cv = (LAS float*)(F.lds + RING_OFF);
    cv_fill(cv, lg, tid); cv_fill(cv + DM, lb, tid); LDS_WAIT(); __syncthreads();
    const int gw = F.vcu * NWAVES + wave, NGW = F.G * NWAVES;
    for (int row = gw; row < M; row += NGW) {
        Row32 v; ln_row_cv<true>((const float*)((const bf16*)(X1 + (size_t)row * DM) + ((row >> 3) & 1) * DM), Y1 + (size_t)row * DM, cv, cv + DM, lane, v);
#pragma unroll
        for (int j = 0; j < 4; ++j) { const int c = 8 * lane + 512 * j; *(GAS f32x4*)(X1 + (size_t)row * DM + c) = v.a[j]; *(GAS f32x4*)(X1 + (size_t)row * DM + c + 4) = v.b[j]; }
    }
}

namespace wkv {
constexpr int NSLOT_ = 8;
typedef short bf16x8 __attribute__((ext_vector_type(8)));
typedef float f32x16 __attribute__((ext_vector_type(16)));
typedef float f32x4 __attribute__((ext_vector_type(4)));
typedef unsigned u32x4 __attribute__((ext_vector_type(4)));
typedef unsigned u32x2 __attribute__((ext_vector_type(2)));
typedef _Float16 h16x2 __attribute__((ext_vector_type(2)));
constexpr int O_KR = 0, O_BGT = 4096, O_KGT = 6144, O_VT = 8192, O_AM = 10240, O_LC = 11264, O_GC = 12288, O_BON = 12544, SLOT = 12608;
constexpr int OENT = 4096 + 64;
constexpr int NPREP = 6, L_SLOTS = 0, L_BK = NSLOT_ * SLOT, L_ORING = L_BK + NPREP * 4096, L_FLAGS = L_ORING + NSLOT_ * OENT, L_END = L_FLAGS + 256;
constexpr int NSLOT = 8;
constexpr float L2E = 1.4426950408889634f;
__device__ __forceinline__ int kr_off(int row, int chunk) { return row * 128 + ((chunk ^ ((row >> 1) & 7)) << 4); }
__device__ __forceinline__ int t_off(int row, int half) { return row * 32 + ((half ^ ((row >> 3) & 1)) << 4); }
typedef float f32x2_t __attribute__((ext_vector_type(2))); typedef __bf16 bf16x2_t __attribute__((ext_vector_type(2)));
__device__ __forceinline__ unsigned cvtpk(float lo, float hi) { f32x2_t v = {lo, hi}; bf16x2_t b = __builtin_convertvector(v, bf16x2_t); return __builtin_bit_cast(unsigned, b); }
__device__ __forceinline__ int rho(int j, int h) { return (j & 3) + 8 * (j >> 2) + 4 * h; }
template <int B> __device__ __forceinline__ bf16x8 frag(const f32x16& x) {
    u32x4 w = {cvtpk(x[B + 0], x[B + 1]), cvtpk(x[B + 2], x[B + 3]), cvtpk(x[B + 4], x[B + 5]), cvtpk(x[B + 6], x[B + 7])};
    return __builtin_bit_cast(bf16x8, w);
}
template <int B> __device__ __forceinline__ bf16x8 frag_pI(const f32x16& x, const float (&dI)[8]) {
    u32x4 w = {cvtpk(x[B + 0] + dI[0], x[B + 1] + dI[1]), cvtpk(x[B + 2] + dI[2], x[B + 3] + dI[3]), cvtpk(x[B + 4] + dI[4], x[B + 5] + dI[5]), cvtpk(x[B + 6] + dI[6], x[B + 7] + dI[7])};
    return __builtin_bit_cast(bf16x8, w);
}
__device__ __forceinline__ float dppf(float v, int) { return v; }
__device__ __forceinline__ float sum16(float v) {
    v += __builtin_bit_cast(float, __builtin_amdgcn_update_dpp(0, __builtin_bit_cast(int, v), 0xB1, 0xf, 0xf, false));
    v += __builtin_bit_cast(float, __builtin_amdgcn_update_dpp(0, __builtin_bit_cast(int, v), 0x4E, 0xf, 0xf, false));
    v += __builtin_bit_cast(float, __builtin_amdgcn_update_dpp(0, __builtin_bit_cast(int, v), 0x141, 0xf, 0xf, false));
    v += __builtin_bit_cast(float, __builtin_amdgcn_update_dpp(0, __builtin_bit_cast(int, v), 0x140, 0xf, 0xf, false));
    return v;
}
__device__ __forceinline__ float sum32(float v) { v = sum16(v); return v + __shfl_xor(v, 16); }
#define MF(A_, B_, C_) __builtin_amdgcn_mfma_f32_32x32x16_bf16((A_), (B_), (C_), 0, 0, 0)

struct Tensors { const unsigned short* R; const unsigned short* K; const unsigned short* V; const unsigned short* SG; const unsigned short* LOGW; const unsigned short* AA; unsigned short* OG;
                 const float* k_k; const float* k_a; const float* r_k; const float* gn_w; const float* gn_b; };

struct Raw { unsigned r[8], k[8], v[8], l[8], a[8]; };
__device__ __forceinline__ void prep_load(const Tensors& T, size_t grow0, int h, int lane, Raw& w) {
    const int cp = lane & 31, hh = lane >> 5;
    const size_t ub = grow0 * 2048 + h * 64;
    const unsigned lo = (unsigned)(hh * 8 * 2048 + 2 * cp);
    const unsigned short* pr = T.R + ub; const unsigned short* pk = T.K + ub; const unsigned short* pv = T.V + ub; const unsigned short* pl = T.LOGW + ub; const unsigned short* pa = T.AA + ub;
#pragma unroll
    for (int i = 0; i < 8; ++i) { const unsigned e = lo + (unsigned)i * 2048u;
        w.r[i] = *(const GAS unsigned*)(pr + e); w.k[i] = *(const GAS unsigned*)(pk + e); w.v[i] = *(const GAS unsigned*)(pv + e);
        w.l[i] = *(const GAS unsigned*)(pl + e); w.a[i] = *(const GAS unsigned*)(pa + e); }
}
template <class WaitSlot>
__device__ __forceinline__ void prep_elem(const Tensors& T, const Raw& w, int h, LAS unsigned char* slot, LAS unsigned char* bk, int lane, const WaitSlot& wait_slot) {
    const int cp = lane & 31, hh = lane >> 5;
    float lw[8][2], aa[8][2], rr[8][2], kr[8][2];
#pragma unroll
    for (int i = 0; i < 8; ++i) {
        const unsigned wr_ = w.r[i], wk_ = w.k[i], wl_ = w.l[i], wa_ = w.a[i];
        rr[i][0] = bflo(wr_); rr[i][1] = bfhi(wr_); kr[i][0] = bflo(wk_); kr[i][1] = bfhi(wk_);
        const h16x2 hl = __builtin_bit_cast(h16x2, wl_), ha = __builtin_bit_cast(h16x2, wa_);
        lw[i][0] = (float)hl[0]; lw[i][1] = (float)hl[1]; aa[i][0] = (float)ha[0]; aa[i][1] = (float)ha[1]; }
    float kkc[2], kac[2], rkc[2];
#pragma unroll
    for (int e = 0; e < 2; ++e) { kkc[e] = T.k_k[h * 64 + 2 * cp + e]; kac[e] = T.k_a[h * 64 + 2 * cp + e]; rkc[e] = T.r_k[h * 64 + 2 * cp + e]; }
    float g[8][2], e0x[2], gam[2];
#pragma unroll
    for (int e = 0; e < 2; ++e) { float run = 0.f;
#pragma unroll
        for (int i = 0; i < 8; ++i) { run += lw[i][e]; g[i][e] = run; }
        auto sw = __builtin_amdgcn_permlane32_swap(__float_as_uint(run), __float_as_uint(run), false, false);
        const float lo_tot = __uint_as_float(sw[0]), hi_tot = __uint_as_float(sw[1]);
        const float off = hh ? lo_tot : 0.f;
#pragma unroll
        for (int i = 0; i < 8; ++i) g[i][e] += off;
        e0x[e] = hh ? __builtin_amdgcn_exp2f(lo_tot * L2E) : 1.0f;
        gam[e] = __builtin_amdgcn_exp2f((lo_tot + hi_tot) * L2E); }
    float inv[8], bon[8], kp[8][2];
#pragma unroll
    for (int i = 0; i < 8; ++i) { const float q0 = kr[i][0] * kkc[0], q1 = kr[i][1] * kkc[1];
        const float ss = sum32(q0 * q0 + q1 * q1); inv[i] = __builtin_amdgcn_rsqf(fmaxf(ss, 1e-24f));
        kp[i][0] = kr[i][0] * (1.0f + (aa[i][0] - 1.0f) * kac[0]); kp[i][1] = kr[i][1] * (1.0f + (aa[i][1] - 1.0f) * kac[1]);
        bon[i] = sum32(rr[i][0] * kp[i][0] * rkc[0] + rr[i][1] * kp[i][1] * rkc[1]); }
    unsigned pBg[2][4], pKg[2][4], pKn[8], pRq[8];
    float eprev[2] = {e0x[0], e0x[1]};
    const int ch = cp >> 2, wo = (cp & 3) * 4;
#pragma unroll
    for (int ip = 0; ip < 4; ++ip) {
        float Bg[2][2], Kg[2][2];
#pragma unroll
        for (int q = 0; q < 2; ++q) { const int i = 2 * ip + q;
            float Kn[2], Rq[2], Bd[2], Kd[2];
#pragma unroll
            for (int e = 0; e < 2; ++e) { const float E1 = __builtin_amdgcn_exp2f(g[i][e] * L2E), Ei = __builtin_amdgcn_exp2f(-g[i][e] * L2E);
                const float kkn = kr[i][e] * kkc[e] * inv[i];
                Kn[e] = -kkn * eprev[e]; Rq[e] = rr[i][e] * E1; Bd[e] = kkn * aa[i][e] * Ei; Kd[e] = kp[i][e] * Ei; Bg[q][e] = Bd[e] * gam[e]; Kg[q][e] = Kd[e] * gam[e]; eprev[e] = E1; }
            const int tt = 8 * hh + i;
            pKn[i] = cvtpk(Kn[0], Kn[1]); pRq[i] = cvtpk(Rq[0], Rq[1]);
            *(LAS unsigned*)(bk + kr_off(tt, ch) + wo) = cvtpk(Bd[0], Bd[1]);
            *(LAS unsigned*)(bk + kr_off(16 + tt, ch) + wo) = cvtpk(Kd[0], Kd[1]); }
#pragma unroll
        for (int e = 0; e < 2; ++e) { pBg[e][ip] = cvtpk(Bg[0][e], Bg[1][e]); pKg[e][ip] = cvtpk(Kg[0][e], Kg[1][e]); }
    }
    wait_slot();
#pragma unroll
    for (int i = 0; i < 8; ++i) { const int tt = 8 * hh + i;
        *(LAS unsigned*)(slot + O_KR + kr_off(tt, ch) + wo) = pKn[i];
        *(LAS unsigned*)(slot + O_KR + kr_off(16 + tt, ch) + wo) = pRq[i]; }
    unsigned pV[2][4];
#pragma unroll
    for (int ip = 0; ip < 4; ++ip) { const unsigned a_ = w.v[2 * ip], b_ = w.v[2 * ip + 1]; pV[0][ip] = (a_ & 0xffffu) | (b_ << 16); pV[1][ip] = (a_ >> 16) | (b_ & 0xffff0000u); }
#pragma unroll
    for (int e = 0; e < 2; ++e) { const int row = 2 * cp + e;
        *(LAS u32x2*)(slot + O_BGT + t_off(row, 0) + 8 * hh) = (u32x2){pBg[e][0], pBg[e][1]}; *(LAS u32x2*)(slot + O_BGT + t_off(row, 1) + 8 * hh) = (u32x2){pBg[e][2], pBg[e][3]};
        *(LAS u32x2*)(slot + O_KGT + t_off(row, 0) + 8 * hh) = (u32x2){pKg[e][0], pKg[e][1]}; *(LAS u32x2*)(slot + O_KGT + t_off(row, 1) + 8 * hh) = (u32x2){pKg[e][2], pKg[e][3]};
        *(LAS u32x2*)(slot + O_VT + t_off(row, 0) + 8 * hh) = (u32x2){pV[e][0], pV[e][1]}; *(LAS u32x2*)(slot + O_VT + t_off(row, 1) + 8 * hh) = (u32x2){pV[e][2], pV[e][3]}; }
    if (hh == 0) *(LAS f32x2v*)(slot + O_GC + 8 * cp) = (f32x2v){gam[0], gam[1]};
    if (cp == 0) {
#pragma unroll
        for (int i = 0; i < 8; ++i) *(LAS float*)(slot + O_BON + 4 * (8 * hh + i)) = bon[i]; }
    LDS_WAIT(); asm volatile("" ::: "memory");
}
template <class WaitSlot>
__device__ __forceinline__ void prep_elem_kv(const Tensors& T, const Raw& w, int h, LAS unsigned char* slot, LAS unsigned char* bk, int lane, const float (&kkc)[2], const float (&kac)[2], const float (&rkc)[2], const WaitSlot& wait_slot) {
    const int cp = lane & 31, hh = lane >> 5;
    float lw[8][2], aa[8][2], rr[8][2], kr[8][2];
#pragma unroll
    for (int i = 0; i < 8; ++i) {
        const unsigned wr_ = w.r[i], wk_ = w.k[i], wl_ = w.l[i], wa_ = w.a[i];
        rr[i][0] = bflo(wr_); rr[i][1] = bfhi(wr_); kr[i][0] = bflo(wk_); kr[i][1] = bfhi(wk_);
        const h16x2 hl = __builtin_bit_cast(h16x2, wl_), ha = __builtin_bit_cast(h16x2, wa_);
        lw[i][0] = (float)hl[0]; lw[i][1] = (float)hl[1]; aa[i][0] = (float)ha[0]; aa[i][1] = (float)ha[1]; }
    float g[8][2], e0x[2], gam[2];
#pragma unroll
    for (int e = 0; e < 2; ++e) { float run = 0.f;
#pragma unroll
        for (int i = 0; i < 8; ++i) { run += lw[i][e]; g[i][e] = run; }
        auto sw = __builtin_amdgcn_permlane32_swap(__float_as_uint(run), __float_as_uint(run), false, false);
        const float lo_tot = __uint_as_float(sw[0]), hi_tot = __uint_as_float(sw[1]);
        const float off = hh ? lo_tot : 0.f;
#pragma unroll
        for (int i = 0; i < 8; ++i) g[i][e] += off;
        e0x[e] = hh ? __builtin_amdgcn_exp2f(lo_tot * L2E) : 1.0f;
        gam[e] = __builtin_amdgcn_exp2f((lo_tot + hi_tot) * L2E); }
    float inv[8], bon[8], kp[8][2];
#pragma unroll
    for (int i = 0; i < 8; ++i) { const float q0 = kr[i][0] * kkc[0], q1 = kr[i][1] * kkc[1];
        const float ss = sum32(q0 * q0 + q1 * q1); inv[i] = __builtin_amdgcn_rsqf(fmaxf(ss, 1e-24f));
        kp[i][0] = kr[i][0] * (1.0f + (aa[i][0] - 1.0f) * kac[0]); kp[i][1] = kr[i][1] * (1.0f + (aa[i][1] - 1.0f) * kac[1]);
        bon[i] = sum32(rr[i][0] * kp[i][0] * rkc[0] + rr[i][1] * kp[i][1] * rkc[1]); }
    unsigned pBg[2][4], pKg[2][4], pKn[8], pRq[8];
    float eprev[2] = {e0x[0], e0x[1]};
    const int ch = cp >> 2, wo = (cp & 3) * 4;
#pragma unroll
    for (int ip = 0; ip < 4; ++ip) {
        float Bg[2][2], Kg[2][2];
#pragma unroll
        for (int q = 0; q < 2; ++q) { const int i = 2 * ip + q;
            float Kn[2], Rq[2], Bd[2], Kd[2];
#pragma unroll
            for (int e = 0; e < 2; ++e) { const float E1 = __builtin_amdgcn_exp2f(g[i][e] * L2E), Ei = __builtin_amdgcn_exp2f(-g[i][e] * L2E);
                const float kkn = kr[i][e] * kkc[e] * inv[i];
                Kn[e] = -kkn * eprev[e]; Rq[e] = rr[i][e] * E1; Bd[e] = kkn * aa[i][e] * Ei; Kd[e] = kp[i][e] * Ei; Bg[q][e] = Bd[e] * gam[e]; Kg[q][e] = Kd[e] * gam[e]; eprev[e] = E1; }
            const int tt = 8 * hh + i;
            pKn[i] = cvtpk(Kn[0], Kn[1]); pRq[i] = cvtpk(Rq[0], Rq[1]);
            *(LAS unsigned*)(bk + kr_off(tt, ch) + wo) = cvtpk(Bd[0], Bd[1]);
            *(LAS unsigned*)(bk + kr_off(16 + tt, ch) + wo) = cvtpk(Kd[0], Kd[1]); }
#pragma unroll
        for (int e = 0; e < 2; ++e) { pBg[e][ip] = cvtpk(Bg[0][e], Bg[1][e]); pKg[e][ip] = cvtpk(Kg[0][e], Kg[1][e]); }
    }
    wait_slot();
#pragma unroll
    for (int i = 0; i < 8; ++i) { const int tt = 8 * hh + i;
        *(LAS unsigned*)(slot + O_KR + kr_off(tt, ch) + wo) = pKn[i];
        *(LAS unsigned*)(slot + O_KR + kr_off(16 + tt, ch) + wo) = pRq[i]; }
    unsigned pV[2][4];
#pragma unroll
    for (int ip = 0; ip < 4; ++ip) { const unsigned a_ = w.v[2 * ip], b_ = w.v[2 * ip + 1]; pV[0][ip] = (a_ & 0xffffu) | (b_ << 16); pV[1][ip] = (a_ >> 16) | (b_ & 0xffff0000u); }
#pragma unroll
    for (int e = 0; e < 2; ++e) { const int row = 2 * cp + e;
        *(LAS u32x2*)(slot + O_BGT + t_off(row, 0) + 8 * hh) = (u32x2){pBg[e][0], pBg[e][1]}; *(LAS u32x2*)(slot + O_BGT + t_off(row, 1) + 8 * hh) = (u32x2){pBg[e][2], pBg[e][3]};
        *(LAS u32x2*)(slot + O_KGT + t_off(row, 0) + 8 * hh) = (u32x2){pKg[e][0], pKg[e][1]}; *(LAS u32x2*)(slot + O_KGT + t_off(row, 1) + 8 * hh) = (u32x2){pKg[e][2], pKg[e][3]};
        *(LAS u32x2*)(slot + O_VT + t_off(row, 0) + 8 * hh) = (u32x2){pV[e][0], pV[e][1]}; *(LAS u32x2*)(slot + O_VT + t_off(row, 1) + 8 * hh) = (u32x2){pV[e][2], pV[e][3]}; }
    if (hh == 0) *(LAS f32x2v*)(slot + O_GC + 8 * cp) = (f32x2v){gam[0], gam[1]};
    if (cp == 0) {
#pragma unroll
        for (int i = 0; i < 8; ++i) *(LAS float*)(slot + O_BON + 4 * (8 * hh + i)) = bon[i]; }
    LDS_WAIT(); asm volatile("" ::: "memory");
}
__device__ __forceinline__ void prep_mfma(LAS unsigned char* slot, LAS unsigned char* bk, int lane) {
    const int r = lane & 31, hq = lane >> 5;
    bf16x8 fKR[4], fBK[4];
#pragma unroll
    for (int s4 = 0; s4 < 4; ++s4) { fKR[s4] = *(const LAS bf16x8*)(slot + O_KR + kr_off(r, 2 * s4 + hq)); fBK[s4] = *(const LAS bf16x8*)(bk + kr_off(r, 2 * s4 + hq)); }
    f32x16 P = {}, PT = {};
#pragma unroll
    for (int s4 = 0; s4 < 4; ++s4) { P = MF(fKR[s4], fBK[s4], P); PT = MF(fBK[s4], fKR[s4], PT); }
    {
        const int jc = r & 15;
#pragma unroll
        for (int gg = 0; gg < 16; ++gg) { const int tr = (gg & 3) + 8 * ((gg >> 2) & 1) + 4 * hq;
            const bool keepP = (gg < 8) ? (jc < tr) : (jc <= tr);
            const bool keepT = (r < 16) ? (tr < jc) : (tr <= jc);
            P[gg] = keepP ? P[gg] : 0.f; PT[gg] = keepT ? PT[gg] : 0.f; }
    }
    float dI[8];
#pragma unroll
    for (int j = 0; j < 8; ++j) dI[j] = (r == rho(j, hq)) ? 1.0f : 0.f;
    const f32x16 Z = {};
    const bf16x8 opN = frag<0>(P), opNt = frag<0>(PT);
    const f32x16 N2 = MF(opNt, opN, Z), N2t = MF(opN, opNt, Z);
    const bf16x8 opN2 = frag<0>(N2), opN2t = frag<0>(N2t);
    const f32x16 N4 = MF(opN2t, opN2, Z), N4t = MF(opN2, opN2t, Z);
    const bf16x8 opN4 = frag<0>(N4), opN4t = frag<0>(N4t);
    const f32x16 N8 = MF(opN4t, opN4, Z);
    const f32x16 G1t = MF(frag_pI<0>(N2, dI), frag_pI<0>(PT, dI), Z);
    const f32x16 G2 = MF(frag_pI<0>(N4t, dI), frag_pI<0>(N8, dI), Z);
    const f32x16 Tm = MF(frag<0>(G1t), frag<0>(G2), Z);
    const f32x16 Dm = MF(frag<0>(Tm), opNt, Z);
    *(LAS bf16x8*)(slot + O_LC + lane * 16) = frag_pI<0>(Dm, dI);
    *(LAS bf16x8*)(slot + O_AM + lane * 16) = frag<8>(PT);
}

__device__ __forceinline__ void chunk_step(LAS unsigned char* slot, LAS unsigned char* oent, f32x16& S0, f32x16& S1, int vh, int lane) {
    const int r = lane & 31, hq = lane >> 5, vrow = 32 * vh + r;
    const bf16x8 fVT = *(const LAS bf16x8*)(slot + O_VT + t_off(vrow, hq));
    const bf16x8 fAM = *(const LAS bf16x8*)(slot + O_AM + lane * 16);
    const f32x16 Z = {};
    f32x16 X = MF(fAM, fVT, Z);
#define LFRAG(tau, u) ({ const u32x2 a_ = *(const LAS u32x2*)(slot + O_KR + kr_off(r, 4 * (tau) + 2 * (u)) + 8 * hq), b_ = *(const LAS u32x2*)(slot + O_KR + kr_off(r, 4 * (tau) + 2 * (u) + 1) + 8 * hq); \
                         u32x4 w_ = {a_.x, a_.y, b_.x, b_.y}; __builtin_bit_cast(bf16x8, w_); })
    X = MF(LFRAG(0, 0), frag<0>(S0), X);
    X = MF(LFRAG(0, 1), frag<8>(S0), X);
    X = MF(LFRAG(1, 0), frag<0>(S1), X);
    X = MF(LFRAG(1, 1), frag<8>(S1), X);
#undef LFRAG
    const bf16x8 fLC = *(const LAS bf16x8*)(slot + O_LC + lane * 16);
    const f32x16 D2 = MF(fLC, frag<0>(X), Z);
#pragma unroll
    for (int j = 0; j < 8; ++j) *(LAS float*)(oent + (rho(j, hq) * 64 + vrow) * 4) = X[8 + j] + D2[8 + j];
    const bf16x8 fU = frag<0>(D2);
#pragma unroll
    for (int q = 0; q < 4; ++q) { const f32x4 g0 = *(const LAS f32x4*)(slot + O_GC + (8 * q + 4 * hq) * 4), g1 = *(const LAS f32x4*)(slot + O_GC + (32 + 8 * q + 4 * hq) * 4);
#pragma unroll
        for (int e = 0; e < 4; ++e) { S0[4 * q + e] *= g0[e]; S1[4 * q + e] *= g1[e]; } }
    S0 = MF(*(const LAS bf16x8*)(slot + O_BGT + t_off(r, hq)), fU, S0);
    S1 = MF(*(const LAS bf16x8*)(slot + O_BGT + t_off(32 + r, hq)), fU, S1);
    S0 = MF(*(const LAS bf16x8*)(slot + O_KGT + t_off(r, hq)), fVT, S0);
    S1 = MF(*(const LAS bf16x8*)(slot + O_KGT + t_off(32 + r, hq)), fVT, S1);
}
#undef MF
}

#define SCAN_SPIN_CAP (1u << 21)
__device__ __forceinline__ void scan_wait(volatile LAS int* f, int target, volatile LAS int* tmo) {
    unsigned sp = 0;
    while (*f < target) { __builtin_amdgcn_s_sleep(1); if (++sp > SCAN_SPIN_CAP || *tmo) { *tmo = 1; break; } }
    asm volatile("" ::: "memory");
}
__device__ __forceinline__ void scan_epilogue(const wkv::Tensors& T, LAS unsigned char* oent, size_t grow_c, int h, int lane, const v4u& va, const v4u& vb, const v4u& ga, const v4u& gb) {
    const int i = lane >> 2, vq = lane & 3;
    float o[16], s = 0.f;
#pragma unroll
    for (int m = 0; m < 4; ++m) { const f32x4 x = *(const LAS f32x4*)(oent + (i * 64 + 16 * vq + 4 * m) * 4); o[4 * m] = x[0]; o[4 * m + 1] = x[1]; o[4 * m + 2] = x[2]; o[4 * m + 3] = x[3]; s += (x[0] + x[1]) + (x[2] + x[3]); }
    const float bonus = *(const LAS float*)(oent + 4096 + 4 * i);
    s += __builtin_bit_cast(float, __builtin_amdgcn_update_dpp(0, __builtin_bit_cast(int, s), 0xB1, 0xf, 0xf, false));
    s += __builtin_bit_cast(float, __builtin_amdgcn_update_dpp(0, __builtin_bit_cast(int, s), 0x4E, 0xf, 0xf, false));
    const float mean = s * (1.f / 64.f); float s2 = 0.f;
#pragma unroll
    for (int m = 0; m < 16; ++m) { o[m] -= mean; s2 += o[m] * o[m]; }
    s2 += __builtin_bit_cast(float, __builtin_amdgcn_update_dpp(0, __builtin_bit_cast(int, s2), 0xB1, 0xf, 0xf, false));
    s2 += __builtin_bit_cast(float, __builtin_amdgcn_update_dpp(0, __builtin_bit_cast(int, s2), 0x4E, 0xf, 0xf, false));
    const float rstd = __builtin_amdgcn_rsqf(s2 * (1.f / 64.f) + GN_EPS);
    const size_t ge = (grow_c + i) * 2048 + h * 64 + 16 * vq;
    const unsigned vw[8] = {va.x, va.y, va.z, va.w, vb.x, vb.y, vb.z, vb.w}, gw[8] = {ga.x, ga.y, ga.z, ga.w, gb.x, gb.y, gb.z, gb.w};
    unsigned ow[8];
#pragma unroll
    for (int m = 0; m < 8; ++m) { const int col = h * 64 + 16 * vq + 2 * m;
        const float r0 = (o[2 * m] * rstd * T.gn_w[col] + T.gn_b[col] + bonus * bflo(vw[m])) * bflo(gw[m]);
        const float r1 = (o[2 * m + 1] * rstd * T.gn_w[col + 1] + T.gn_b[col + 1] + bonus * bfhi(vw[m])) * bfhi(gw[m]);
        ow[m] = pk2(r0, r1); }
    *(GAS v4u*)(T.OG + ge) = (v4u){ow[0], ow[1], ow[2], ow[3]}; *(GAS v4u*)(T.OG + ge + 8) = (v4u){ow[4], ow[5], ow[6], ow[7]};
}
constexpr int G_RG = 16, G_ESTR = 12800;
static_assert((size_t)BATCH * 32 * G_RG * G_ESTR <= 34 * MiB && wkv::SLOT <= G_ESTR, "image rings");
__device__ __forceinline__ bool gwait(unsigned* f, unsigned target, volatile LAS int* tmo) {
    unsigned sp = 0;
    while (__hip_atomic_load(f, __ATOMIC_RELAXED, __HIP_MEMORY_SCOPE_AGENT) < target) { __builtin_amdgcn_s_sleep(2); if (++sp > SCAN_SPIN_CAP || *tmo) { *tmo = 1; return false; } }
    return true;
}
__device__ __forceinline__ void scan_phase_split(Frame& F, const Args& a) {
    wkv::Tensors T;
    T.R = (const unsigned short*)(a.ws + WS_R); T.K = (const unsigned short*)(a.ws + WS_K2); T.V = (const unsigned short*)(a.ws + WS_V2); T.SG = (const unsigned short*)(a.ws + WS_SG);
    T.LOGW = (const unsigned short*)(a.ws + WS_LOGW); T.AA = (const unsigned short*)(a.ws + WS_AA); T.OG = (unsigned short*)(a.ws + WS_OG);
    T.k_k = a.in[16]; T.k_a = a.in[17]; T.r_k = a.in[18]; T.gn_w = a.in[19]; T.gn_b = a.in[20];
    PHASE_TID();
    constexpr int NCH = SEQ / 16, NP = NCH / 2, NH = BATCH * 32;
    const int j = F.vcu % NH, b = j >> 5, h = j & 31;
    const size_t grow0 = (size_t)b * SEQ;
    unsigned char* gring = a.ws + WS_GRING + (size_t)j * G_RG * G_ESTR;
    unsigned* gfl = (unsigned*)(F.ctl + CW_GFL) + j * 32;
    if (F.vcu >= 2 * NH) return;
    if (F.vcu >= NH) {
        volatile LAS int* tmo = (volatile LAS int*)(F.MISC + 16);
        if (tid == 0) *tmo = 0;
        __syncthreads();
        LAS unsigned char* slot = F.lds + RING_OFF + wave * (G_ESTR + 4096); LAS unsigned char* bk = slot + G_ESTR;
        const __amdgpu_buffer_rsrc_t rsrc = __builtin_amdgcn_make_buffer_rsrc((void*)gring, (short)0, G_RG * G_ESTR, 0x00020000);
        wkv::Raw raw;
        wkv::prep_load(T, grow0 + (size_t)(2 * wave + 1) * 16, h, lane, raw);
#pragma unroll 1
        for (int P = wave; P < NP; P += 8) {
            wkv::prep_elem(T, raw, h, slot, bk, lane, [&]() {});
            if (P + 8 < NP) wkv::prep_load(T, grow0 + (size_t)(2 * (P + 8) + 1) * 16, h, lane, raw);
            wkv::prep_mfma(slot, bk, lane);
            LDS_WAIT(); asm volatile("" ::: "memory");
            const int en = P & (G_RG - 1);
            if (P >= G_RG) (void)gwait(gfl + 16 + en, (unsigned)(P - G_RG + 1), tmo);
#pragma unroll
            for (int k = 0; k < 13; ++k) { if (k < 12 || lane < 20) { const wkv::u32x4 v = *(const LAS wkv::u32x4*)(slot + k * 1024 + lane * 16);
                __builtin_amdgcn_raw_buffer_store_b128(v, rsrc, en * G_ESTR + k * 1024 + lane * 16, 0, 16  ); } }
            asm volatile("s_waitcnt vmcnt(0)" ::: "memory");
            if (lane == 0) __hip_atomic_store(gfl + en, (unsigned)(P + 1), __ATOMIC_RELAXED, __HIP_MEMORY_SCOPE_AGENT);
        }
        __syncthreads();
        {
            constexpr int I_SQ = (DM / 64) * (DM / 32);
            LAS float* scr = (LAS float*)(F.lds + RING_OFF + wave * 16384);
            for (int it = (F.vcu - NH) * NWAVES + wave; it < I_SQ; it += NH * NWAVES) p0_transpose_item(a.in[21], DM, (bf16*)(a.ws + WS_WOT), DM, 0, scr, it, lane);
        }
        return;
    }
    volatile LAS int* FL = (volatile LAS int*)(F.lds + wkv::L_FLAGS);
    volatile LAS int* ready = FL; volatile LAS int* cons0 = FL + 8; volatile LAS int* cons1 = FL + 16; volatile LAS int* freed = FL + 24; volatile LAS int* tmo = FL + 32;
    __syncthreads();
    if (tid < 40) FL[tid] = 0;
    __syncthreads();
    if (wave < 2) {
        wkv::f32x16 S0 = {}, S1 = {};
        volatile LAS int* mycons = wave ? cons1 : cons0;
#pragma unroll 1
        for (int c = 0; c < NCH; ++c) { const int sl = c & 7;
            scan_wait(ready + sl, c + 1, tmo);
            if (c >= 8) scan_wait(freed + sl, c - 7, tmo);
            LAS unsigned char* slot = F.lds + sl * wkv::SLOT; LAS unsigned char* oent = F.lds + wkv::L_ORING + sl * wkv::OENT;
            if (wave == 0 && lane < 16) *(LAS float*)(oent + 4096 + 4 * lane) = *(const LAS float*)(slot + wkv::O_BON + 4 * lane);
            wkv::chunk_step(slot, oent, S0, S1, wave, lane);
            LDS_WAIT(); asm volatile("" ::: "memory");
            if (lane == 0) mycons[sl] = c + 1;
        }
    } else {
        const int p = wave - 2;
        LAS unsigned char* bk = F.lds + wkv::L_BK + p * 4096;
        float kkc[2], kac[2], rkc[2];
#pragma unroll
        for (int e_ = 0; e_ < 2; ++e_) { const int col = h * 64 + 2 * (lane & 31) + e_; kkc[e_] = T.k_k[col]; kac[e_] = T.k_a[col]; rkc[e_] = T.r_k[col]; }
        wkv::Raw raw;
        wkv::prep_load(T, grow0 + (size_t)(2 * p) * 16, h, lane, raw);
        unsigned nflag = __hip_atomic_load(gfl + (p & (G_RG - 1)), __ATOMIC_RELAXED, __HIP_MEMORY_SCOPE_AGENT);
#pragma unroll 1
        for (int P = p; P < NP + 2; P += 6) {
            const int c0 = 2 * P, c1 = c0 + 1, Pe = P - 2, e0 = 2 * Pe, e1 = e0 + 1;
            const bool has = P < NP, hasE = Pe >= 0, hasN = P + 6 < NP;
            v4u va0 = {0u, 0u, 0u, 0u}, vb0 = va0, ga0 = va0, gb0 = va0, va1 = va0, vb1 = va0, ga1 = va0, gb1 = va0;
            auto epi_loads = [&]() { if (hasE) {
                const size_t g0 = (grow0 + (size_t)e0 * 16 + (lane >> 2)) * 2048 + h * 64 + 16 * (lane & 3), g1 = g0 + (size_t)16 * 2048;
                va0 = *(const GAS v4u*)(T.V + g0); vb0 = *(const GAS v4u*)(T.V + g0 + 8); ga0 = *(const GAS v4u*)(T.SG + g0); gb0 = *(const GAS v4u*)(T.SG + g0 + 8);
                va1 = *(const GAS v4u*)(T.V + g1); vb1 = *(const GAS v4u*)(T.V + g1 + 8); ga1 = *(const GAS v4u*)(T.SG + g1); gb1 = *(const GAS v4u*)(T.SG + g1 + 8); } };
            if (has) { const int sl0 = c0 & 7, sl1 = c1 & 7, en = P & (G_RG - 1);
                if (c1 >= 8) { scan_wait(cons0 + sl1, c1 - 7, tmo); scan_wait(cons1 + sl1, c1 - 7, tmo); }
                if (nflag < (unsigned)(P + 1)) (void)gwait(gfl + en, (unsigned)(P + 1), tmo);
                if (hasN) nflag = __hip_atomic_load(gfl + ((P + 6) & (G_RG - 1)), __ATOMIC_RELAXED, __HIP_MEMORY_SCOPE_AGENT);
                { const unsigned char* ge = gring + (size_t)en * G_ESTR + lane * 16; LAS unsigned char* ls = F.lds + sl1 * wkv::SLOT;
#pragma unroll
                  for (int k = 0; k < 13; ++k) { if (k < 12 || lane < 20) __builtin_amdgcn_global_load_lds((const unsigned*)(ge + k * 1024), (LAS unsigned*)(ls + k * 1024), 16, 0, 17  ); } }
                wkv::prep_elem_kv(T, raw, h, F.lds + sl0 * wkv::SLOT, bk, lane, kkc, kac, rkc, [&]() { epi_loads(); if (c0 >= 8) { scan_wait(cons0 + sl0, c0 - 7, tmo); scan_wait(cons1 + sl0, c0 - 7, tmo); } });
                if (hasN) wkv::prep_load(T, grow0 + (size_t)(c0 + 12) * 16, h, lane, raw);
                wkv::prep_mfma(F.lds + sl0 * wkv::SLOT, bk, lane);
                LDS_WAIT(); asm volatile("" ::: "memory");
                if (lane == 0) ready[sl0] = c0 + 1;
                if (hasE) { if (hasN) asm volatile("s_waitcnt vmcnt(48)" ::: "memory"); else asm volatile("s_waitcnt vmcnt(8)" ::: "memory"); }
                else      { if (hasN) asm volatile("s_waitcnt vmcnt(40)" ::: "memory"); else asm volatile("s_waitcnt vmcnt(0)" ::: "memory"); }
                if (lane == 0) { ready[sl1] = c1 + 1; __hip_atomic_store(gfl + 16 + en, (unsigned)(P + 1), __ATOMIC_RELAXED, __HIP_MEMORY_SCOPE_AGENT); }
            } else epi_loads();
            if (hasE) {
#pragma unroll
                for (int i_ = 0; i_ < 8; ++i_) asm volatile("" : "+v"(raw.r[i_]), "+v"(raw.k[i_]), "+v"(raw.v[i_]), "+v"(raw.l[i_]), "+v"(raw.a[i_]));
                { const int se = e0 & 7; scan_wait(cons0 + se, e0 + 1, tmo); scan_wait(cons1 + se, e0 + 1, tmo);
                  scan_epilogue(T, F.lds + wkv::L_ORING + se * wkv::OENT, grow0 + (size_t)e0 * 16, h, lane, va0, vb0, ga0, gb0);
                  LDS_WAIT(); asm volatile("" ::: "memory"); if (lane == 0) freed[se] = e0 + 1; }
                { const int se = e1 & 7; scan_wait(cons0 + se, e1 + 1, tmo); scan_wait(cons1 + se, e1 + 1, tmo);
                  scan_epilogue(T, F.lds + wkv::L_ORING + se * wkv::OENT, grow0 + (size_t)e1 * 16, h, lane, va1, vb1, ga1, gb1);
                  LDS_WAIT(); asm volatile("" ::: "memory"); if (lane == 0) freed[se] = e1 + 1; }
            }
        }
    }
    __syncthreads();
}
__device__ __forceinline__ void scan_phase(Frame& F, const Args& a) {
    wkv::Tensors T;
    T.R = (const unsigned short*)(a.ws + WS_R); T.K = (const unsigned short*)(a.ws + WS_K2); T.V = (const unsigned short*)(a.ws + WS_V2); T.SG = (const unsigned short*)(a.ws + WS_SG);
    T.LOGW = (const unsigned short*)(a.ws + WS_LOGW); T.AA = (const unsigned short*)(a.ws + WS_AA); T.OG = (unsigned short*)(a.ws + WS_OG);
    T.k_k = a.in[16]; T.k_a = a.in[17]; T.r_k = a.in[18]; T.gn_w = a.in[19]; T.gn_b = a.in[20];
    PHASE_TID();
    constexpr int NCH = SEQ / 16, NPREP = wkv::NPREP;
    if (F.vcu >= BATCH * 32) {
        constexpr int I_SQ = (DM / 64) * (DM / 32);
        LAS float* scr = (LAS float*)(F.lds + RING_OFF + wave * 16384);
        for (int it = (F.vcu - BATCH * 32) * NWAVES + wave; it < I_SQ; it += (F.G - BATCH * 32) * NWAVES) p0_transpose_item(a.in[21], DM, (bf16*)(a.ws + WS_WOT), DM, 0, scr, it, lane);
        return;
    }
    volatile LAS int* FL = (volatile LAS int*)(F.lds + wkv::L_FLAGS);
    volatile LAS int* ready = FL; volatile LAS int* cons0 = FL + 8; volatile LAS int* cons1 = FL + 16; volatile LAS int* freed = FL + 24; volatile LAS int* tmo = FL + 32;
    for (int bh = F.vcu; bh < BATCH * 32; bh += F.G) {
        const int b = bh >> 5, h = bh & 31;
        const size_t grow0 = (size_t)b * SEQ;
        __syncthreads();
        if (tid < 40) FL[tid] = 0;
        __syncthreads();
        if (wave < 2) {
            wkv::f32x16 S0 = {}, S1 = {};
            volatile LAS int* mycons = wave ? cons1 : cons0;
#pragma unroll 1
            for (int c = 0; c < NCH; ++c) { const int sl = c & 7;
                scan_wait(ready + sl, c + 1, tmo);
                if (c >= 8) scan_wait(freed + sl, c - 7, tmo);
                LAS unsigned char* slot = F.lds + sl * wkv::SLOT; LAS unsigned char* oent = F.lds + wkv::L_ORING + sl * wkv::OENT;
                if (wave == 0 && lane < 16) *(LAS float*)(oent + 4096 + 4 * lane) = *(const LAS float*)(slot + wkv::O_BON + 4 * lane);
                wkv::chunk_step(slot, oent, S0, S1, wave, lane);
                LDS_WAIT(); asm volatile("" ::: "memory");
                if (lane == 0) mycons[sl] = c + 1;
            }
        } else {
            const int p = wave - 2;
            LAS unsigned char* bk = F.lds + wkv::L_BK + p * 4096;
            wkv::Raw raw;
            wkv::prep_load(T, grow0 + (size_t)p * 16, h, lane, raw);
#pragma unroll 1
            for (int c = p; c < NCH + NPREP; c += NPREP) {
                const int e = c - NPREP;
                v4u va = {0u, 0u, 0u, 0u}, vb = va, ga = va, gb = va;
                const size_t ge = (grow0 + (size_t)(e < 0 ? 0 : e) * 16 + (lane >> 2)) * 2048 + h * 64 + 16 * (lane & 3);
                auto epi_loads = [&]() { if (e >= 0) { va = *(const GAS v4u*)(T.V + ge); vb = *(const GAS v4u*)(T.V + ge + 8); ga = *(const GAS v4u*)(T.SG + ge); gb = *(const GAS v4u*)(T.SG + ge + 8); } };
                if (c < NCH) { const int sl = c & 7;
                    wkv::prep_elem(T, raw, h, F.lds + sl * wkv::SLOT, bk, lane, [&]() { epi_loads(); if (c >= 8) { scan_wait(cons0 + sl, c - 7, tmo); scan_wait(cons1 + sl, c - 7, tmo); } });
                    if (c + NPREP < NCH) wkv::prep_load(T, grow0 + (size_t)(c + NPREP) * 16, h, lane, raw);
                    wkv::prep_mfma(F.lds + sl * wkv::SLOT, bk, lane);
                    LDS_WAIT(); asm volatile("" ::: "memory");
                    if (lane == 0) ready[sl] = c + 1;
                }
                if (c >= NCH) epi_loads();
                if (e >= 0) { const int se = e & 7;
                    scan_wait(cons0 + se, e + 1, tmo); scan_wait(cons1 + se, e + 1, tmo);
#pragma unroll
                    for (int i_ = 0; i_ < 8; ++i_) asm volatile("" : "+v"(raw.r[i_]), "+v"(raw.k[i_]), "+v"(raw.v[i_]), "+v"(raw.l[i_]), "+v"(raw.a[i_]));
                    scan_epilogue(T, F.lds + wkv::L_ORING + se * wkv::OENT, grow0 + (size_t)e * 16, h, lane, va, vb, ga, gb);
                    LDS_WAIT(); asm volatile("" ::: "memory");
                    if (lane == 0) freed[se] = e + 1;
                }
            }
        }
    }
    __syncthreads();
    if (F.G <= BATCH * 32) {
        constexpr int I_SQ = (DM / 64) * (DM / 32);
        LAS float* scr = (LAS float*)(F.lds + RING_OFF + wave * 16384);
        for (int it = F.vcu * NWAVES + wave; it < I_SQ; it += F.G * NWAVES) p0_transpose_item(a.in[21], DM, (bf16*)(a.ws + WS_WOT), DM, 0, scr, it, lane);
    }
}

__global__ void __launch_bounds__(NWAVES * 64, 2) fwd_kernel(Args args) {
    extern __shared__ __attribute__((aligned(16))) unsigned char lds[];
    Frame F;
    F.lds = (LAS unsigned char*)lds;
    F.MISC = (volatile LAS unsigned*)(F.lds + MISC_OFF);
    F.G = gridDim.x; { const int bx = blockIdx.x; F.vcu = (F.G % 8 == 0) ? (bx % 8) * (F.G / 8) + bx / 8 : bx; }
    unsigned char* ws = args.ws;
    F.ctl = (gu32*)(ws + WS_CTL);
    for (int u = threadIdx.x; u < (LDS_BYTES - LDSCTL_OFF) / 4; u += NWAVES * 64) ((LAS unsigned*)(F.lds + LDSCTL_OFF))[u] = 0u;
    __syncthreads();
    XcdBarrier bar; bar.bar = (unsigned*)(F.ctl + CW_BAR); bar.x = 0; bar.st = nullptr;
    if (N_LAUNCHES == 1) bar = xcd_barrier_post((unsigned*)(F.ctl + CW_BAR), F.MISC + 8);
#define GRID_BAR() do { if (N_LAUNCHES == 1) xcd_barrier(bar); } while (0)
    const int lo = args.ph_lo, hi = args.ph_hi;
#ifndef PH_MASK
#define PH_MASK 0xFFF
#endif
#define IN(k) ((((PH_MASK) >> (k)) & 1) && lo <= (k) && (k) < hi)
#define BOTH(k) (IN(k) && IN((k) + 1))
#ifndef REPEAT_MASK
#define REPEAT_MASK 0
#endif
#define REPS(k) for (int rep_ = 0; rep_ < 1 + (((REPEAT_MASK) >> (k)) & 1); ++rep_) if (((rep_ > 0 && N_LAUNCHES == 1) ? (xcd_barrier(bar), 0) : 0), true)
    bf16* H = (bf16*)(ws + WS_H); bf16* MIX = (bf16*)(ws + WS_MIX);

    if (IN(0)) { REPS(0) p0_prologue(F, args); if (BOTH(0)) GRID_BAR(); }

    if (IN(1)) { REPS(1) {
        pg8::Gemm g{(const bf16*)(ws + WS_XB), (const bf16*)(ws + WS_WINT), M, EVEN_IN, DM, DM, DM, 0, 0};
        pg8::StaticOrder S; S.init(M, EVEN_IN, F.G, (int)blockIdx.x);
        pg8::EpiH E{H};
        pg8::gemm_phase<pg8::EpiH, pg8::StaticOrder>(F.lds + RING_OFF, g, S, E); }
        if (BOTH(1)) GRID_BAR();
    }

    if (IN(2)) { REPS(2) {
        const bool weights_first = (F.vcu & 1) != 0;
        if (weights_first) { late_weights(F, args); __syncthreads(); }
#ifndef NO_POOL
        for (int rp_ = 0; rp_ < 1 + (((REPEAT_MASK) >> 12) & 1); ++rp_) {
            if (rp_ > 0 && N_LAUNCHES == 1) xcd_barrier(bar);
            pg8::StaticOrder SO; SO.init(M, 1024, F.G, (int)blockIdx.x); pg8::Unit u;
            bf16* POOLED = (bf16*)(ws + WS_POOLED);
            for (int i = 0; SO.next(i, u); ++i) {
                pool_tile(F, H, POOLED, u.pm, u.pn);
                VM_WAIT(); __syncthreads();
                if (threadIdx.x == 0) { __builtin_amdgcn_fence(__ATOMIC_ACQUIRE, "agent"); VM_WAIT(); }
                __syncthreads();
                pg8::Gemm g{POOLED, (const bf16*)(ws + WS_WPOOLT), M, 1024, 256, 1024, 256, 1, 256};
                pg8::OneUnit S1{u};
                pg8::EpiPool E{MIX, H, args.in[3]};
                pg8::gemm_phase<pg8::EpiPool, pg8::OneUnit>(F.lds + RING_OFF, g, S1, E);
            }
        }
#endif
#ifndef NO_ATTN
        for (int rp_ = 0; rp_ < 1 + (((REPEAT_MASK) >> 13) & 1); ++rp_) {
            if (rp_ > 0 && N_LAUNCHES == 1) xcd_barrier(bar);
            const sba::bf16* Hb = (const sba::bf16*)H; sba::bf16* Mb = (sba::bf16*)MIX;
            for (int item = F.vcu; item < 256; item += F.G) {
                const int bh = item >> 3, x = item & 7, b = bh >> 3, h = bh & 7;
                const size_t rowbase = (size_t)b * SEQ;
                const sba::bf16* Kp = Hb + rowbase * 6144 + 1024 + h * 128; const sba::bf16* Vp = Hb + rowbase * 6144 + 2048 + h * 128;
#pragma unroll 1
                for (int pass = 0; pass < 2; ++pass) {
                    const int qb = pass ? 15 - x : x; sba::BlockRef br;
                    br.P0 = qb * 256; br.Q = Hb + (rowbase + br.P0) * 6144 + h * 128; br.K = Kp; br.V = Vp; br.G = Hb + (rowbase + br.P0) * 6144 + 3072 + h * 128; br.O = Mb + (rowbase + br.P0) * 2048 + h * 128;
                    sba::sb_block(br, (char*)lds + RING_OFF);
                }
            }
        }
#endif
        if (!weights_first) { __syncthreads(); late_weights(F, args); }
        }
        if (BOTH(2)) GRID_BAR();
    }

    if (IN(3)) { REPS(3) {
        pg8::Gemm g{MIX, (const bf16*)(ws + WS_WOUTT), M, DM, DM, DM, DM, 0, 0};
        pg8::StaticOrder S; S.init(M, DM, F.G, (int)blockIdx.x);
        pg8::EpiY E{(bf16*)(ws + WS_Y0)};
        pg8::gemm_phase<pg8::EpiY, pg8::StaticOrder>(F.lds + RING_OFF, g, S, E); }
        if (BOTH(3)) GRID_BAR();
    }

    if (IN(4)) { REPS(4) ln_mix_phase(F, args); if (BOTH(4)) GRID_BAR(); }

    if (IN(5)) { REPS(5) {
        pg8::Gemm g{(const bf16*)(ws + WS_XMIX), (const bf16*)(ws + WS_W2CAT), M, N2CAT, DM, DM, DM, 2, AST / 2};
        pg8::ArrayOrder S; S.init(M, F.G, (int)blockIdx.x);
        pg8::Epi5 E{{(bf16*)(ws + WS_R), (bf16*)(ws + WS_K2), (bf16*)(ws + WS_V2), (bf16*)(ws + WS_SG)}, (bf16*)(ws + WS_TL), (unsigned*)(F.ctl + CW_ACNT), (unsigned)((M / 256) * 8), (volatile LAS unsigned*)(F.MISC + 64)};
        pg8::gemm_phase<pg8::Epi5, pg8::ArrayOrder, true, true, true>(F.lds + RING_OFF, g, S, E);
        { unsigned* acnt = (unsigned*)(F.ctl + CW_ACNT);
          if (threadIdx.x == 0) { unsigned sp = 0; while (__hip_atomic_load(acnt + 4, __ATOMIC_RELAXED, __HIP_MEMORY_SCOPE_AGENT) < (unsigned)(2 * (M / 256))) { __builtin_amdgcn_s_sleep(4); if (++sp > (1u << 22)) break; } }
          __syncthreads(); __builtin_amdgcn_fence(__ATOMIC_ACQUIRE, "agent");
          pg8::Gemm g8{(const bf16*)(ws + WS_TL), (const bf16*)(ws + WS_L2T), M, 4096, 128, 256, 128, 3, 128};
          pg8::TailOrder S8; S8.init(F.G, (int)blockIdx.x, 2 * (M / 256));
          pg8::Epi6 E8{(unsigned short*)(ws + WS_LOGW), (unsigned short*)(ws + WS_AA), args.in[10], args.in[13]};
          pg8::gemm_phase<pg8::Epi6, pg8::TailOrder>(F.lds + RING_OFF, g8, S8, E8); } }
        if (BOTH(5)) GRID_BAR();
    }

    if (IN(9)) { REPS(9) { if (F.G >= 2 * BATCH * 32) scan_phase_split(F, args); else scan_phase(F, args); } if (BOTH(9)) GRID_BAR(); }

    if (IN(10)) {
        pg8::Gemm g{(const bf16*)(ws + WS_OG), (const bf16*)(ws + WS_WOT), M, DM, DM, DM, DM, 0, 0};
        pg8::StaticOrder S; S.init(M, DM, F.G, (int)blockIdx.x);
        pg8::EpiY E{(bf16*)(ws + WS_Y1)};
        pg8::gemm_phase<pg8::EpiY, pg8::StaticOrder>(F.lds + RING_OFF, g, S, E);
        if (BOTH(10)) GRID_BAR();
    }

    if (IN(11)) { final_ln_phase(F, args); }
#undef IN
#undef BOTH
#undef GRID_BAR
}

extern "C" void kernel_launch(void* const* d_in, const int* in_sizes, int n_in, void* d_out, int out_size, void* d_ws, size_t ws_size, hipStream_t stream) {
    static int grid = 0;
    if (grid == 0) {
        if (n_in != 24 || in_sizes[0] != M * DM || out_size != M * DM || ws_size < WS_END) { fprintf(stderr, "kernel_launch: shape/workspace mismatch (n_in %d, in0 %d, out %d, ws %zu, need %zu)\n", n_in, n_in > 0 ? in_sizes[0] : -1, out_size, ws_size, (size_t)WS_END); grid = -1; return; }
        int dev = 0, cus = 0;
        if (hipGetDevice(&dev) != hipSuccess || hipDeviceGetAttribute(&cus, hipDeviceAttributeMultiprocessorCount, dev) != hipSuccess) { grid = -1; return; }
        if (hipFuncSetAttribute((const void*)fwd_kernel, hipFuncAttributeMaxDynamicSharedMemorySize, LDS_BYTES) != hipSuccess) { fprintf(stderr, "kernel_launch: hipFuncSetAttribute failed\n"); grid = -1; return; }
        int per_cu = 0;
        if (hipOccupancyMaxActiveBlocksPerMultiprocessor(&per_cu, (const void*)fwd_kernel, NWAVES * 64, LDS_BYTES) != hipSuccess || per_cu < 1) fprintf(stderr, "kernel_launch: occupancy query says %d\n", per_cu);
        (void)hipGetLastError();
        grid = cus;
    }
    if (grid < 0) return;
    if (hipMemsetAsync((char*)d_ws + WS_CTL, 0, CTL_ZERO_BYTES, stream) != hipSuccess) return;
    Args a{};
    for (int i = 0; i < 24; ++i) a.in[i] = (const float*)d_in[i];
    a.out = (float*)d_out; a.ws = (unsigned char*)d_ws;
    if (N_LAUNCHES == 1) { a.ph_lo = 0; a.ph_hi = N_PHASES; a.li = 0; hipLaunchKernelGGL(fwd_kernel, dim3(grid), dim3(NWAVES * 64), LDS_BYTES, stream, a); }
    else for (int li = 0; li < N_PHASES; ++li) { a.ph_lo = li; a.ph_hi = li + 1; a.li = li; hipLaunchKernelGGL(fwd_kernel, dim3(grid), dim3(NWAVES * 64), LDS_BYTES, stream, a); }
}
```
